# Optimizing an MI355X kernel written in HIP

```python
import math
import jax, jax.numpy as jnp
from jax import lax
import numpy as np

D_MODEL = 1024
BATCH = 2
SEQ = 8192
DEPTH = 4

CHUNK = 64
N_EVEN = (DEPTH + 1) // 2
N_ODD = DEPTH // 2
CONV_WIDTH = 3
CONV_DIM = D_MODEL // 2
POOL_DIM = D_MODEL // 2
POOL_WINDOWS = (2, 4, 8, 16)
POOL_GROUP = POOL_DIM // len(POOL_WINDOWS)
SSM_DIM = D_MODEL // 2
SSM_GROUP = 16
SSM_GROUPS = SSM_DIM // SSM_GROUP
SSM_STATE = 64
SGU_DIM = D_MODEL // 2
SGU_HEADS = 4
SGU_HEAD_DIM = SGU_DIM // SGU_HEADS
SGU_LEN = 128
EVEN_IN = 3 * CONV_DIM + POOL_DIM
ODD_IN = SSM_DIM + 2 * SGU_DIM
MIX_OUT = CONV_DIM + POOL_DIM
FFN_DIM = 2816
N_EXPERTS = 8
TOP_K = 2
EXPERT_DIM = 3584
RMS_EPS = 1e-5
LN_EPS = 1e-5
DT_MIN = 1e-3
DT_MAX = 1e-1

kernel_name = 'hybrid_conv_pool_s5_gmlp_moe_trunk'


def rms_norm(x, g):
    xf = x.astype(jnp.float32)
    y = xf * lax.rsqrt(jnp.mean(xf * xf, axis=-1, keepdims=True) + RMS_EPS)
    return (y * g.astype(jnp.float32)).astype(x.dtype)


def swiglu(x, w1, w3, w2):
    return (jax.nn.silu(x @ w1) * (x @ w3)) @ w2


def short_conv_mixer(gb, gc, xa, conv_w):
    z = gc * xa
    l = z.shape[1]
    zp = jnp.pad(z, ((0, 0), (CONV_WIDTH - 1, 0), (0, 0)))
    y = conv_w[0] * zp[:, 0:l]
    for k in range(1, CONV_WIDTH):
        y = y + conv_w[k] * zp[:, k:k + l]
    return gb * y


def pool_mixer(p, pool_w, pool_scale):
    b, l, _ = p.shape
    pg = p.astype(jnp.float32).reshape(b, l, len(POOL_WINDOWS), POOL_GROUP)
    cs = jnp.cumsum(pg, axis=1)
    pos = jnp.arange(1, l + 1, dtype=jnp.float32)
    outs = []
    for gi, w in enumerate(POOL_WINDOWS):
        c = cs[:, :, gi]
        c_prev = jnp.pad(c, ((0, 0), (w, 0), (0, 0)))[:, :l]
        cnt = jnp.minimum(pos, float(w))[None, :, None]
        outs.append((c - c_prev) / cnt - pg[:, :, gi])
    pooled = jnp.stack(outs, axis=2)
    mixed = jnp.einsum('blgc,gcd->blgd', pooled, pool_w.astype(jnp.float32))
    out = mixed.reshape(b, l, POOL_DIM) * pool_scale.astype(jnp.float32)
    return out.astype(p.dtype)


def _complex_scan_combine(e1, e2):
    a1r, a1i, b1r, b1i = e1
    a2r, a2i, b2r, b2i = e2
    ar = a2r * a1r - a2i * a1i
    ai = a2r * a1i + a2i * a1r
    br = a2r * b1r - a2i * b1i + b2r
    bi = a2r * b1i + a2i * b1r + b2i
    return (ar, ai, br, bi)


def s5_mixer(u, lam_re, lam_im, log_dt, b_re, b_im, c_re, c_im, d_skip, glu_w, glu_b):
    f32 = jnp.float32
    bsz, l, _ = u.shape
    uf = u.astype(f32)
    ug = uf.reshape(bsz, l, SSM_GROUPS, SSM_GROUP)
    lr = lam_re.astype(f32)
    li = lam_im.astype(f32)
    dt = jnp.exp(log_dt.astype(f32))[:, None]
    mag = jnp.exp(lr * dt)
    abar_r = mag * jnp.cos(li * dt)
    abar_i = mag * jnp.sin(li * dt)
    qr = abar_r - 1.0
    qi = abar_i
    den = lr * lr + li * li
    fr = ((qr * lr + qi * li) / den)[..., None]
    fi = ((qi * lr - qr * li) / den)[..., None]
    br = b_re.astype(f32)
    bi = b_im.astype(f32)
    bbar_r = fr * br - fi * bi
    bbar_i = fr * bi + fi * br
    bu_r = jnp.einsum('blgh,gph->blgp', ug, bbar_r)
    bu_i = jnp.einsum('blgh,gph->blgp', ug, bbar_i)
    a_r = jnp.broadcast_to(abar_r, bu_r.shape)
    a_i = jnp.broadcast_to(abar_i, bu_i.shape)
    _, _, h_r, h_i = lax.associative_scan(_complex_scan_combine, (a_r, a_i, bu_r, bu_i), axis=1)
    y = (jnp.einsum('ghp,blgp->blgh', c_re.astype(f32), h_r)
         - jnp.einsum('ghp,blgp->blgh', c_im.astype(f32), h_i))
    y = y.reshape(bsz, l, SSM_DIM) + d_skip.astype(f32) * uf
    g = jax.nn.gelu(y)
    out = g * jax.nn.sigmoid(g @ glu_w.astype(f32) + glu_b.astype(f32))
    return out.astype(u.dtype)


def sgu_mixer(zu, zv, ln_g, sgu_w, sgu_b):
    f32 = jnp.float32
    bsz, l, _ = zu.shape
    u = jax.nn.gelu(zu)
    v = jax.nn.gelu(zv).astype(f32).reshape(bsz, l, SGU_HEADS, SGU_HEAD_DIM)
    mu = jnp.mean(v, axis=-1, keepdims=True)
    var = jnp.mean(jnp.square(v - mu), axis=-1, keepdims=True)
    v = (v - mu) * lax.rsqrt(var + LN_EPS) * ln_g.astype(f32).reshape(SGU_HEADS, SGU_HEAD_DIM)
    v = v.reshape(bsz, l // SGU_LEN, SGU_LEN, SGU_HEADS, SGU_HEAD_DIM)
    cidx = jnp.arange(SGU_LEN) // CHUNK
    mask = cidx[None, :] <= cidx[:, None]
    w = jnp.where(mask[None], sgu_w.astype(f32), 0.0)
    s = jnp.einsum('hij,bnjhc->bnihc', w, v) + sgu_b.astype(f32).T[None, None, :, :, None]
    return u * s.reshape(bsz, l, SGU_DIM).astype(u.dtype)


def moe_swiglu(h, router_w, w1, w3, w2):
    bsz, l, d = h.shape
    xf = h.reshape(-1, d)
    logits = (xf @ router_w).astype(jnp.float32)
    top_v, top_i = lax.top_k(logits, TOP_K)
    top_w = jax.nn.softmax(top_v, axis=-1)
    gates = jnp.sum(jax.nn.one_hot(top_i, N_EXPERTS, dtype=jnp.float32) * top_w[..., None], axis=1)
    gates = gates.astype(h.dtype)
    out = jnp.zeros_like(xf)
    for e in range(N_EXPERTS):
        out = out + gates[:, e:e + 1] * swiglu(xf, w1[e], w3[e], w2[e])
    return out.reshape(bsz, l, d)


def setup_inputs(seed: int = 0) -> dict:
    key = jax.random.key(seed)
    k = jax.random.split(key, 40)
    f32 = jnp.float32
    D = D_MODEL
    ne, no = N_EVEN, N_ODD

    def nrm(kk, shape, scale):
        return jax.random.normal(kk, shape, f32) * scale

    def gain(kk, shape):
        return 1.0 + nrm(kk, shape, 0.02)

    n_idx = jnp.arange(SSM_STATE, dtype=f32)
    return {
        'x': nrm(k[0], (BATCH, SEQ, D), 1.0),
        'ev_norm1_g': gain(k[1], (ne, D)),
        'ev_w_in': nrm(k[2], (ne, D, EVEN_IN), D ** -0.5),
        'ev_conv_w': nrm(k[3], (ne, CONV_WIDTH, CONV_DIM), CONV_WIDTH ** -0.5),
        'ev_pool_w': nrm(k[4], (ne, len(POOL_WINDOWS), POOL_GROUP, POOL_GROUP), POOL_GROUP ** -0.5),
        'ev_pool_scale': 1.0 + nrm(k[5], (ne, POOL_DIM), 0.1),
        'ev_w_out': nrm(k[6], (ne, MIX_OUT, D), MIX_OUT ** -0.5),
        'ev_norm2_g': gain(k[7], (ne, D)),
        'ev_ffn_w1': nrm(k[8], (ne, D, FFN_DIM), D ** -0.5),
        'ev_ffn_w3': nrm(k[9], (ne, D, FFN_DIM), D ** -0.5),
        'ev_ffn_w2': nrm(k[10], (ne, FFN_DIM, D), FFN_DIM ** -0.5),
        'od_norm1_g': gain(k[11], (no, D)),
        'od_w_in': nrm(k[12], (no, D, ODD_IN), D ** -0.5),
        'od_lambda_re': -0.5 * jnp.exp(nrm(k[13], (no, SSM_GROUPS, SSM_STATE), 0.02)),
        'od_lambda_im': math.pi * n_idx + nrm(k[14], (no, SSM_GROUPS, SSM_STATE), 0.01),
        'od_log_dt': jax.random.uniform(k[15], (no, SSM_GROUPS), f32, math.log(DT_MIN), math.log(DT_MAX)),
        'od_b_re': nrm(k[16], (no, SSM_GROUPS, SSM_STATE, SSM_GROUP), (2 * SSM_GROUP) ** -0.5),
        'od_b_im': nrm(k[17], (no, SSM_GROUPS, SSM_STATE, SSM_GROUP), (2 * SSM_GROUP) ** -0.5),
        'od_c_re': nrm(k[18], (no, SSM_GROUPS, SSM_GROUP, SSM_STATE), SSM_STATE ** -0.5),
        'od_c_im': nrm(k[19], (no, SSM_GROUPS, SSM_GROUP, SSM_STATE), SSM_STATE ** -0.5),
        'od_d': nrm(k[20], (no, SSM_DIM), 1.0),
        'od_glu_w': nrm(k[21], (no, SSM_DIM, SSM_DIM), SSM_DIM ** -0.5),
        'od_glu_b': nrm(k[22], (no, SSM_DIM), 0.01),
        'od_sgu_ln_g': gain(k[23], (no, SGU_DIM)),
        'od_sgu_w': nrm(k[24], (no, SGU_HEADS, SGU_LEN, SGU_LEN), SGU_LEN ** -0.5),
        'od_sgu_b': 1.0 + nrm(k[25], (no, SGU_HEADS, SGU_LEN), 0.01),
        'od_w_out': nrm(k[26], (no, MIX_OUT, D), MIX_OUT ** -0.5),
        'od_norm2_g': gain(k[27], (no, D)),
        'od_router_w': nrm(k[28], (no, D, N_EXPERTS), D ** -0.5),
        'od_moe_w1': nrm(k[29], (no, N_EXPERTS, D, EXPERT_DIM), D ** -0.5),
        'od_moe_w3': nrm(k[30], (no, N_EXPERTS, D, EXPERT_DIM), D ** -0.5),
        'od_moe_w2': nrm(k[31], (no, N_EXPERTS, EXPERT_DIM, D), EXPERT_DIM ** -0.5),
        'final_norm_g': gain(k[32], (D,)),
    }


def reference(x, ev_norm1_g, ev_w_in, ev_conv_w, ev_pool_w, ev_pool_scale, ev_w_out,
              ev_norm2_g, ev_ffn_w1, ev_ffn_w3, ev_ffn_w2,
              od_norm1_g, od_w_in, od_lambda_re, od_lambda_im, od_log_dt,
              od_b_re, od_b_im, od_c_re, od_c_im, od_d, od_glu_w, od_glu_b,
              od_sgu_ln_g, od_sgu_w, od_sgu_b, od_w_out, od_norm2_g,
              od_router_w, od_moe_w1, od_moe_w3, od_moe_w2, final_norm_g):
    h = x
    for layer in range(DEPTH):
        i = layer // 2
        if layer % 2 == 0:
            z = rms_norm(h, ev_norm1_g[i]) @ ev_w_in[i]
            gb, gc, xa, p = jnp.split(z, [CONV_DIM, 2 * CONV_DIM, 3 * CONV_DIM], axis=-1)
            mix = jnp.concatenate([short_conv_mixer(gb, gc, xa, ev_conv_w[i]),
                                   pool_mixer(p, ev_pool_w[i], ev_pool_scale[i])], axis=-1)
            h = h + mix @ ev_w_out[i]
            h = h + swiglu(rms_norm(h, ev_norm2_g[i]), ev_ffn_w1[i], ev_ffn_w3[i], ev_ffn_w2[i])
        else:
            z = rms_norm(h, od_norm1_g[i]) @ od_w_in[i]
            u, zu, zv = jnp.split(z, [SSM_DIM, SSM_DIM + SGU_DIM], axis=-1)
            ssm = s5_mixer(u, od_lambda_re[i], od_lambda_im[i], od_log_dt[i], od_b_re[i], od_b_im[i],
                           od_c_re[i], od_c_im[i], od_d[i], od_glu_w[i], od_glu_b[i])
            sgu = sgu_mixer(zu, zv, od_sgu_ln_g[i], od_sgu_w[i], od_sgu_b[i])
            mix = jnp.concatenate([ssm, sgu], axis=-1)
            h = h + mix @ od_w_out[i]
            h = h + moe_swiglu(rms_norm(h, od_norm2_g[i]), od_router_w[i], od_moe_w1[i],
                               od_moe_w3[i], od_moe_w2[i])
    return rms_norm(h, final_norm_g)
```

```cpp
#define F8_FFN_FROM 2
#include <hip/hip_runtime.h>
#include <cstdio>
#include <cstdint>

namespace pg8 {
#define PG8_LAS __attribute__((address_space(3)))
typedef unsigned short bf16_t;
typedef short bf16x8 __attribute__((ext_vector_type(8)));
typedef float f32x4 __attribute__((ext_vector_type(4)));
typedef float f32x2 __attribute__((ext_vector_type(2)));
typedef unsigned u32x4 __attribute__((ext_vector_type(4)));
typedef unsigned u32x2 __attribute__((ext_vector_type(2)));
constexpr int BM = 256, BK = 64, HALF = 128, HTB = HALF * BK * 2  , STAGE_BYTES = 8 * HTB, NXCD = 8, WGM = 8;

__host__ __device__ __forceinline__ int lds_byte(int r, int c) { const int st = (r >> 4) * 2 + (c >> 5), rr = r & 15, cc = c & 31, ob = rr * 64 + cc * 2; return st * 1024 + (ob ^ (((ob >> 9) & 1) << 5)); }
__host__ __device__ __forceinline__ void stage_rc(int b, int& R, int& C) { const int st = b / 1024, sb = b % 1024, swz = sb ^ (((sb >> 9) & 1) << 5); R = (st >> 1) * 16 + swz / 64; C = (st & 1) * 32 + (swz % 64) / 2; }
__host__ __device__ __forceinline__ int perm32(int rho) { const int n = rho >> 4, i = rho & 15; return 8 * (i >> 2) + 4 * n + (i & 3); }

typedef int i32x4 __attribute__((ext_vector_type(4)));
typedef int i32x8 __attribute__((ext_vector_type(8)));
__device__ __forceinline__ i32x8 cat8(const bf16x8 a, const bf16x8 b) { return __builtin_shufflevector(__builtin_bit_cast(i32x4, a), __builtin_bit_cast(i32x4, b), 0, 1, 2, 3, 4, 5, 6, 7); }
__device__ __forceinline__ unsigned pk4_fp8(float a, float b, float c, float d) {
    a = __builtin_fminf(__builtin_fmaxf(a, -448.f), 448.f); b = __builtin_fminf(__builtin_fmaxf(b, -448.f), 448.f); c = __builtin_fminf(__builtin_fmaxf(c, -448.f), 448.f); d = __builtin_fminf(__builtin_fmaxf(d, -448.f), 448.f);
    int p = __builtin_amdgcn_cvt_pk_fp8_f32(a, b, 0, false); p = __builtin_amdgcn_cvt_pk_fp8_f32(c, d, p, true); return (unsigned)p;
}
struct Unit { int pm, pn, idx; };

struct Order {
    int nM, nN, nwg, G, c;
    __device__ __forceinline__ void init(int nM_, int nN_, int G_, int c_) { nM = nM_; nN = nN_; nwg = nM * nN; G = G_; c = c_; }
    __device__ __forceinline__ bool next(int i, Unit& u) const {
        const long L = (long)i * G + c; if (L >= nwg) return false;
        int wgid = (int)L; { const int q = nwg / NXCD, r = nwg % NXCD, xcd = wgid % NXCD, off = wgid / NXCD; wgid = (xcd < r ? xcd * (q + 1) : r * (q + 1) + (xcd - r) * q) + off; }
        const int nig = WGM * nN, gid = wgid / nig, fm = gid * WGM, gsz = (nM - fm) < WGM ? (nM - fm) : WGM;
        u.pm = fm + ((wgid % nig) % gsz); u.pn = (wgid % nig) / gsz; u.idx = i; return true;
    }
    __device__ __forceinline__ void a_ready(const Unit&) const {}
    __device__ __forceinline__ void done(const Unit&) const {}
};

struct GDs {
    const bf16_t* A; const bf16_t* Bt; int lda, ldb, K, gshift; size_t gstride;
    __device__ __forceinline__ const char* a_ptr(const Unit& u) const { return (const char*)(A + (size_t)u.pm * BM * lda); }
    __device__ __forceinline__ const char* b_ptr(const Unit& u) const { return (const char*)(Bt + (size_t)(u.pm >> gshift) * gstride + (size_t)u.pn * BM * ldb); }
};
struct GDh {
    const bf16_t* A; const bf16_t* Bt; int lda, ldb, K, gshift; size_t gstride;
    __device__ __forceinline__ const char* a_ptr(const Unit& u) const { return (const char*)(A + (size_t)u.pm * BM * lda); }
    __device__ __forceinline__ const char* b_ptr(const Unit& u) const { return (const char*)(Bt + (size_t)(u.pm >> gshift) * gstride + (size_t)u.pn * HALF * ldb); }
};
struct GDt {
    const bf16_t* A; const bf16_t* Bt; int lda, ldb, K; size_t gstride; const PG8_LAS int* tab;
    __device__ __forceinline__ const char* a_ptr(const Unit& u) const { return (const char*)(A + (size_t)u.pm * BM * lda); }
    __device__ __forceinline__ const char* b_ptr(const Unit& u) const { const int grp = __builtin_amdgcn_readfirstlane(tab[u.pm]); return (const char*)(Bt + (size_t)grp * gstride + (size_t)u.pn * BM * ldb); }
};

struct GDk {
    const bf16_t* A; const bf16_t* Bt; int lda, ldb, K; size_t gstride; const PG8_LAS int* tab; int pm0, ksl;
    __device__ __forceinline__ const char* a_ptr(const Unit& u) const { return (const char*)(A + (size_t)(pm0 + u.pm) * BM * lda + (size_t)(u.pn >> 2) * ksl); }
    __device__ __forceinline__ const char* b_ptr(const Unit& u) const { const int grp = __builtin_amdgcn_readfirstlane(tab[pm0 + u.pm]); return (const char*)(Bt + (size_t)grp * gstride + (size_t)(u.pn & 3) * BM * ldb + (size_t)(u.pn >> 2) * ksl); }
};

__device__ __forceinline__ unsigned cvt_pk_bf16(float lo, float hi) { unsigned r; asm volatile("v_cvt_pk_bf16_f32 %0, %1, %2" : "=v"(r) : "v"(lo), "v"(hi)); return r; }
__device__ __forceinline__ float bf_lo(unsigned w) { return __uint_as_float(w << 16); }
__device__ __forceinline__ float bf_hi(unsigned w) { return __uint_as_float(w & 0xffff0000u); }
__device__ __forceinline__ float sigmoid_f(float x) { return __builtin_amdgcn_rcpf(1.0f + __expf(-x)); }
__device__ __forceinline__ float silu_f(float x) { return x * sigmoid_f(x); }
__device__ __forceinline__ float gelu_f(float x) { const float z2 = 1.5957691216057308f * (x + 0.044715f * x * x * x); return x * sigmoid_f(z2); }

constexpr float RMS_EPS_F = 1e-5f;
__device__ __forceinline__ float row_rstd(const float* ssq, int row, int fq) {
    const f32x4 p = *(const f32x4*)(ssq + (size_t)row * 16 + 4 * fq);
    float s = (p[0] + p[1]) + (p[2] + p[3]);
    s += __shfl_xor(s, 16); s += __shfl_xor(s, 32);
    return 1.0f / sqrtf(s * (1.0f / 1024.0f) + RMS_EPS_F);
}
__device__ __forceinline__ void rows_rstd(const float* ssq, int row0, int fq, float (&rs)[2][4]) {
    f32x4 p[2][4];
#pragma unroll
    for (int ai = 0; ai < 2; ++ai)
#pragma unroll
        for (int m = 0; m < 4; ++m) p[ai][m] = *(const f32x4*)(ssq + (size_t)(row0 + ai * HALF + m * 16) * 16 + 4 * fq);
#pragma unroll
    for (int ai = 0; ai < 2; ++ai)
#pragma unroll
        for (int m = 0; m < 4; ++m) { float s = (p[ai][m][0] + p[ai][m][1]) + (p[ai][m][2] + p[ai][m][3]); s += __shfl_xor(s, 16); s += __shfl_xor(s, 32); rs[ai][m] = 1.0f / sqrtf(s * (1.0f / 1024.0f) + RMS_EPS_F); }
}
__device__ __forceinline__ void rows_rstd_lds(const PG8_LAS float* t, float (&rs)[2][4]) {
#pragma unroll
    for (int ai = 0; ai < 2; ++ai)
#pragma unroll
        for (int m = 0; m < 4; ++m) rs[ai][m] = t[ai * HALF + m * 16];
}
__device__ __forceinline__ u32x4 pack8(const f32x4& a, const f32x4& b) { u32x4 w; w.x = cvt_pk_bf16(a[0], a[1]); w.y = cvt_pk_bf16(a[2], a[3]); w.z = cvt_pk_bf16(b[0], b[1]); w.w = cvt_pk_bf16(b[2], b[3]); return w; }

struct EpiScaleBf16 {
    static constexpr bool PERM = true, AFTER_DRAIN = false;
    bf16_t* O; int ldc; const PG8_LAS float* rst;
    __device__ __forceinline__ void operator()(const f32x4 (&acc)[2][2][4][2], const Unit& u, int wr, int wc, int fr, int fq) const {
        const int row0 = u.pm * BM + wr * 64 + fr, col0 = u.pn * BM + wc * 32 + 8 * fq;
        float rsv[2][4]; rows_rstd_lds(rst + u.idx * 256 + wr * 64 + fr, rsv);
#pragma unroll
        for (int ai = 0; ai < 2; ++ai)
#pragma unroll
            for (int m = 0; m < 4; ++m) { const int row = row0 + ai * HALF + m * 16; const float rs = rsv[ai][m]; bf16_t* rowp = O + (size_t)row * ldc + col0;
#pragma unroll
                for (int bj = 0; bj < 2; ++bj) *(u32x4*)(rowp + bj * HALF) = pack8(acc[ai][bj][m][0] * rs, acc[ai][bj][m][1] * rs); }
    }
};
template <bool SCALED> struct EpiResid {
    static constexpr bool PERM = false, AFTER_DRAIN = false;
    const float* resid; float* H; bf16_t* HB; float* ssq; float sc; unsigned char* H8;
    __device__ __forceinline__ void operator()(const f32x4 (&acc)[2][2][4][2], const Unit& u, int wr, int wc, int fr, int fq) const {
        const int row0 = u.pm * BM + wr * 64 + fr, col0 = u.pn * BM + wc * 32 + 4 * fq;
#pragma unroll
        for (int ai = 0; ai < 2; ++ai)
#pragma unroll
            for (int m = 0; m < 4; ++m) { const int row = row0 + ai * HALF + m * 16; const size_t off = (size_t)row * 1024 + col0; float q = 0.f;
#pragma unroll
                for (int bj = 0; bj < 2; ++bj)
#pragma unroll
                    for (int n = 0; n < 2; ++n) { const f32x4 bs = *(const f32x4*)(resid + off + bj * HALF + n * 16); f32x4 o; if (SCALED) { const f32x4 a4 = acc[ai][bj][m][n]; o[0] = __builtin_fmaf(a4[0], sc, bs[0]); o[1] = __builtin_fmaf(a4[1], sc, bs[1]); o[2] = __builtin_fmaf(a4[2], sc, bs[2]); o[3] = __builtin_fmaf(a4[3], sc, bs[3]); } else o = bs + acc[ai][bj][m][n];
                        *(f32x4*)(H + off + bj * HALF + n * 16) = o;
                        if (HB) { u32x2 w; w.x = cvt_pk_bf16(o[0], o[1]); w.y = cvt_pk_bf16(o[2], o[3]); *(u32x2*)(HB + off + bj * HALF + n * 16) = w; q += (o[0] * o[0] + o[1] * o[1]) + (o[2] * o[2] + o[3] * o[3]); }
                        if (H8) *(unsigned*)(H8 + off + bj * HALF + n * 16) = pk4_fp8(o[0], o[1], o[2], o[3]); }
                if (HB) { q += __shfl_xor(q, 16); q += __shfl_xor(q, 32); if (fq == 0) ssq[(size_t)row * 16 + u.pn * 4 + wc] = q; }
                asm volatile("" ::: "memory"); }
    }
};
template <bool MOE> struct EpiSwiGLU {
    static constexpr bool PERM = true, AFTER_DRAIN = false;
    bf16_t* U; int ldc; const PG8_LAS float* rst;
    __device__ __forceinline__ void operator()(const f32x4 (&acc)[2][2][4][2], const Unit& u, int wr, int wc, int fr, int fq) const {
        const int row0 = u.pm * BM + wr * 64 + fr, col0 = u.pn * HALF + wc * 32 + 8 * fq;
        float rsv[2][4];
        if (!MOE) rows_rstd_lds(rst + u.idx * 256 + wr * 64 + fr, rsv);
#pragma unroll
        for (int ai = 0; ai < 2; ++ai)
#pragma unroll
            for (int m = 0; m < 4; ++m) { const int row = row0 + ai * HALF + m * 16;
                const float rs = MOE ? 1.0f : rsv[ai][m], gw = 1.0f;
                f32x4 o0, o1;
#pragma unroll
                for (int j = 0; j < 4; ++j) { o0[j] = silu_f(acc[ai][0][m][0][j] * rs) * (acc[ai][1][m][0][j] * rs) * gw; o1[j] = silu_f(acc[ai][0][m][1][j] * rs) * (acc[ai][1][m][1][j] * rs) * gw; }
                *(u32x4*)(U + (size_t)row * ldc + col0) = pack8(o0, o1); }
    }
};
template <bool RS> struct EpiSwiGLUF8 {
    static constexpr bool PERM = true, AFTER_DRAIN = false;
    unsigned char* U; int ldc; float isc, osc; const PG8_LAS float* rst;
    __device__ __forceinline__ void operator()(const f32x4 (&acc)[2][2][4][2], const Unit& u, int wr, int wc, int fr, int fq) const {
        const int row0 = u.pm * BM + wr * 64 + fr, col0 = u.pn * HALF + wc * 32 + 8 * fq;
        float rsv[2][4];
        if (RS) rows_rstd_lds(rst + u.idx * 256 + wr * 64 + fr, rsv);
#pragma unroll
        for (int ai = 0; ai < 2; ++ai)
#pragma unroll
            for (int m = 0; m < 4; ++m) { const int row = row0 + ai * HALF + m * 16; float o[8]; const float is = RS ? isc * rsv[ai][m] : isc;
#pragma unroll
                for (int j = 0; j < 4; ++j) { o[j] = silu_f(acc[ai][0][m][0][j] * is) * (acc[ai][1][m][0][j] * is) * osc; o[4 + j] = silu_f(acc[ai][0][m][1][j] * is) * (acc[ai][1][m][1][j] * is) * osc; }
                u32x2 w; w.x = pk4_fp8(o[0], o[1], o[2], o[3]); w.y = pk4_fp8(o[4], o[5], o[6], o[7]);
                *(u32x2*)(U + (size_t)row * ldc + col0) = w; }
    }
};
struct EpiOddIn {
    static constexpr bool PERM = true, AFTER_DRAIN = false;
    bf16_t* AG; bf16_t* ZUV; const PG8_LAS float* rst;
    __device__ __forceinline__ void operator()(const f32x4 (&acc)[2][2][4][2], const Unit& u, int wr, int wc, int fr, int fq) const {
        const int row0 = u.pm * BM + wr * 64 + fr;
        float rsv[2][4]; rows_rstd_lds(rst + u.idx * 256 + wr * 64 + fr, rsv);
#pragma unroll
        for (int ai = 0; ai < 2; ++ai)
#pragma unroll
            for (int m = 0; m < 4; ++m) { const int row = row0 + ai * HALF + m * 16; const float rs = rsv[ai][m];
#pragma unroll
                for (int bj = 0; bj < 2; ++bj) { f32x4 v0 = acc[ai][bj][m][0] * rs, v1 = acc[ai][bj][m][1] * rs;
                    if (u.pn < 2) { const int cc = u.pn * BM + bj * HALF + wc * 32 + 8 * fq, g = cc >> 4, h0 = cc & 15;
                        *(u32x4*)(AG + ((size_t)g * 512 + (row >> 5)) * 640 + 128 + (row & 31) * 16 + h0) = pack8(v0, v1); }
                    else { const int cc = (u.pn - 2) * BM + bj * HALF + wc * 32 + 8 * fq;
#pragma unroll
                        for (int j = 0; j < 4; ++j) { v0[j] = gelu_f(v0[j]); v1[j] = gelu_f(v1[j]); }
                        *(u32x4*)(ZUV + (size_t)row * 1024 + cc) = pack8(v0, v1); } } }
    }
};
struct EpiS5Scan {
    static constexpr bool PERM = false, AFTER_DRAIN = true;
    bf16_t* AG; const float* AT;
    __device__ __forceinline__ void operator()(const f32x4 (&)[2][2][4][2], const Unit&, int, int, int, int) const {}
    __device__ __forceinline__ void fused(const f32x4 (&acc)[2][2][4][2], const Unit& u, int wr, int wc, int fr, int fq, PG8_LAS unsigned char* lds, int wid, int lane) const {
#pragma unroll
        for (int ai = 0; ai < 2; ++ai)
#pragma unroll
            for (int m = 0; m < 4; ++m) { const int r = ai * HALF + wr * 64 + m * 16 + fr;
#pragma unroll
                for (int n = 0; n < 2; ++n) { const int gq = (wc * 32 + n * 16 + 4 * fq) >> 2; *(PG8_LAS f32x4*)(lds + r * 512 + ((gq ^ (r & 15)) << 4)) = acc[ai][0][m][n]; } }
        asm volatile("s_waitcnt lgkmcnt(0)" ::: "memory"); __builtin_amdgcn_s_barrier(); asm volatile("" ::: "memory");
        if (wid == 0) { const int g = u.pm >> 1, p = lane;
            const float ar = AT[(g * 64 + p) * 2], ai_ = AT[(g * 64 + p) * 2 + 1]; float hr = 0.f, hi = 0.f;
            bf16_t* ap = AG + (size_t)u.pm * BM * 640 + p;
            const int g0 = p >> 2, g1 = (64 + p) >> 2, sub = (p & 3) << 2;
            for (int c0 = 0; c0 < 256; c0 += 8) { float sr[8], si[8];
#pragma unroll
                for (int e = 0; e < 8; ++e) { const int c = c0 + e; sr[e] = *(const PG8_LAS float*)(lds + c * 512 + ((g0 ^ (c & 15)) << 4) + sub); si[e] = *(const PG8_LAS float*)(lds + c * 512 + ((g1 ^ (c & 15)) << 4) + sub); }
#pragma unroll
                for (int e = 0; e < 8; ++e) { const unsigned w = cvt_pk_bf16(hr, hi); ap[(size_t)(c0 + e) * 640] = (bf16_t)(w & 0xffffu); ap[(size_t)(c0 + e) * 640 + 64] = (bf16_t)(w >> 16);
                    const float nr = ar * hr - ai_ * hi + sr[e], ni = ar * hi + ai_ * hr + si[e]; hr = nr; hi = ni; } }
        }
    }
};
struct EpiS5Y {
    static constexpr bool PERM = true, AFTER_DRAIN = false;
    const bf16_t* AG; const float* dskip; bf16_t* GY;
    __device__ __forceinline__ void operator()(const f32x4 (&acc)[2][2][4][2], const Unit& u, int wr, int wc, int fr, int fq) const {
        const int row0 = u.pm * BM + wr * 64 + fr, g = u.pm >> 1;
        const int n0 = u.pn * HALF + wc * 32 + 8 * fq, jl = n0 >> 4, h0 = n0 & 15;
        const f32x4 d0 = *(const f32x4*)(dskip + g * 16 + h0), d1 = *(const f32x4*)(dskip + g * 16 + h0 + 4);
#pragma unroll
        for (int ai = 0; ai < 2; ++ai)
#pragma unroll
            for (int m = 0; m < 4; ++m) { const int row = row0 + ai * HALF + m * 16;
                const u32x4 uu = *(const u32x4*)(AG + (size_t)row * 640 + 128 + n0);
                f32x4 y0 = acc[ai][0][m][0], y1 = acc[ai][0][m][1];
                y0[0] += d0[0] * bf_lo(uu.x); y0[1] += d0[1] * bf_hi(uu.x); y0[2] += d0[2] * bf_lo(uu.y); y0[3] += d0[3] * bf_hi(uu.y);
                y1[0] += d1[0] * bf_lo(uu.z); y1[1] += d1[1] * bf_hi(uu.z); y1[2] += d1[2] * bf_lo(uu.w); y1[3] += d1[3] * bf_hi(uu.w);
#pragma unroll
                for (int j = 0; j < 4; ++j) { y0[j] = gelu_f(y0[j]); y1[j] = gelu_f(y1[j]); }
                const int chunk = row & 511, token = chunk * 32 + jl;
                *(u32x4*)(GY + (size_t)token * 512 + g * 16 + h0) = pack8(y0, y1); }
    }
};
struct EpiGLU {
    static constexpr bool PERM = true, AFTER_DRAIN = false;
    const bf16_t* GY; const float* bias; bf16_t* MIX;
    __device__ __forceinline__ void operator()(const f32x4 (&acc)[2][2][4][2], const Unit& u, int wr, int wc, int fr, int fq) const {
        const int row0 = u.pm * BM + wr * 64 + fr, c0 = u.pn * HALF + wc * 32 + 8 * fq;
        const f32x4 b0 = *(const f32x4*)(bias + c0), b1 = *(const f32x4*)(bias + c0 + 4);
#pragma unroll
        for (int ai = 0; ai < 2; ++ai)
#pragma unroll
            for (int m = 0; m < 4; ++m) { const int row = row0 + ai * HALF + m * 16;
                const u32x4 gg = *(const u32x4*)(GY + (size_t)row * 512 + c0);
                const f32x4 a0 = acc[ai][0][m][0] + b0, a1 = acc[ai][0][m][1] + b1; f32x4 o0, o1;
                o0[0] = bf_lo(gg.x) * sigmoid_f(a0[0]); o0[1] = bf_hi(gg.x) * sigmoid_f(a0[1]); o0[2] = bf_lo(gg.y) * sigmoid_f(a0[2]); o0[3] = bf_hi(gg.y) * sigmoid_f(a0[3]);
                o1[0] = bf_lo(gg.z) * sigmoid_f(a1[0]); o1[1] = bf_hi(gg.z) * sigmoid_f(a1[1]); o1[2] = bf_lo(gg.w) * sigmoid_f(a1[2]); o1[3] = bf_hi(gg.w) * sigmoid_f(a1[3]);
                *(u32x4*)(MIX + (size_t)row * 1024 + c0) = pack8(o0, o1); }
    }
};
struct EpiBf16 {
    static constexpr bool PERM = true, AFTER_DRAIN = false;
    bf16_t* O; int ldc; float sc;
    __device__ __forceinline__ void operator()(const f32x4 (&acc)[2][2][4][2], const Unit& u, int wr, int wc, int fr, int fq) const {
        const int row0 = u.pm * BM + wr * 64 + fr, col0 = u.pn * BM + wc * 32 + 8 * fq;
#pragma unroll
        for (int ai = 0; ai < 2; ++ai)
#pragma unroll
            for (int m = 0; m < 4; ++m) { bf16_t* rowp = O + (size_t)(row0 + ai * HALF + m * 16) * ldc + col0;
#pragma unroll
                for (int bj = 0; bj < 2; ++bj) *(u32x4*)(rowp + bj * HALF) = pack8(acc[ai][bj][m][0] * sc, acc[ai][bj][m][1] * sc); }
    }
};

struct EpiPartF32 {
    static constexpr bool PERM = false, AFTER_DRAIN = false;
    float* P; float sc;
    __device__ __forceinline__ void operator()(const f32x4 (&acc)[2][2][4][2], const Unit& u, int wr, int wc, int fr, int fq) const {
        float* base = P + ((size_t)(u.pm * 7 + (u.pn >> 2)) * 256 + wr * 64 + fr) * 1024 + (u.pn & 3) * BM + wc * 32 + 4 * fq;
#pragma unroll
        for (int ai = 0; ai < 2; ++ai)
#pragma unroll
            for (int m = 0; m < 4; ++m) { float* rowp = base + (size_t)(ai * HALF + m * 16) * 1024;
#pragma unroll
                for (int bj = 0; bj < 2; ++bj)
#pragma unroll
                    for (int n = 0; n < 2; ++n) *(f32x4*)(rowp + bj * HALF + n * 16) = acc[ai][bj][m][n] * sc; }
    }
};

template <class Epi, class Sched, class GD, int MMODE = 0, bool ALIGN_EPI = true, bool SP2 = true>
__device__ __forceinline__ void gemm_phase(PG8_LAS unsigned char* lds, const GD& g, const Sched& S, const Epi& E, const int wid) {
    int lane_o; asm volatile("v_mbcnt_lo_u32_b32 %0, -1, 0\n\tv_mbcnt_hi_u32_b32 %0, -1, %0" : "=v"(lane_o));
    const int lane = lane_o, tid = wid * 64 + lane, wr = wid >> 2, wc = wid & 3, fr = lane & 15, fq = lane >> 4;
    const int K = g.K, nt = K / BK, lda = g.lda, ldb = g.ldb;
    unsigned voffA[2], voffB[2];
#pragma unroll
    for (int i = 0; i < 2; ++i) { int R, C; stage_rc(tid * 16 + i * 8192, R, C); const int Rb = Epi::PERM ? ((R & ~31) + perm32(R & 31)) : R;
        voffA[i] = (unsigned)(R * lda + C) * 2u; voffB[i] = (unsigned)(Rb * ldb + C) * 2u; }
    const size_t kstep = (size_t)(BK * 2);
    const size_t hstepA = (size_t)HALF * lda * 2, hstepB = (size_t)HALF * ldb * 2;
    const unsigned ldsw = (unsigned)wid * 1024u;
    const int aoff = lds_byte(wr * 64 + fr, fq * 8), boff = lds_byte(wc * 32 + fr, fq * 8);
#define PG8_SA(b, h) (((b) * 2 + (h)) * HTB)
#define PG8_SB(b, h) ((4 + (b) * 2 + (h)) * HTB)
#define PG8_STAGE(bufoff, gbase, voff) do { _Pragma("unroll") for (int _i = 0; _i < 2; ++_i) \
        __builtin_amdgcn_global_load_lds((const unsigned*)((const char*)(gbase) + (voff)[_i]), (PG8_LAS unsigned*)(lds + (bufoff) + ldsw + _i * 8192), 16, 0, 0); } while (0)
#define PG8_LDA(dst, b, h) do { if constexpr (MMODE == 0) { _Pragma("unroll") for (int m = 0; m < 4; ++m) _Pragma("unroll") for (int k = 0; k < 2; ++k) dst[m][k] = *(const PG8_LAS bf16x8*)(lds + PG8_SA(b, h) + aoff + m * 2048 + k * 1024); } \
        else { _Pragma("unroll") for (int m = 0; m < 4; ++m) dst##8[m] = cat8(*(const PG8_LAS bf16x8*)(lds + PG8_SA(b, h) + aoff + m * 2048), *(const PG8_LAS bf16x8*)(lds + PG8_SA(b, h) + aoff + m * 2048 + 1024)); } } while (0)
#define PG8_LDB(dst, b, h) do { if constexpr (MMODE == 0) { _Pragma("unroll") for (int n = 0; n < 2; ++n) _Pragma("unroll") for (int k = 0; k < 2; ++k) dst[n][k] = *(const PG8_LAS bf16x8*)(lds + PG8_SB(b, h) + boff + n * 2048 + k * 1024); } \
        else { _Pragma("unroll") for (int n = 0; n < 2; ++n) dst##8[n] = cat8(*(const PG8_LAS bf16x8*)(lds + PG8_SB(b, h) + boff + n * 2048), *(const PG8_LAS bf16x8*)(lds + PG8_SB(b, h) + boff + n * 2048 + 1024)); } } while (0)
#define PG8_MMA(ai, bj, At, Bt) do { __builtin_amdgcn_s_setprio(1); \
        if constexpr (MMODE == 0) { _Pragma("unroll") for (int m = 0; m < 4; ++m) _Pragma("unroll") for (int n = 0; n < 2; ++n) _Pragma("unroll") for (int k = 0; k < 2; ++k) \
            acc[ai][bj][m][n] = __builtin_amdgcn_mfma_f32_16x16x32_bf16(Bt[n][k], At[m][k], acc[ai][bj][m][n], 0, 0, 0); } \
        else { asm volatile("s_nop 1"); _Pragma("unroll") for (int m = 0; m < 4; ++m) _Pragma("unroll") for (int n = 0; n < 2; ++n) \
            asm volatile("v_mfma_scale_f32_16x16x128_f8f6f4 %0, %1, %2, %0, %3, %3 op_sel_hi:[0,0,0]" : "+v"(acc[ai][bj][m][n]) : "v"(Bt##8[n]), "v"(At##8[m]), "v"(f8one)); } \
        __builtin_amdgcn_s_setprio(0); } while (0)
#define PG8_WAIT_V(n) asm volatile("s_waitcnt vmcnt(" #n ")" ::: "memory")
#define PG8_WAIT_L(n) asm volatile("s_waitcnt lgkmcnt(" #n ")" ::: "memory")
#define PG8_BAR __builtin_amdgcn_s_barrier()
#define PG8_SCHED __builtin_amdgcn_sched_barrier(0)
    Unit cur, nxt; int ui = 0;
    if (!S.next(0, cur)) return;
    f32x4 acc[2][2][4][2];
#pragma unroll
    for (int a = 0; a < 2; ++a)
#pragma unroll
        for (int b = 0; b < 2; ++b)
#pragma unroll
            for (int m = 0; m < 4; ++m)
#pragma unroll
                for (int n = 0; n < 2; ++n) acc[a][b][m][n] = (f32x4){0.f, 0.f, 0.f, 0.f};
    const int f8one = 0x7f7f7f7f;
    bf16x8 At[4][2], B0[2][2], B1[2][2]; i32x8 At8[4], B08[2], B18[2];
    const char* cA = g.a_ptr(cur); const char* cB = g.b_ptr(cur);
    S.a_ready(cur);
    if constexpr (SP2) {
        PG8_STAGE(PG8_SB(0, 0), cB, voffB); PG8_STAGE(PG8_SB(0, 1), cB + hstepB, voffB); PG8_STAGE(PG8_SA(0, 0), cA, voffA); PG8_STAGE(PG8_SA(0, 1), cA + hstepA, voffA);
        if (wr == 1) PG8_BAR;
        PG8_WAIT_V(2); PG8_BAR;
        PG8_STAGE(PG8_SB(1, 0), cB + kstep, voffB); PG8_STAGE(PG8_SA(1, 0), cA + kstep, voffA); PG8_STAGE(PG8_SB(1, 1), cB + hstepB + kstep, voffB);
        PG8_WAIT_V(6); PG8_BAR;
    } else {
        PG8_STAGE(PG8_SB(0, 0), cB, voffB); PG8_STAGE(PG8_SA(0, 0), cA, voffA); PG8_STAGE(PG8_SB(0, 1), cB + hstepB, voffB); PG8_STAGE(PG8_SA(0, 1), cA + hstepA, voffA);
        if (wr == 1) PG8_BAR;
        PG8_WAIT_V(4); PG8_BAR;
        PG8_STAGE(PG8_SB(1, 0), cB + kstep, voffB); PG8_STAGE(PG8_SA(1, 0), cA + kstep, voffA); PG8_STAGE(PG8_SB(1, 1), cB + hstepB + kstep, voffB);
        PG8_WAIT_V(6); PG8_BAR;
    }
    for (;;) {
        const bool has_next = S.next(ui + 1, nxt);
        const char* nA = has_next ? g.a_ptr(nxt) : cA; const char* nB = has_next ? g.b_ptr(nxt) : cB;
        for (int t = 0; t < nt; t += 2) {
            const bool last = (t == nt - 2);
            const char* a1 = cA + (size_t)(t + 1) * kstep;
            const char* a2 = last ? nA : cA + (size_t)(t + 2) * kstep; const char* b2 = last ? nB : cB + (size_t)(t + 2) * kstep;
            const char* a3 = a2 + kstep; const char* b3 = b2 + kstep;
            if (last && has_next) S.a_ready(nxt);
            if constexpr (SP2) {
            PG8_LDB(B0, 0, 0); PG8_LDB(B1, 0, 1); PG8_SCHED; PG8_LDA(At, 0, 0); PG8_STAGE(PG8_SA(1, 1), a1 + hstepA, voffA);
            PG8_WAIT_V(8); PG8_WAIT_L(0); PG8_BAR; PG8_MMA(0, 0, At, B0); PG8_MMA(0, 1, At, B1); PG8_BAR; PG8_SCHED;
            PG8_LDA(At, 0, 1); PG8_STAGE(PG8_SB(0, 0), b2, voffB); PG8_STAGE(PG8_SB(0, 1), b2 + hstepB, voffB); PG8_STAGE(PG8_SA(0, 0), a2, voffA);
            PG8_WAIT_V(8); PG8_WAIT_L(0); PG8_BAR; PG8_MMA(1, 0, At, B0); PG8_MMA(1, 1, At, B1); PG8_BAR; PG8_SCHED;
            PG8_LDB(B0, 1, 0); PG8_LDB(B1, 1, 1); PG8_SCHED; PG8_LDA(At, 1, 0); PG8_STAGE(PG8_SA(0, 1), a2 + hstepA, voffA);
            PG8_WAIT_V(8); PG8_WAIT_L(0); PG8_BAR; PG8_MMA(0, 0, At, B0); PG8_MMA(0, 1, At, B1); PG8_BAR; PG8_SCHED;
            PG8_LDA(At, 1, 1); PG8_STAGE(PG8_SB(1, 0), b3, voffB); PG8_STAGE(PG8_SB(1, 1), b3 + hstepB, voffB); PG8_STAGE(PG8_SA(1, 0), a3, voffA);
            PG8_WAIT_V(8); PG8_WAIT_L(0); PG8_BAR; PG8_MMA(1, 0, At, B0); PG8_MMA(1, 1, At, B1); PG8_BAR; PG8_SCHED;
            } else {
            PG8_LDB(B0, 0, 0); PG8_SCHED; PG8_LDA(At, 0, 0); PG8_STAGE(PG8_SA(1, 1), a1 + hstepA, voffA);
            PG8_WAIT_L(8); PG8_BAR; PG8_WAIT_L(0); PG8_MMA(0, 0, At, B0); PG8_BAR; PG8_SCHED;
            PG8_LDB(B1, 0, 1); PG8_STAGE(PG8_SB(0, 0), b2, voffB);
            PG8_BAR; PG8_WAIT_L(0); PG8_MMA(0, 1, At, B1); PG8_BAR;
            PG8_LDA(At, 0, 1); PG8_STAGE(PG8_SA(0, 0), a2, voffA);
            PG8_BAR; PG8_WAIT_L(0); PG8_MMA(1, 0, At, B0); PG8_BAR; PG8_SCHED;
            PG8_STAGE(PG8_SB(0, 1), b2 + hstepB, voffB);
            PG8_WAIT_V(6); PG8_BAR; PG8_MMA(1, 1, At, B1); PG8_BAR;
            PG8_LDB(B0, 1, 0); PG8_SCHED; PG8_LDA(At, 1, 0); PG8_STAGE(PG8_SA(0, 1), a2 + hstepA, voffA);
            PG8_WAIT_L(8); PG8_BAR; PG8_WAIT_L(0); PG8_MMA(0, 0, At, B0); PG8_BAR; PG8_SCHED;
            PG8_LDB(B1, 1, 1); PG8_STAGE(PG8_SB(1, 0), b3, voffB);
            PG8_BAR; PG8_WAIT_L(0); PG8_MMA(0, 1, At, B1); PG8_BAR;
            PG8_LDA(At, 1, 1); PG8_STAGE(PG8_SA(1, 0), a3, voffA);
            PG8_BAR; PG8_WAIT_L(0); PG8_MMA(1, 0, At, B0); PG8_BAR; PG8_SCHED;
            PG8_STAGE(PG8_SB(1, 1), b3 + hstepB, voffB);
            PG8_WAIT_V(6); PG8_BAR; PG8_MMA(1, 1, At, B1); PG8_BAR;
            }
        }
        if constexpr (MMODE == 1) asm volatile("s_nop 15\n\ts_nop 15" ::: "memory");
        if constexpr (ALIGN_EPI) { if (wr == 0) PG8_BAR; }
        if constexpr (!Epi::AFTER_DRAIN) { E(acc, cur, wr, wc, fr, fq); S.done(cur); }
        if (!has_next) break;
#pragma unroll
        for (int a = 0; a < 2; ++a)
#pragma unroll
            for (int b = 0; b < 2; ++b)
#pragma unroll
                for (int m = 0; m < 4; ++m)
#pragma unroll
                    for (int n = 0; n < 2; ++n) acc[a][b][m][n] = (f32x4){0.f, 0.f, 0.f, 0.f};
        cur = nxt; cA = nA; cB = nB; ++ui;
        if constexpr (ALIGN_EPI) { if (wr == 1) PG8_BAR; }
    }
    PG8_WAIT_V(0);
    if constexpr (!ALIGN_EPI) { if (wr == 0) PG8_BAR; }
    PG8_BAR;
    if constexpr (Epi::AFTER_DRAIN) { E.fused(acc, cur, wr, wc, fr, fq, lds, wid, lane); S.done(cur); }
#undef PG8_SA
#undef PG8_SB
#undef PG8_STAGE
#undef PG8_LDA
#undef PG8_LDB
#undef PG8_MMA
#undef PG8_WAIT_V
#undef PG8_WAIT_L
#undef PG8_BAR
#undef PG8_SCHED
}
}

constexpr int NWAVES = 8;
constexpr int D = 1024, SEQ = 8192, M = 16384;
constexpr int FFN = 2816, EXD = 3584, NEXP = 8;
constexpr int XS_ROWS = 2 * M + NEXP * 256;
constexpr int MAXPAN = XS_ROWS / 256;
constexpr int NPH = 31;

constexpr size_t MiB = 1u << 20;
constexpr size_t WS_CTL = 0, CTL_ZERO_BYTES = 1 * MiB;
constexpr size_t WS_SMALL = 1 * MiB;
constexpr size_t SM_AT = 0;
constexpr size_t SM_TOKE = 64 * 1024;
constexpr size_t SM_TOKW = SM_TOKE + 128 * 1024;
constexpr size_t SM_TOKR = SM_TOKW + 128 * 1024;
constexpr size_t SM_TOKP = SM_TOKR + 128 * 1024;
constexpr size_t SM_RSTD = SM_TOKP + 128 * 1024;
constexpr size_t SM_WGCNT = SM_RSTD + 64 * 1024;
constexpr size_t SM_ROWG = SM_WGCNT + 8 * 1024;
constexpr size_t SM_PANEL = SM_ROWG + 192 * 1024;
constexpr size_t SM_SSQ = 1 * MiB;
constexpr size_t WS_WEIN = 9 * MiB;
constexpr size_t EV_EIN = 0, EV_EOUT = 4 * MiB, EV_E13 = 6 * MiB, EV_E2 = 17 * MiB, EV_STRIDE = 23 * MiB;
constexpr size_t WS_WODD = WS_WEIN + 2 * EV_STRIDE;
constexpr size_t OD_OIN = 0, OD_GLU = 3 * MiB, OD_OOUT = 4 * MiB, OD_SGU = 6 * MiB, OD_WST = 7 * MiB, OD_MY = 15 * MiB, OD_M13 = 35 * MiB, OD_M2 = 147 * MiB, OD_STRIDE = 203 * MiB;
constexpr size_t WS_HB = WS_WODD + 2 * OD_STRIDE;
constexpr size_t WS_ARENA = WS_HB + 32 * MiB;
constexpr size_t AR_UM = 0;
constexpr size_t AR_Z = 0, AR_MIX = 64 * MiB, AR_UF = 96 * MiB;
constexpr size_t AR_AG = 0, AR_SST = 20 * MiB, AR_ZUV = 32 * MiB, AR_GY = 96 * MiB;
constexpr size_t AR_XS = 238 * MiB;
constexpr size_t WS_PART = WS_ARENA + 306 * MiB;
constexpr size_t WS_END = WS_PART + 56 * MiB;
static_assert((size_t)XS_ROWS * EXD * 2 <= 238 * MiB && (size_t)XS_ROWS * D * 2 <= 68 * MiB, "arena");
static_assert(SM_PANEL + 1024 <= SM_SSQ && SM_SSQ + (size_t)M * 16 * 4 <= 8 * MiB, "small tables");
constexpr int CW_TMO = 0;
constexpr int CW_BAR = 4096;
constexpr int CW_QUEUE = 64;

constexpr int RING_OFF = 0, RING_BYTES = 131072;
constexpr int LDSCTL_OFF = RING_BYTES, MISC_OFF = LDSCTL_OFF + 320;
constexpr int PTAB_OFF = LDSCTL_OFF + 1024;
constexpr int RST_OFF = LDSCTL_OFF + 2048;
constexpr int RST_UNITS = 6;
constexpr int LDS_BYTES = 147456;

#define GAS __attribute__((address_space(1)))
#define LAS __attribute__((address_space(3)))
typedef unsigned short bf16;
typedef unsigned v4u __attribute__((ext_vector_type(4)));
typedef unsigned v2u __attribute__((ext_vector_type(2)));
typedef float f32x4 __attribute__((ext_vector_type(4)));
typedef short bf16x8 __attribute__((ext_vector_type(8)));
#define RLX_AGENT __ATOMIC_RELAXED, __HIP_MEMORY_SCOPE_AGENT
#define LDS_WAIT() asm volatile("s_waitcnt lgkmcnt(0)" ::: "memory")
#define VM_WAIT() asm volatile("s_waitcnt vmcnt(0)" ::: "memory")
__device__ __forceinline__ unsigned f2bf(float f) { unsigned u = __builtin_bit_cast(unsigned, f); return (u + 0x7fffu + ((u >> 16) & 1u)) >> 16; }
__device__ __forceinline__ unsigned pk2(float lo, float hi) { return f2bf(lo) | (f2bf(hi) << 16); }
__device__ __forceinline__ float bflo(unsigned w) { return __uint_as_float(w << 16); }
__device__ __forceinline__ float bfhi(unsigned w) { return __uint_as_float(w & 0xffff0000u); }

#define XB_TMO      128
#define XB_XCNT(j)  (256  + 64 * (j))
#define XB_XSUB(j)  (1280 + 64 * (j))
#define XB_XGEN(j)  (2304 + 64 * (j))
#define XB_TOP      3328
#define XB_TOPGEN   3392
#define XCD_BAR_WORDS 3456
#define XB_SPIN_CAP (1u << 22)

__device__ __forceinline__ unsigned xb_ld(unsigned* p)              { return __hip_atomic_load(p, __ATOMIC_RELAXED, __HIP_MEMORY_SCOPE_AGENT); }
__device__ __forceinline__ unsigned xb_add(unsigned* p, unsigned v) { return __hip_atomic_fetch_add(p, v, __ATOMIC_RELAXED, __HIP_MEMORY_SCOPE_AGENT); }
__device__ __forceinline__ unsigned xb_xcc_id() { return (unsigned)__builtin_amdgcn_s_getreg((3 << 11) | 20) & 0xFu; }
#define XB_SPIN(cond, bar) do { unsigned _sp = 0; while (cond) { __builtin_amdgcn_s_sleep(1); \
    if ((++_sp & 255u) == 0u) { if (xb_ld(&(bar)[XB_TMO])) break; if (_sp > XB_SPIN_CAP) { atomicAdd(&(bar)[XB_TMO], 1u); break; } } } } while (0)

struct XcdBarrier { unsigned* bar; unsigned x; volatile LAS unsigned* st; };

__device__ __forceinline__ XcdBarrier xcd_barrier_post(unsigned* bar, volatile LAS unsigned* st) {
    XcdBarrier b; b.bar = bar; b.x = xb_xcc_id(); b.st = st;
    if (threadIdx.x == 0) (void)xb_add(&bar[XB_XCNT(b.x)], 1u);
    return b;
}
__device__ __forceinline__ void xcd_barrier_complete(unsigned* bar, unsigned x, unsigned& nloc, unsigned& nx) {
    const unsigned G = gridDim.x * gridDim.y * gridDim.z;
    unsigned sum, cnt, mine, sp = 0u;
    for (;;) {
        sum = 0u; cnt = 0u; mine = 0u;
#pragma unroll
        for (unsigned j = 0; j < 16; ++j) { const unsigned c = xb_ld(&bar[XB_XCNT(j)]); sum += c; cnt += (c > 0u) ? 1u : 0u; mine = (j == x) ? c : mine; }
        if (sum == G) break;
        __builtin_amdgcn_s_sleep(1);
        if ((++sp & 255u) == 0u) { if (xb_ld(&bar[XB_TMO])) break; if (sp > XB_SPIN_CAP) { atomicAdd(&bar[XB_TMO], 1u); break; } }
    }
    nloc = mine > 0u ? mine : 1u; nx = cnt > 0u ? cnt : 1u;
}
__device__ __forceinline__ void xcd_barrier(const XcdBarrier& b, const int wave_idx) {
    asm volatile("s_waitcnt vmcnt(0)" ::: "memory");
    __syncthreads();
    unsigned lane_b_; asm volatile("v_mbcnt_lo_u32_b32 %0, -1, 0\n\tv_mbcnt_hi_u32_b32 %0, -1, %0" : "=v"(lane_b_));
    if (wave_idx == 0 && lane_b_ == 0u) {
        unsigned* bar = b.bar;
        __builtin_amdgcn_s_waitcnt(0);
        unsigned nloc = b.st[0], nx = b.st[1];
        if (nloc == 0u) { xcd_barrier_complete(bar, b.x, nloc, nx); b.st[0] = nloc; b.st[1] = nx; }
        const unsigned old = xb_add(&bar[XB_XSUB(b.x)], 1u);
        const unsigned gen = old / nloc;
        if (old + 1u == (gen + 1u) * nloc) {
            __builtin_amdgcn_fence(__ATOMIC_RELEASE, "agent");
            asm volatile("s_waitcnt vmcnt(0)" ::: "memory");
            const unsigned og = xb_add(&bar[XB_TOP], 1u);
            const unsigned tg = og / nx;
            if (og + 1u == (tg + 1u) * nx) xb_add(&bar[XB_TOPGEN], 1u);
            else XB_SPIN(xb_ld(&bar[XB_TOPGEN]) == tg, bar);
            __builtin_amdgcn_fence(__ATOMIC_ACQUIRE, "agent");
            xb_add(&bar[XB_XGEN(b.x)], 1u);
            asm volatile("s_waitcnt vmcnt(0)" ::: "memory");
        } else {
            XB_SPIN(xb_ld(&bar[XB_XGEN(b.x)]) == gen, bar);
            __builtin_amdgcn_fence(__ATOMIC_ACQUIRE, "agent");
            asm volatile("s_waitcnt vmcnt(0)" ::: "memory");
        }
    }
    __syncthreads();
}

__device__ __forceinline__ float wave_sum(float v) {
#pragma unroll
    for (int o = 1; o < 64; o <<= 1) v += __shfl_xor(v, o);
    return v;
}
struct TTile { const float* src; const float* gain; unsigned char* dst; int ldw, ldo_b; float f8sc; };
__device__ __forceinline__ void sincos_turns(double turns, float& c, float& s) {
    const double fr = turns - __builtin_rint(turns);
    const float x = (float)fr * 6.283185307179586f;
    c = cosf(x); s = sinf(x);
}

#ifndef REP_P0
#define REP_P0 1
#endif
#ifndef REP_E2
#define REP_E2 1
#endif
#ifndef REP_SGU
#define REP_SGU 1
#endif
#ifndef REP_ROUTE
#define REP_ROUTE 1
#endif
#ifndef REP_BAR
#define REP_BAR 1
#endif
struct Args { const float* in[33]; float* out; unsigned char* ws; int ph_lo, ph_hi; };

__device__ __forceinline__ const float* in_ptr(int k) {
    const __attribute__((address_space(4))) char* ka = (const __attribute__((address_space(4))) char*)__builtin_amdgcn_kernarg_segment_ptr();
    int off = k * 8; asm volatile("" : "+s"(off));
    return *(const float* const __attribute__((address_space(4)))*)(ka + off);
}
#define INP(k) in_ptr(k)
#ifndef F8_LAST
#define F8_LAST 1
#endif
#ifndef F8_FROM
#define F8_FROM 0
#endif
#ifndef F8_FFN_FROM
#define F8_FFN_FROM 1
#endif
constexpr float F8_W13_SC = 32.f, F8_W2_SC = 64.f, F8_UM_SC = 16.f;
constexpr int TT_EV = 688, TT_OD = 5552, TT_LAYER = TT_EV + TT_OD, TT_EXP = 672, TT_TOTAL = 2 * TT_LAYER;
__device__ __forceinline__ TTile decode_tile(const Args& args, unsigned char* ws, int it) {
    const int li = it / TT_LAYER; int r = it % TT_LAYER;
    const float* W; const float* gain = nullptr; int ldw, nbn, ldo, mode = 0; unsigned char* WT; float f8sc = 0.f; int esz = 2;
    if (r < TT_EV) {
        unsigned char* wb = ws + WS_WEIN + li * EV_STRIDE;
        if (r < 96) { W = args.in[2] + (size_t)li * D * 2048; ldw = 2048; nbn = 12; gain = args.in[1] + li * D; WT = wb + EV_EIN; ldo = D; }
        else if (r < 160) { r -= 96; W = args.in[6] + (size_t)li * D * D; ldw = D; nbn = 8; WT = wb + EV_EOUT; ldo = D; }
        else if (r < 336) { r -= 160; W = args.in[8] + (size_t)li * D * FFN; ldw = FFN; nbn = 22; gain = args.in[7] + li * D; WT = wb + EV_E13; ldo = D; mode = 1; if (F8_LAST && li >= F8_FFN_FROM) { esz = 1; f8sc = F8_W13_SC; } }
        else if (r < 512) { r -= 336; W = args.in[9] + (size_t)li * D * FFN; ldw = FFN; nbn = 22; gain = args.in[7] + li * D; WT = wb + EV_E13; ldo = D; mode = 2; if (F8_LAST && li >= F8_FFN_FROM) { esz = 1; f8sc = F8_W13_SC; } }
        else { r -= 512; W = args.in[10] + (size_t)li * FFN * D; ldw = D; nbn = 8; WT = wb + EV_E2; ldo = FFN; if (F8_LAST && li >= F8_FFN_FROM) { esz = 1; f8sc = F8_W2_SC; } }
    } else {
        r -= TT_EV; unsigned char* wb = ws + WS_WODD + li * OD_STRIDE;
        if (r < 96) { W = args.in[12] + (size_t)li * D * 1536; ldw = 1536; nbn = 12; gain = args.in[11] + li * D; WT = wb + OD_OIN; ldo = D; }
        else if (r < 112) { r -= 96; W = args.in[21] + (size_t)li * 512 * 512; ldw = 512; nbn = 4; WT = wb + OD_GLU; ldo = 512; }
        else if (r < 176) { r -= 112; W = args.in[26] + (size_t)li * D * D; ldw = D; nbn = 8; WT = wb + OD_OOUT; ldo = D; }
        else { r -= 176; const int e = r / TT_EXP; r %= TT_EXP; const bool f8 = F8_LAST && li >= F8_FROM; if (f8) esz = 1;
            if (r < 224) { W = args.in[29] + ((size_t)li * NEXP + e) * D * EXD; ldw = EXD; nbn = 28; gain = args.in[27] + li * D; WT = wb + OD_M13 + (size_t)e * 2 * EXD * D * esz; ldo = D; mode = 1; if (f8) f8sc = F8_W13_SC; }
            else if (r < 448) { r -= 224; W = args.in[30] + ((size_t)li * NEXP + e) * D * EXD; ldw = EXD; nbn = 28; gain = args.in[27] + li * D; WT = wb + OD_M13 + (size_t)e * 2 * EXD * D * esz; ldo = D; mode = 2; if (f8) f8sc = F8_W13_SC; }
            else { r -= 448; W = args.in[31] + ((size_t)li * NEXP + e) * EXD * D; ldw = D; nbn = 8; WT = wb + OD_M2 + (size_t)e * D * EXD * esz; ldo = EXD; if (f8) f8sc = F8_W2_SC; } }
    }
    const int kb = r / nbn, nb = r % nbn, k0 = 128 * kb, n0 = 128 * nb;
    const size_t orow0 = mode == 0 ? (size_t)n0 : (size_t)(nb * 256 + (mode == 2 ? 128 : 0));
    TTile d; d.src = W + (size_t)k0 * ldw + n0; d.gain = gain ? gain + k0 : nullptr; d.ldw = ldw; d.f8sc = f8sc;
    d.dst = WT + (orow0 * ldo + k0) * esz; d.ldo_b = ldo * esz; return d;
}

__global__ void __launch_bounds__(NWAVES * 64, 2) trunk_fwd(Args args) {
    extern __shared__ __attribute__((aligned(16))) unsigned char lds_raw[];
    LAS unsigned char* lds = (LAS unsigned char*)lds_raw;
    volatile LAS unsigned* MISC = (volatile LAS unsigned*)(lds + MISC_OFF);
    const int G = gridDim.x, bx = blockIdx.x;
#define G_O ({ int g_ = G; asm volatile("" : "+s"(g_)); g_; })
#define BX_O ({ int b_ = bx; asm volatile("" : "+s"(b_)); b_; })
    const int wave_s = __builtin_amdgcn_readfirstlane((int)threadIdx.x >> 6);
#define PHASE_IDS int lane_o_; asm volatile("v_mbcnt_lo_u32_b32 %0, -1, 0\n\tv_mbcnt_hi_u32_b32 %0, -1, %0" : "=v"(lane_o_)); const int lane = lane_o_, wave = wave_s, tid = wave * 64 + lane; (void)tid;
#define P_ws ({ unsigned char* w_ = args.ws; asm volatile("" : "+s"(w_)); w_; })
#define P_ctl ((unsigned*)(P_ws + WS_CTL))
#define P_sm (P_ws + WS_SMALL)
#define P_SSQ ((float*)(P_ws + WS_SMALL + SM_SSQ))
#define P_HB ((bf16*)(P_ws + WS_HB))
#define P_arena (P_ws + WS_ARENA)
#define P_H ({ float* h_ = args.out; asm volatile("" : "+s"(h_)); h_; })
#define P_x_in INP(0)
#define P_wev (P_ws + WS_WEIN + lp * EV_STRIDE)
#define P_wod (P_ws + WS_WODD + lp * OD_STRIDE)
#define P_Z ((bf16*)(P_arena + AR_Z))
#define P_MIX ((bf16*)(P_arena + AR_MIX))
#define P_UF ((bf16*)(P_arena + AR_UF))
#define P_AG ((bf16*)(P_arena + AR_AG))
#define P_ZUV ((bf16*)(P_arena + AR_ZUV))
#define P_GY ((bf16*)(P_arena + AR_GY))
#define P_XS ((bf16*)(P_arena + AR_XS))
#define P_UM ((bf16*)(P_arena + AR_UM))
#define P_TOKE ((int*)(P_sm + SM_TOKE))
#define P_TOKW ((float*)(P_sm + SM_TOKW))
#define P_TOKR ((int*)(P_sm + SM_TOKR))
#define P_TOKP ((int*)(P_sm + SM_TOKP))
#define P_RSTD ((float*)(P_sm + SM_RSTD))
#define P_WGCNT ((int*)(P_sm + SM_WGCNT))
#define P_PANEL ((int*)(P_sm + SM_PANEL))

    for (int u = threadIdx.x; u < (LDS_BYTES - LDSCTL_OFF) / 4; u += NWAVES * 64) ((LAS unsigned*)(lds + LDSCTL_OFF))[u] = 0u;
    __syncthreads();
    (void)xcd_barrier_post(P_ctl + CW_BAR, MISC + 8);
    const int lo = args.ph_lo, hi = args.ph_hi;
#define IN(k) (lo <= (k) && (k) < hi)
#define RST_PREAMBLE(S) do { PHASE_IDS LAS float* rst_ = (LAS float*)(lds + RST_OFF); pg8::Unit u_; \
        for (int i_ = 0; i_ < RST_UNITS && (S).next(i_, u_); ++i_) { const int row_ = u_.pm * 256 + (tid >> 1); \
            const f32x4 a_ = *(const f32x4*)(P_SSQ + (size_t)row_ * 16 + (tid & 1) * 8), b_ = *(const f32x4*)(P_SSQ + (size_t)row_ * 16 + (tid & 1) * 8 + 4); \
            float s_ = ((a_[0] + a_[1]) + (a_[2] + a_[3])) + ((b_[0] + b_[1]) + (b_[2] + b_[3])); s_ += __shfl_xor(s_, 1); \
            if ((tid & 1) == 0) rst_[i_ * 256 + (tid >> 1)] = 1.0f / sqrtf(s_ * (1.0f / 1024.0f) + 1e-5f); } \
        __syncthreads(); } while (0)
#define SEAM(k) do { if (IN(k) && IN((k) + 1)) { for (int rb_ = 0; rb_ < REP_BAR; ++rb_) { XcdBarrier bar_; bar_.bar = P_ctl + CW_BAR; bar_.x = xb_xcc_id(); bar_.st = (volatile LAS unsigned*)(lds + MISC_OFF) + 8; xcd_barrier(bar_, wave_s); } } } while (0)

    for (int rep_ = 0; rep_ < REP_P0; ++rep_)
    if (IN(0)) {
        PHASE_IDS
        LAS float* scr = (LAS float*)(lds + RING_OFF + wave * 16384);
        const int gw = bx * NWAVES + wave, NGW = G * NWAVES;
        for (int task = bx; task < 64; task += G) {
            const int li = task >> 5, g = task & 31;
            LAS float* PWr = (LAS float*)(lds + RING_OFF);
            LAS float* PWi = PWr + 33 * 64;
            LAS float* BBr = PWi + 33 * 64;
            LAS float* BBi = BBr + 1024;
            LAS float* CRe = BBi + 1024;
            LAS float* CIm = CRe + 1024;
            LAS float* KT = CIm + 1024;
            __syncthreads();
            if (tid < 64) {
                const int p = tid; const int gp = (li * 32 + g) * 64 + p;
                const float lr = args.in[13][gp], lim = args.in[14][gp], dt = expf(args.in[15][li * 32 + g]);
                const float rho = lr * dt; const double td = (double)lim * (double)dt * 0.15915494309189535;
                for (int tau = 0; tau <= 32; ++tau) { float c, s; sincos_turns(td * (double)tau, c, s); const float mg = expf(rho * (float)tau); PWr[tau * 64 + p] = mg * c; PWi[tau * 64 + p] = mg * s; }
                float c1, s1, ch, sh; sincos_turns(td, c1, s1); sincos_turns(td * 0.5, ch, sh);
                const float mg = expf(rho), qr = expm1f(rho) * c1 - 2.0f * sh * sh, qi = mg * s1, den = lr * lr + lim * lim;
                const float fre = (qr * lr + qi * lim) / den, fim = (qi * lr - qr * lim) / den;
                for (int h = 0; h < 16; ++h) { const float br = args.in[16][(size_t)gp * 16 + h], bi = args.in[17][(size_t)gp * 16 + h]; BBr[p * 16 + h] = fre * br - fim * bi; BBi[p * 16 + h] = fre * bi + fim * br; }
                float* AT = (float*)(P_sm + SM_AT) + (size_t)gp * 2; AT[0] = PWr[32 * 64 + p]; AT[1] = PWi[32 * 64 + p];
            }
            for (int e = tid; e < 1024; e += 512) { CRe[e] = args.in[18][(size_t)(li * 32 + g) * 1024 + e]; CIm[e] = args.in[19][(size_t)(li * 32 + g) * 1024 + e]; }
            __syncthreads();
            for (int r = 0; r < 16; ++r) { const int o = tid + 512 * r, tau = o >> 8, hp = (o >> 4) & 15, h = o & 15; float a = 0.f;
                for (int p = 0; p < 64; ++p) { const float cr = CRe[hp * 64 + p], ci = CIm[hp * 64 + p], wr_ = PWr[tau * 64 + p], wi_ = PWi[tau * 64 + p];
                    const float car = cr * wr_ - ci * wi_, cai = cr * wi_ + ci * wr_; a += car * BBr[p * 16 + h] - cai * BBi[p * 16 + h]; }
                KT[o] = a; }
            __syncthreads();
            bf16* MY = (bf16*)(P_ws + WS_WODD + li * OD_STRIDE + OD_MY) + (size_t)g * 512 * 640;
            for (int r = 0; r < 80; ++r) { const int q = tid + 512 * r, n = q / 80, k0 = (q % 80) * 8, j = n >> 4, hp = n & 15; float v[8];
                if (k0 < 64) {
#pragma unroll
                    for (int e = 0; e < 8; ++e) { const int p = k0 + e; v[e] = CRe[hp * 64 + p] * PWr[(j + 1) * 64 + p] - CIm[hp * 64 + p] * PWi[(j + 1) * 64 + p]; }
                } else if (k0 < 128) {
#pragma unroll
                    for (int e = 0; e < 8; ++e) { const int p = k0 - 64 + e; v[e] = -(CRe[hp * 64 + p] * PWi[(j + 1) * 64 + p] + CIm[hp * 64 + p] * PWr[(j + 1) * 64 + p]); }
                } else { const int s = (k0 - 128) >> 4, h0 = (k0 - 128) & 15;
#pragma unroll
                    for (int e = 0; e < 8; ++e) v[e] = (s <= j) ? KT[(j - s) * 256 + hp * 16 + h0 + e] : 0.f; }
                v4u o; o.x = pk2(v[0], v[1]); o.y = pk2(v[2], v[3]); o.z = pk2(v[4], v[5]); o.w = pk2(v[6], v[7]);
                *(GAS v4u*)(MY + (size_t)n * 640 + k0) = o; }
            bf16* WST = (bf16*)(P_ws + WS_WODD + li * OD_STRIDE + OD_WST) + (size_t)g * 256 * 512;
            for (int r = 0; r < 32; ++r) { const int q = tid + 512 * r, n = q >> 6, k0 = (q & 63) * 8, s = k0 >> 4, h0 = k0 & 15; float v[8];
                if (n < 64) {
#pragma unroll
                    for (int e = 0; e < 8; ++e) v[e] = PWr[(31 - s) * 64 + n] * BBr[n * 16 + h0 + e] - PWi[(31 - s) * 64 + n] * BBi[n * 16 + h0 + e];
                } else if (n < 128) { const int p = n - 64;
#pragma unroll
                    for (int e = 0; e < 8; ++e) v[e] = PWr[(31 - s) * 64 + p] * BBi[p * 16 + h0 + e] + PWi[(31 - s) * 64 + p] * BBr[p * 16 + h0 + e];
                } else {
#pragma unroll
                    for (int e = 0; e < 8; ++e) v[e] = 0.f; }
                v4u o; o.x = pk2(v[0], v[1]); o.y = pk2(v[2], v[3]); o.z = pk2(v[4], v[5]); o.w = pk2(v[6], v[7]);
                *(GAS v4u*)(WST + (size_t)n * 512 + k0) = o; }
            __syncthreads();
        }
        for (int it = gw; it < 2 * 256; it += NGW) {
            const int li = it >> 8, r = it & 255, kb = r >> 4, gi = (r >> 2) & 3, db = r & 3, k = kb * 64 + lane;
            const float* wrow = args.in[2] + ((size_t)li * D + k) * 2048 + 1536 + gi * 128;
            const float* pw = args.in[4] + ((size_t)li * 4 + gi) * 128 * 128 + db * 32;
            float a[32];
#pragma unroll
            for (int d = 0; d < 32; ++d) a[d] = 0.f;
            for (int c4 = 0; c4 < 32; ++c4) { const f32x4 xv = *(const f32x4*)(wrow + c4 * 4);
#pragma unroll
                for (int cc = 0; cc < 4; ++cc) { const float xs = xv[cc]; const float* pr = pw + (size_t)(c4 * 4 + cc) * 128;
#pragma unroll
                    for (int d = 0; d < 32; ++d) a[d] += xs * pr[d]; } }
            const float gk = args.in[1][li * D + k];
            bf16* WT = (bf16*)(P_ws + WS_WEIN + li * EV_STRIDE + EV_EIN);
#pragma unroll
            for (int d = 0; d < 32; ++d) { const int n = gi * 128 + db * 32 + d; WT[(size_t)(1536 + n) * D + k] = (bf16)f2bf(a[d] * gk * args.in[5][li * 512 + n]); }
        }
        for (int q = bx * 512 + tid; q < 2 * 4 * 128 * 16; q += G * 512) {
            const int li = q >> 13, rem = q & 8191, hh = rem >> 11, i = (rem >> 4) & 127, j0 = (rem & 15) * 8;
            const float* src = args.in[24] + (((size_t)li * 4 + hh) * 128 + i) * 128 + j0;
            const f32x4 a = *(const f32x4*)src, b = *(const f32x4*)(src + 4);
            const bool keep = (j0 >> 6) <= (i >> 6);
            v4u o; o.x = keep ? pk2(a[0], a[1]) : 0u; o.y = keep ? pk2(a[2], a[3]) : 0u; o.z = keep ? pk2(b[0], b[1]) : 0u; o.w = keep ? pk2(b[2], b[3]) : 0u;
            *(GAS v4u*)((bf16*)(P_ws + WS_WODD + li * OD_STRIDE + OD_SGU) + ((size_t)hh * 128 + i) * 128 + j0) = o;
        }
        for (int m = gw; m < M; m += NGW) {
            const GAS f32x4* xr = (const GAS f32x4*)(args.in[0] + (size_t)m * D) + lane; f32x4 v[4]; float s = 0.f;
#pragma unroll
            for (int j = 0; j < 4; ++j) { v[j] = xr[64 * j]; s += (v[j].x * v[j].x + v[j].y * v[j].y) + (v[j].z * v[j].z + v[j].w * v[j].w); }
            s = wave_sum(s);
            GAS v2u* o8 = (GAS v2u*)(P_HB + (size_t)m * D) + lane;
#pragma unroll
            for (int j = 0; j < 4; ++j) { v2u w; w.x = pk2(v[j].x, v[j].y); w.y = pk2(v[j].z, v[j].w); o8[64 * j] = w; }
            if (lane < 16) P_SSQ[(size_t)m * 16 + lane] = lane == 0 ? s : 0.f;
        }
        {
            LAS float* tile = (LAS float*)(lds + RING_OFF); volatile LAS int* nxt = (volatile LAS int*)(lds + RING_OFF + 65536);
            unsigned* qctr = P_ctl + CW_QUEUE; int it = bx;
            const int lr = lane >> 5, nc4 = (lane & 31) * 4;
            const int cch = lane & 15, nro = lane >> 4;
#define TT_LOAD(RG, DD) do { _Pragma("unroll") for (int i = 0; i < 8; ++i) RG[i] = *(const f32x4*)((DD).src + (size_t)(wave * 16 + 2 * i + lr) * (DD).ldw + nc4); } while (0)
#define TT_STEP(RG, DD, ITC) do { \
                __syncthreads();                                                \
                _Pragma("unroll") for (int i = 0; i < 8; ++i) { const int k = wave * 16 + 2 * i + lr; *(LAS f32x4*)(tile + k * 128 + (nc4 ^ (((k >> 3) & 7) << 2))) = RG[i]; } \
                if (tid == 0) { nxt[0] = tk; tk = 2 * G + (int)__hip_atomic_fetch_add(qctr, 1u, RLX_AGENT); }     \
                __syncthreads(); \
                const int itn_ = nxt[0]; const TTile dc_ = DD; DD = decode_tile(args, P_ws, itn_ < TT_TOTAL ? itn_ : 0); \
                if (itn_ < TT_TOTAL) TT_LOAD(RG, DD); \
                f32x4 g0 = {1.f, 1.f, 1.f, 1.f}, g1 = {1.f, 1.f, 1.f, 1.f}; \
                if (dc_.gain) { g0 = *(const f32x4*)(dc_.gain + 8 * cch); g1 = *(const f32x4*)(dc_.gain + 8 * cch + 4); } \
                _Pragma("unroll") for (int i = 0; i < 4; ++i) { const int n = wave * 16 + i * 4 + nro; const int sw = n ^ ((cch & 7) << 2); const LAS float* s = tile + (8 * cch) * 128 + sw; \
                    const float e0 = s[0 * 128] * g0[0], e1 = s[1 * 128] * g0[1], e2 = s[2 * 128] * g0[2], e3 = s[3 * 128] * g0[3], e4 = s[4 * 128] * g1[0], e5 = s[5 * 128] * g1[1], e6 = s[6 * 128] * g1[2], e7 = s[7 * 128] * g1[3]; \
                    if (dc_.f8sc != 0.f) { const float q = dc_.f8sc; v2u o; o.x = pg8::pk4_fp8(e0 * q, e1 * q, e2 * q, e3 * q); o.y = pg8::pk4_fp8(e4 * q, e5 * q, e6 * q, e7 * q); \
                        *(GAS v2u*)(dc_.dst + (size_t)n * dc_.ldo_b + 8 * cch) = o; } \
                    else { v4u o; o.x = pk2(e0, e1); o.y = pk2(e2, e3); o.z = pk2(e4, e5); o.w = pk2(e6, e7); \
                        *(GAS v4u*)(dc_.dst + (size_t)n * dc_.ldo_b + 16 * cch) = o; } } \
                ITC = itn_; } while (0)
            int tk = 0; if (tid == 0) tk = 2 * G + (int)__hip_atomic_fetch_add(qctr, 1u, RLX_AGENT);
            f32x4 rgA[8], rgB[8]; int itA = bx, itB = bx + G;
            TTile dA = decode_tile(args, P_ws, itA < TT_TOTAL ? itA : 0), dB = decode_tile(args, P_ws, itB < TT_TOTAL ? itB : 0);
            if (itA < TT_TOTAL) TT_LOAD(rgA, dA);
            if (itB < TT_TOTAL) TT_LOAD(rgB, dB);
            for (;;) {
                if (itA < TT_TOTAL) TT_STEP(rgA, dA, itA);
                if (itB < TT_TOTAL) TT_STEP(rgB, dB, itB);
                if (itA >= TT_TOTAL && itB >= TT_TOTAL) break;
            }
#undef TT_LOAD
#undef TT_STEP
            __syncthreads();
        }
    }
    SEAM(0);

    for (int lp = 0; lp < 2; ++lp) {
        const int pb = 1 + lp * 15;
        if (IN(pb + 0)) {
            pg8::GDs g{P_HB, (const bf16*)(P_wev + EV_EIN), D, D, D, 30, 0}; pg8::Order S; S.init(M / 256, 2048 / 256, G_O, BX_O);
            RST_PREAMBLE(S);
            pg8::EpiScaleBf16 E{P_Z, 2048, (const LAS float*)(lds + RST_OFF)};
            pg8::gemm_phase<pg8::EpiScaleBf16, pg8::Order, pg8::GDs>(lds + RING_OFF, g, S, E, wave_s);
        }
        SEAM(pb + 0);
        for (int rep_ = 0; rep_ < REP_E2; ++rep_)
        if (IN(pb + 1)) {
            PHASE_IDS
            const float* cw = INP(3) + (size_t)lp * 3 * 512;
            const int cv = tid & 63, c0 = 8 * cv;
            f32x4 cwv[3][2];
#pragma unroll
            for (int k = 0; k < 3; ++k) { cwv[k][0] = *(const f32x4*)(cw + (2 - k) * 512 + c0); cwv[k][1] = *(const f32x4*)(cw + (2 - k) * 512 + c0 + 4); }
            const int gi = wave & 3;
            for (int vb = bx; vb < 256; vb += G) {
                for (int itx = 0; itx < 8; ++itx) {
                    const int tc = vb * 64 + itx * 8 + (tid >> 6), lc = tc & (SEQ - 1);
                    const bf16* zr = P_Z + (size_t)tc * 2048 + c0; const bool v1 = lc >= 1, v2 = lc >= 2;
                    const bf16* zr1 = v1 ? zr - 2048 : zr; const bf16* zr2 = v2 ? zr - 4096 : zr;
                    const v4u gb = *(const GAS v4u*)(zr), gc0 = *(const GAS v4u*)(zr + 512), xa0 = *(const GAS v4u*)(zr + 1024);
                    const v4u gc1 = *(const GAS v4u*)(zr1 + 512), xa1 = *(const GAS v4u*)(zr1 + 1024), gc2 = *(const GAS v4u*)(zr2 + 512), xa2 = *(const GAS v4u*)(zr2 + 1024);
                    const int t = vb * 64 + itx * 8 + 4 * (wave >> 2) + (lane >> 4), l = t & (SEQ - 1), pc0 = gi * 128 + 8 * (lane & 15);
                    const bf16* qr = P_Z + (size_t)t * 2048 + 1536 + pc0; float s[8];
#pragma unroll
                    for (int e = 0; e < 8; ++e) s[e] = 0.f;
                    v4u q0;
#define POOLW(WN) { v4u q[WN]; _Pragma("unroll") for (int k = 0; k < WN; ++k) q[k] = *(const GAS v4u*)(k <= l ? qr - (size_t)k * 2048 : qr); q0 = q[0]; \
                        _Pragma("unroll") for (int k = 0; k < WN; ++k) { const float mk = k <= l ? 1.f : 0.f; s[0] += mk * bflo(q[k].x); s[1] += mk * bfhi(q[k].x); s[2] += mk * bflo(q[k].y); s[3] += mk * bfhi(q[k].y); \
                            s[4] += mk * bflo(q[k].z); s[5] += mk * bfhi(q[k].z); s[6] += mk * bflo(q[k].w); s[7] += mk * bfhi(q[k].w); } }
                    if (gi == 0) POOLW(2) else if (gi == 1) POOLW(4) else if (gi == 2) POOLW(8) else POOLW(16)
#undef POOLW
                    {
                        const float m1 = v1 ? 1.f : 0.f, m2 = v2 ? 1.f : 0.f; float o[8];
#define CONV1(e, G0, X0, G1, X1, G2, X2, W) o[e] = cwv[0][(e) >> 2][(e) & 3] * W(G0) * W(X0) + m1 * cwv[1][(e) >> 2][(e) & 3] * W(G1) * W(X1) + m2 * cwv[2][(e) >> 2][(e) & 3] * W(G2) * W(X2)
                        CONV1(0, gc0.x, xa0.x, gc1.x, xa1.x, gc2.x, xa2.x, bflo); CONV1(1, gc0.x, xa0.x, gc1.x, xa1.x, gc2.x, xa2.x, bfhi);
                        CONV1(2, gc0.y, xa0.y, gc1.y, xa1.y, gc2.y, xa2.y, bflo); CONV1(3, gc0.y, xa0.y, gc1.y, xa1.y, gc2.y, xa2.y, bfhi);
                        CONV1(4, gc0.z, xa0.z, gc1.z, xa1.z, gc2.z, xa2.z, bflo); CONV1(5, gc0.z, xa0.z, gc1.z, xa1.z, gc2.z, xa2.z, bfhi);
                        CONV1(6, gc0.w, xa0.w, gc1.w, xa1.w, gc2.w, xa2.w, bflo); CONV1(7, gc0.w, xa0.w, gc1.w, xa1.w, gc2.w, xa2.w, bfhi);
#undef CONV1
                        v4u ov; ov.x = pk2(bflo(gb.x) * o[0], bfhi(gb.x) * o[1]); ov.y = pk2(bflo(gb.y) * o[2], bfhi(gb.y) * o[3]); ov.z = pk2(bflo(gb.z) * o[4], bfhi(gb.z) * o[5]); ov.w = pk2(bflo(gb.w) * o[6], bfhi(gb.w) * o[7]);
                        *(GAS v4u*)(P_MIX + (size_t)tc * 1024 + c0) = ov;
                    }
                    {
                        const int w = 2 << gi, cnt = (l + 1) < w ? (l + 1) : w; const float inv = 1.0f / (float)cnt;
                        v4u ov; ov.x = pk2(s[0] * inv - bflo(q0.x), s[1] * inv - bfhi(q0.x)); ov.y = pk2(s[2] * inv - bflo(q0.y), s[3] * inv - bfhi(q0.y));
                        ov.z = pk2(s[4] * inv - bflo(q0.z), s[5] * inv - bfhi(q0.z)); ov.w = pk2(s[6] * inv - bflo(q0.w), s[7] * inv - bfhi(q0.w));
                        *(GAS v4u*)(P_MIX + (size_t)t * 1024 + 512 + pc0) = ov;
                    }
                }
            }
        }
        SEAM(pb + 1);
        const bool ffn8 = F8_LAST && lp >= F8_FFN_FROM;
        if (IN(pb + 2)) {
            pg8::GDs g{P_MIX, (const bf16*)(P_wev + EV_EOUT), D, D, D, 30, 0}; pg8::Order S; S.init(M / 256, D / 256, G_O, BX_O);
            pg8::EpiResid<false> E{lp == 0 ? P_x_in : (const float*)P_H, P_H, P_HB, P_SSQ, 1.0f, ffn8 ? (unsigned char*)P_Z : nullptr};
            pg8::gemm_phase<pg8::EpiResid<false>, pg8::Order, pg8::GDs>(lds + RING_OFF, g, S, E, wave_s);
        }
        SEAM(pb + 2);
        if (IN(pb + 3)) {
            pg8::Order S; S.init(M / 256, FFN / 128, G_O, BX_O);
            RST_PREAMBLE(S);
            if (ffn8) {
                pg8::GDs g{P_Z, (const bf16*)(P_wev + EV_E13), D / 2, D / 2, D / 2, 30, 0};
                pg8::EpiSwiGLUF8<true> E{(unsigned char*)P_UF, FFN, 1.0f / F8_W13_SC, F8_UM_SC, (const LAS float*)(lds + RST_OFF)};
                pg8::gemm_phase<pg8::EpiSwiGLUF8<true>, pg8::Order, pg8::GDs, 1>(lds + RING_OFF, g, S, E, wave_s);
            } else {
                pg8::GDs g{P_HB, (const bf16*)(P_wev + EV_E13), D, D, D, 30, 0};
                pg8::EpiSwiGLU<false> E{P_UF, FFN, (const LAS float*)(lds + RST_OFF)};
                pg8::gemm_phase<pg8::EpiSwiGLU<false>, pg8::Order, pg8::GDs>(lds + RING_OFF, g, S, E, wave_s);
            }
        }
        SEAM(pb + 3);
        if (IN(pb + 4)) {
            pg8::Order S; S.init(M / 256, D / 256, G_O, BX_O);
            if (ffn8) {
                pg8::GDs g{P_UF, (const bf16*)(P_wev + EV_E2), FFN / 2, FFN / 2, FFN / 2, 30, 0};
                pg8::EpiResid<true> E{P_H, P_H, P_HB, P_SSQ, 1.0f / (F8_UM_SC * F8_W2_SC), nullptr};
                pg8::gemm_phase<pg8::EpiResid<true>, pg8::Order, pg8::GDs, 1>(lds + RING_OFF, g, S, E, wave_s);
            } else {
                pg8::GDs g{P_UF, (const bf16*)(P_wev + EV_E2), FFN, FFN, FFN, 30, 0};
                pg8::EpiResid<false> E{P_H, P_H, P_HB, P_SSQ, 1.0f, nullptr};
                pg8::gemm_phase<pg8::EpiResid<false>, pg8::Order, pg8::GDs>(lds + RING_OFF, g, S, E, wave_s);
            }
        }
        SEAM(pb + 4);
        if (IN(pb + 5)) {
            pg8::GDs g{P_HB, (const bf16*)(P_wod + OD_OIN), D, D, D, 30, 0}; pg8::Order S; S.init(M / 256, 1536 / 256, G_O, BX_O);
            RST_PREAMBLE(S);
            pg8::EpiOddIn E{P_AG, P_ZUV, (const LAS float*)(lds + RST_OFF)};
            pg8::gemm_phase<pg8::EpiOddIn, pg8::Order, pg8::GDs>(lds + RING_OFF, g, S, E, wave_s);
        }
        SEAM(pb + 5);
        if (IN(pb + 6)) {
            const int NS5 = G >= 128 ? 64 : 0;
            if (NS5 == 0 || bx < NS5) {
                pg8::GDs g{P_AG + 128, (const bf16*)(P_wod + OD_WST), 640, 512, 512, 1, (size_t)256 * 512}; pg8::Order S; S.init(64, 1, NS5 ? NS5 : G_O, BX_O);
                pg8::EpiS5Scan E{P_AG, (const float*)(P_sm + SM_AT) + (size_t)lp * 32 * 64 * 2};
                pg8::gemm_phase<pg8::EpiS5Scan, pg8::Order, pg8::GDs>(lds + RING_OFF, g, S, E, wave_s);
            }
            for (int rep_ = 0; rep_ < REP_SGU; ++rep_)
            if (NS5 == 0 || bx >= NS5) {
                PHASE_IDS
                const int nwk = NS5 ? G - NS5 : G, wk = NS5 ? bx - NS5 : bx;
                LAS bf16* vT = (LAS bf16*)(lds + RING_OFF);
                const bf16* Wm = (const bf16*)(P_wod + OD_SGU);
                const float* lng = INP(23) + lp * 512; const float* sb = INP(25) + lp * 512;
                const int j_ln = tid >> 2, cq = tid & 3, fr = lane & 15, fq = lane >> 4, i_pos = wave * 16 + fr;
                for (int un = wk; un < 512; un += nwk) {
                    const int nb = un >> 2, hh = un & 3;
                    v4u vraw[4];
                    { const bf16* src = P_ZUV + (size_t)(nb * 128 + j_ln) * 1024 + 512 + hh * 128 + cq * 32;
#pragma unroll
                      for (int q4 = 0; q4 < 4; ++q4) vraw[q4] = *(const GAS v4u*)(src + q4 * 8); }
                    bf16x8 wf[4];
#pragma unroll
                    for (int ks = 0; ks < 4; ++ks) wf[ks] = *(const GAS bf16x8*)(Wm + ((size_t)hh * 128 + i_pos) * 128 + ks * 32 + fq * 8);
                    const float bias = sb[hh * 128 + i_pos]; const size_t tok = (size_t)(nb * 128 + i_pos);
                    v2u uu[8];
#pragma unroll
                    for (int ct = 0; ct < 8; ++ct) uu[ct] = *(const GAS v2u*)(P_ZUV + tok * 1024 + hh * 128 + ct * 16 + fq * 4);
                    __syncthreads();
                    {
                        float v[32]; float s = 0.f;
#pragma unroll
                        for (int q4 = 0; q4 < 4; ++q4) { const v4u w = vraw[q4];
                            v[q4 * 8 + 0] = bflo(w.x); v[q4 * 8 + 1] = bfhi(w.x); v[q4 * 8 + 2] = bflo(w.y); v[q4 * 8 + 3] = bfhi(w.y);
                            v[q4 * 8 + 4] = bflo(w.z); v[q4 * 8 + 5] = bfhi(w.z); v[q4 * 8 + 6] = bflo(w.w); v[q4 * 8 + 7] = bfhi(w.w); }
#pragma unroll
                        for (int e = 0; e < 32; ++e) s += v[e];
                        s += __shfl_xor(s, 1); s += __shfl_xor(s, 2);
                        const float mu = s * (1.0f / 128.0f); float q = 0.f;
#pragma unroll
                        for (int e = 0; e < 32; ++e) { v[e] -= mu; q += v[e] * v[e]; }
                        q += __shfl_xor(q, 1); q += __shfl_xor(q, 2);
                        const float rstd = 1.0f / sqrtf(q * (1.0f / 128.0f) + 1e-5f);
#pragma unroll
                        for (int e = 0; e < 32; ++e) { const int c = cq * 32 + e; vT[c * 136 + j_ln] = (bf16)f2bf(v[e] * rstd * lng[hh * 128 + c]); }
                    }
                    __syncthreads();
                    {
                        f32x4 acc[8];
#pragma unroll
                        for (int ct = 0; ct < 8; ++ct) acc[ct] = (f32x4){0.f, 0.f, 0.f, 0.f};
#pragma unroll
                        for (int ks = 0; ks < 4; ++ks) {
#pragma unroll
                            for (int ct = 0; ct < 8; ++ct) { const bf16x8 vf = *(const LAS bf16x8*)(vT + (ct * 16 + fr) * 136 + ks * 32 + fq * 8);
                                acc[ct] = __builtin_amdgcn_mfma_f32_16x16x32_bf16(vf, wf[ks], acc[ct], 0, 0, 0); }
                        }
#pragma unroll
                        for (int ct = 0; ct < 8; ++ct) { const int c = ct * 16 + fq * 4;
                            v2u o; o.x = pk2(bflo(uu[ct].x) * (acc[ct][0] + bias), bfhi(uu[ct].x) * (acc[ct][1] + bias)); o.y = pk2(bflo(uu[ct].y) * (acc[ct][2] + bias), bfhi(uu[ct].y) * (acc[ct][3] + bias));
                            *(GAS v2u*)(P_MIX + tok * 1024 + 512 + hh * 128 + c) = o; }
                    }
                }
                __syncthreads();
            }
        }
        SEAM(pb + 6);
        if (IN(pb + 7)) {
            pg8::GDh g{P_AG, (const bf16*)(P_wod + OD_MY), 640, 640, 640, 1, (size_t)512 * 640}; pg8::Order S; S.init(64, 4, G_O, BX_O);
            pg8::EpiS5Y E{P_AG, INP(20) + lp * 512, P_GY};
            pg8::gemm_phase<pg8::EpiS5Y, pg8::Order, pg8::GDh>(lds + RING_OFF, g, S, E, wave_s);
        }
        SEAM(pb + 7);
        if (IN(pb + 8)) {
            pg8::GDh g{P_GY, (const bf16*)(P_wod + OD_GLU), 512, 512, 512, 30, 0}; pg8::Order S; S.init(M / 256, 4, G_O, BX_O);
            pg8::EpiGLU E{P_GY, INP(22) + lp * 512, P_MIX};
            pg8::gemm_phase<pg8::EpiGLU, pg8::Order, pg8::GDh>(lds + RING_OFF, g, S, E, wave_s);
        }
        SEAM(pb + 8);
        if (IN(pb + 9)) {
            pg8::GDs g{P_MIX, (const bf16*)(P_wod + OD_OOUT), D, D, D, 30, 0}; pg8::Order S; S.init(M / 256, D / 256, G_O, BX_O);
            pg8::EpiResid<false> E{P_H, P_H, nullptr, nullptr, 1.0f, nullptr};
            pg8::gemm_phase<pg8::EpiResid<false>, pg8::Order, pg8::GDs>(lds + RING_OFF, g, S, E, wave_s);
        }
        SEAM(pb + 9);
        for (int rep_ = 0; rep_ < REP_ROUTE; ++rep_)
        if (IN(pb + 10)) {
            PHASE_IDS
            LAS int* tE = (LAS int*)(lds + RING_OFF);
            const float* Wr = INP(28) + (size_t)lp * D * 8; const float* g2 = INP(27) + lp * D;
            float gw[4][4][8];
#pragma unroll
            for (int j = 0; j < 4; ++j) { const f32x4 gv = *(const f32x4*)(g2 + 256 * j + 4 * lane);
#pragma unroll
                for (int i = 0; i < 4; ++i) { const float* wp = Wr + (size_t)(256 * j + 4 * lane + i) * 8; const f32x4 w0 = *(const f32x4*)wp, w1 = *(const f32x4*)(wp + 4);
#pragma unroll
                    for (int e = 0; e < 4; ++e) { gw[j][i][e] = w0[e] * gv[i]; gw[j][i][4 + e] = w1[e] * gv[i]; } } }
            const bool b0 = lane & 1, b1 = lane & 2, b2 = lane & 4;
            __syncthreads();
            for (int vb = bx; vb < 256; vb += G) {
                for (int tt = 0; tt < 8; tt += 2) {
                    const int tl = wave * 8 + tt, t = vb * 64 + tl;
                    const GAS f32x4* hr = (const GAS f32x4*)(P_H + (size_t)t * D) + lane;
                    f32x4 hv2[2][4];
#pragma unroll
                    for (int q = 0; q < 2; ++q)
#pragma unroll
                        for (int j = 0; j < 4; ++j) hv2[q][j] = hr[q * 256 + 64 * j];
#pragma unroll
                    for (int q = 0; q < 2; ++q) {
                        float lg[8]; float ss = 0.f;
#pragma unroll
                        for (int e = 0; e < 8; ++e) lg[e] = 0.f;
#pragma unroll
                        for (int j = 0; j < 4; ++j) { const f32x4 hv = hv2[q][j]; ss += (hv.x * hv.x + hv.y * hv.y) + (hv.z * hv.z + hv.w * hv.w);
#pragma unroll
                            for (int i = 0; i < 4; ++i) { const float hvi = hv[i];
#pragma unroll
                                for (int e = 0; e < 8; ++e) lg[e] += hvi * gw[j][i][e]; } }
                        ss = wave_sum(ss);
                        float ra[4], rb[2], rc;
#pragma unroll
                        for (int qq = 0; qq < 4; ++qq) { const float mine = b0 ? lg[4 + qq] : lg[qq], oth = b0 ? lg[qq] : lg[4 + qq]; ra[qq] = mine + __shfl_xor(oth, 1); }
#pragma unroll
                        for (int r = 0; r < 2; ++r) { const float mine = b1 ? ra[2 + r] : ra[r], oth = b1 ? ra[r] : ra[2 + r]; rb[r] = mine + __shfl_xor(oth, 2); }
                        { const float mine = b2 ? rb[1] : rb[0], oth = b2 ? rb[0] : rb[1]; rc = mine + __shfl_xor(oth, 4); }
                        rc += __shfl_xor(rc, 8); rc += __shfl_xor(rc, 16); rc += __shfl_xor(rc, 32);
                        const float rstd = 1.0f / sqrtf(ss * (1.0f / 1024.0f) + 1e-5f);
                        float lv[8];
#pragma unroll
                        for (int e = 0; e < 8; ++e) lv[e] = __shfl(rc, (e >> 2) + 2 * ((e >> 1) & 1) + 4 * (e & 1)) * rstd;
                        int e0 = 0; float v0 = lv[0];
#pragma unroll
                        for (int e = 1; e < 8; ++e) { if (lv[e] > v0) { v0 = lv[e]; e0 = e; } }
                        int e1 = -1; float v1 = 0.f;
#pragma unroll
                        for (int e = 0; e < 8; ++e) { if (e != e0 && (e1 < 0 || lv[e] > v1)) { v1 = lv[e]; e1 = e; } }
                        const float ex = __expf(v1 - v0), w0 = 1.0f / (1.0f + ex), w1 = ex * w0;
                        if (lane == 0) { tE[(tl + q) * 2] = e0; tE[(tl + q) * 2 + 1] = e1; P_TOKE[(t + q) * 2] = e0; P_TOKE[(t + q) * 2 + 1] = e1; P_TOKW[(t + q) * 2] = w0; P_TOKW[(t + q) * 2 + 1] = w1; P_RSTD[t + q] = rstd; }
                    }
                }
                __syncthreads();
                if (wave == 0) { const int e0 = tE[lane * 2], e1 = tE[lane * 2 + 1], t = vb * 64 + lane; int r0 = 0, r1 = 0;
#pragma unroll
                    for (int e = 0; e < 8; ++e) { const unsigned long long mk = __ballot(e0 == e || e1 == e); const int rk = __popcll(mk & ((1ull << lane) - 1ull));
                        if (e0 == e) r0 = rk; if (e1 == e) r1 = rk; if (lane == 0) P_WGCNT[vb * 8 + e] = __popcll(mk); }
                    P_TOKR[t * 2] = r0; P_TOKR[t * 2 + 1] = r1; }
                __syncthreads();
            }
        }
        SEAM(pb + 10);
        for (int rep_ = 0; rep_ < REP_ROUTE; ++rep_)
        if (IN(pb + 11)) {
            PHASE_IDS
            const bool f8 = F8_LAST && lp >= F8_FROM;
            LAS int* cntT = (LAS int*)(lds + RING_OFF);
            LAS int* pre = cntT + 32;
            __syncthreads();
            {
                const int e = wave; int s = 0;
#pragma unroll
                for (int i = 0; i < 4; ++i) s += P_WGCNT[(lane * 4 + i) * 8 + e];
#pragma unroll
                for (int o = 1; o < 64; o <<= 1) s += __shfl_xor(s, o);
                if (lane == 0) { cntT[e] = s; cntT[16 + e] = (s + 255) & ~255; }
            }
            __syncthreads();
            if (tid == 0) { int b = 0; for (int e = 0; e < 8; ++e) { cntT[8 + e] = b; b += cntT[16 + e]; } cntT[24] = b >> 8; }
            __syncthreads();
            if (bx == 0) { const int np = cntT[24];
                if (tid < MAXPAN) { int ex = 0; for (int e = 0; e < 8; ++e) if (tid * 256 >= cntT[8 + e]) ex = e; P_PANEL[tid] = tid < np ? ex : 0; }
                if (tid == 0) P_PANEL[MAXPAN] = np; }
            for (int e = bx; e < 8; e += G) {
                const int r0 = cntT[8 + e] + cntT[e], r1 = cntT[8 + e] + cntT[16 + e];
                if (f8) { for (int q = tid; q < (r1 - r0) * 64; q += 512) { const int r = r0 + (q >> 6); *(GAS v4u*)((unsigned char*)P_XS + (size_t)r * D + (q & 63) * 16) = (v4u){0u, 0u, 0u, 0u}; } }
                else { for (int q = tid; q < (r1 - r0) * 128; q += 512) { const int r = r0 + (q >> 7); *(GAS v4u*)(P_XS + (size_t)r * D + (q & 127) * 8) = (v4u){0u, 0u, 0u, 0u}; } }
            }
            for (int vb = bx; vb < 256; vb += G) {
                __syncthreads();
                {   const int e = wave; int s = 0;
#pragma unroll
                    for (int i = 0; i < 4; ++i) { const int b2 = lane * 4 + i; s += b2 < vb ? P_WGCNT[b2 * 8 + e] : 0; }
#pragma unroll
                    for (int o = 1; o < 64; o <<= 1) s += __shfl_xor(s, o);
                    if (lane == 0) pre[e] = s; }
                __syncthreads();
                int mp0 = 0, mp1 = 0; float mrs = 0.f;
                if (lane < 8) { const int t = vb * 64 + wave * 8 + lane; const int e0 = P_TOKE[t * 2], e1 = P_TOKE[t * 2 + 1];
                    mp0 = cntT[8 + e0] + pre[e0] + P_TOKR[t * 2]; mp1 = cntT[8 + e1] + pre[e1] + P_TOKR[t * 2 + 1]; mrs = P_RSTD[t];
                    P_TOKP[t * 2] = mp0; P_TOKP[t * 2 + 1] = mp1; }
                for (int tt = 0; tt < 8; tt += 2) {
                    const int t = vb * 64 + wave * 8 + tt;
                    const GAS f32x4* hr = (const GAS f32x4*)(P_H + (size_t)t * D) + lane;
                    f32x4 hv2[2][4];
#pragma unroll
                    for (int q = 0; q < 2; ++q)
#pragma unroll
                        for (int j = 0; j < 4; ++j) hv2[q][j] = hr[q * 256 + 64 * j];
#pragma unroll
                    for (int q = 0; q < 2; ++q) {
                        const int p0 = __shfl(mp0, tt + q), p1 = __shfl(mp1, tt + q); const float rstd = __shfl(mrs, tt + q);
                        if (f8) { GAS unsigned* o0 = (GAS unsigned*)((unsigned char*)P_XS + (size_t)p0 * D) + lane; GAS unsigned* o1 = (GAS unsigned*)((unsigned char*)P_XS + (size_t)p1 * D) + lane;
#pragma unroll
                            for (int j = 0; j < 4; ++j) { const f32x4 hv = hv2[q][j]; const unsigned w = pg8::pk4_fp8(hv.x * rstd, hv.y * rstd, hv.z * rstd, hv.w * rstd); o0[64 * j] = w; o1[64 * j] = w; }
                        } else { GAS v2u* o0 = (GAS v2u*)(P_XS + (size_t)p0 * D) + lane; GAS v2u* o1 = (GAS v2u*)(P_XS + (size_t)p1 * D) + lane;
#pragma unroll
                            for (int j = 0; j < 4; ++j) { const f32x4 hv = hv2[q][j]; v2u w; w.x = pk2(hv.x * rstd, hv.y * rstd); w.y = pk2(hv.z * rstd, hv.w * rstd); o0[64 * j] = w; o1[64 * j] = w; } }
                    }
                }
            }
        }
        SEAM(pb + 11);
        LAS int* ptab = (LAS int*)(lds + PTAB_OFF);
        if (IN(pb + 12) || IN(pb + 13)) {
            PHASE_IDS
            __syncthreads();
            if (tid <= MAXPAN) ptab[tid] = (int)__hip_atomic_load((unsigned*)P_PANEL + tid, RLX_AGENT);
            __syncthreads();
        }
        if (IN(pb + 12)) {
            const int np = __builtin_amdgcn_readfirstlane(ptab[MAXPAN]);
            pg8::Order S; S.init(np, EXD / 128, G_O, BX_O);
            if (F8_LAST && lp >= F8_FROM) {
                pg8::GDt g{P_XS, (const bf16*)(P_wod + OD_M13), D / 2, D / 2, D / 2, (size_t)EXD * D, ptab};
                pg8::EpiSwiGLUF8<false> E{(unsigned char*)P_UM, EXD, 1.0f / F8_W13_SC, F8_UM_SC, nullptr};
                pg8::gemm_phase<pg8::EpiSwiGLUF8<false>, pg8::Order, pg8::GDt, 1>(lds + RING_OFF, g, S, E, wave_s);
            } else {
                pg8::GDt g{P_XS, (const bf16*)(P_wod + OD_M13), D, D, D, (size_t)2 * EXD * D, ptab};
                pg8::EpiSwiGLU<true> E{P_UM, EXD, nullptr};
                pg8::gemm_phase<pg8::EpiSwiGLU<true>, pg8::Order, pg8::GDt>(lds + RING_OFF, g, S, E, wave_s);
            }
        }
        SEAM(pb + 12);
        if (IN(pb + 13)) {
            const int np = __builtin_amdgcn_readfirstlane(ptab[MAXPAN]);
            if (F8_LAST && lp >= F8_FROM) {
                const float osc = 1.0f / (F8_UM_SC * F8_W2_SC);
                {   pg8::GDt g{P_UM, (const bf16*)(P_wod + OD_M2), EXD / 2, EXD / 2, EXD / 2, (size_t)D * EXD / 2, ptab}; pg8::Order S; S.init(np < 128 ? np : 128, D / 256, G_O, BX_O);
                    pg8::EpiBf16 E{P_XS, D, osc};
                    pg8::gemm_phase<pg8::EpiBf16, pg8::Order, pg8::GDt, 1>(lds + RING_OFF, g, S, E, wave_s); }
                if (np > 128) {
                    pg8::GDk g{P_UM, (const bf16*)(P_wod + OD_M2), EXD / 2, EXD / 2, 256, (size_t)D * EXD / 2, ptab, 128, 256}; pg8::Order S; S.init(np - 128, 28, G_O, BX_O);
                    pg8::EpiPartF32 E{(float*)(P_ws + WS_PART), osc};
                    pg8::gemm_phase<pg8::EpiPartF32, pg8::Order, pg8::GDk, 1>(lds + RING_OFF, g, S, E, wave_s); }
            } else {
                {
                    pg8::GDt g{P_UM, (const bf16*)(P_wod + OD_M2), EXD, EXD, EXD, (size_t)D * EXD, ptab}; pg8::Order S; S.init(np < 128 ? np : 128, D / 256, G_O, BX_O);
                    pg8::EpiBf16 E{P_XS, D, 1.0f};
                    pg8::gemm_phase<pg8::EpiBf16, pg8::Order, pg8::GDt>(lds + RING_OFF, g, S, E, wave_s); }
                if (np > 128) {
                    pg8::GDk g{P_UM, (const bf16*)(P_wod + OD_M2), EXD, EXD, 512, (size_t)D * EXD, ptab, 128, 512}; pg8::Order S; S.init(np - 128, 28, G_O, BX_O);
                    pg8::EpiPartF32 E{(float*)(P_ws + WS_PART), 1.0f};
                    pg8::gemm_phase<pg8::EpiPartF32, pg8::Order, pg8::GDk>(lds + RING_OFF, g, S, E, wave_s); }
            }
        }
        SEAM(pb + 13);
        if (IN(pb + 14)) {
            PHASE_IDS
            const int gw = bx * NWAVES + wave, NGW = G * NWAVES; const bf16* YC = P_XS; const float* fg = INP(32); const float* PART = (const float*)(P_ws + WS_PART);
            int mp0 = 0, mp1 = 0; float mw0 = 0.f, mw1 = 0.f;
            if (lane < 8 && gw + lane * NGW < M) { const int t = gw + lane * NGW; mp0 = P_TOKP[t * 2]; mp1 = P_TOKP[t * 2 + 1]; mw0 = P_TOKW[t * 2]; mw1 = P_TOKW[t * 2 + 1]; }
#define COMBINE_FIN(T, V, AV, BV, FAST, PP0, PP1, GW0, GW1) do { GAS f32x4* hr_ = (GAS f32x4*)(P_H + (size_t)(T) * D) + lane; float s_ = 0.f; \
                if (FAST) { _Pragma("unroll") for (int j = 0; j < 4; ++j) { V[j].x += GW0 * bflo(AV[j].x) + GW1 * bflo(BV[j].x); V[j].y += GW0 * bfhi(AV[j].x) + GW1 * bfhi(BV[j].x); V[j].z += GW0 * bflo(AV[j].y) + GW1 * bflo(BV[j].y); V[j].w += GW0 * bfhi(AV[j].y) + GW1 * bfhi(BV[j].y); } } \
                else { _Pragma("unroll") for (int sl = 0; sl < 2; ++sl) { const int p_ = sl ? PP1 : PP0; const float gwt_ = sl ? GW1 : GW0; \
                        if (p_ < 128 * 256) { const GAS v2u* y_ = (const GAS v2u*)(YC + (size_t)p_ * D) + lane; \
                            _Pragma("unroll") for (int j = 0; j < 4; ++j) { const v2u a_ = y_[64 * j]; V[j].x += gwt_ * bflo(a_.x); V[j].y += gwt_ * bfhi(a_.x); V[j].z += gwt_ * bflo(a_.y); V[j].w += gwt_ * bfhi(a_.y); } } \
                        else { const int q_ = (p_ - 128 * 256) >> 8, r_ = p_ & 255; \
                            for (int ks = 0; ks < 7; ++ks) { const GAS f32x4* y_ = (const GAS f32x4*)(PART + ((size_t)(q_ * 7 + ks) * 256 + r_) * D) + lane; \
                                _Pragma("unroll") for (int j = 0; j < 4; ++j) V[j] += gwt_ * y_[64 * j]; } } } } \
                _Pragma("unroll") for (int j = 0; j < 4; ++j) s_ += (V[j].x * V[j].x + V[j].y * V[j].y) + (V[j].z * V[j].z + V[j].w * V[j].w); \
                s_ = wave_sum(s_); \
                if (lp == 1) { const float rstd_ = 1.0f / sqrtf(s_ * (1.0f / 1024.0f) + 1e-5f); \
                    _Pragma("unroll") for (int j = 0; j < 4; ++j) { const f32x4 gv_ = *((const GAS f32x4*)fg + lane + 64 * j); f32x4 o_; o_.x = V[j].x * rstd_ * gv_.x; o_.y = V[j].y * rstd_ * gv_.y; o_.z = V[j].z * rstd_ * gv_.z; o_.w = V[j].w * rstd_ * gv_.w; hr_[64 * j] = o_; } } \
                else { GAS v2u* o8_ = (GAS v2u*)(P_HB + (size_t)(T) * D) + lane; \
                    _Pragma("unroll") for (int j = 0; j < 4; ++j) { hr_[64 * j] = V[j]; v2u w_; w_.x = pk2(V[j].x, V[j].y); w_.y = pk2(V[j].z, V[j].w); o8_[64 * j] = w_; } \
                    if (lane < 16) P_SSQ[(size_t)(T) * 16 + lane] = lane == 0 ? s_ : 0.f; } } while (0)
            for (int it = 0; it < 8; it += 2) {
                const int t0 = gw + it * NGW, t1 = t0 + NGW; if (t0 >= M) break;
                const bool ok1 = t1 < M;
                const int p00 = __shfl(mp0, it), p01 = __shfl(mp1, it), p10 = __shfl(mp0, it + 1), p11 = __shfl(mp1, it + 1);
                const float g00 = __shfl(mw0, it), g01 = __shfl(mw1, it), g10 = __shfl(mw0, it + 1), g11 = __shfl(mw1, it + 1);
                const bool fast0 = p00 < 128 * 256 && p01 < 128 * 256, fast1 = ok1 && p10 < 128 * 256 && p11 < 128 * 256;
                f32x4 v0[4], v1[4]; v2u a0[4], b0[4], a1[4], b1[4];
                const int t1c = ok1 ? t1 : t0;
                const GAS f32x4* hr0 = (const GAS f32x4*)(P_H + (size_t)t0 * D) + lane; const GAS f32x4* hr1 = (const GAS f32x4*)(P_H + (size_t)t1c * D) + lane;
                const GAS v2u* y00 = (const GAS v2u*)(YC + (size_t)(fast0 ? p00 : 0) * D) + lane; const GAS v2u* y01 = (const GAS v2u*)(YC + (size_t)(fast0 ? p01 : 0) * D) + lane;
                const GAS v2u* y10 = (const GAS v2u*)(YC + (size_t)(fast1 ? p10 : 0) * D) + lane; const GAS v2u* y11 = (const GAS v2u*)(YC + (size_t)(fast1 ? p11 : 0) * D) + lane;
#pragma unroll
                for (int j = 0; j < 4; ++j) { v0[j] = hr0[64 * j]; a0[j] = y00[64 * j]; b0[j] = y01[64 * j]; }
#pragma unroll
                for (int j = 0; j < 4; ++j) { v1[j] = hr1[64 * j]; a1[j] = y10[64 * j]; b1[j] = y11[64 * j]; }
                COMBINE_FIN(t0, v0, a0, b0, fast0, p00, p01, g00, g01);
                if (ok1) COMBINE_FIN(t1, v1, a1, b1, fast1, p10, p11, g10, g11);
            }
#undef COMBINE_FIN
        }
        if (lp == 0) SEAM(pb + 14);
    }
#undef IN
#undef SEAM
}

#ifndef MK_PER_PHASE
#define MK_PER_PHASE 0
#endif
extern "C" void kernel_launch(void* const* d_in, const int* in_sizes, int n_in, void* d_out, int out_size, void* d_ws, size_t ws_size, hipStream_t stream) {
    static int grid = 0;
    if (grid == 0) {
        if (n_in != 33 || out_size != M * D || ws_size < WS_END) { fprintf(stderr, "kernel_launch: unexpected shapes (n_in %d, out %d, ws %zu, need %zu)\n", n_in, out_size, ws_size, (size_t)WS_END); grid = -1; return; }
        int dev = 0, cus = 0, per_cu = 0;
        if (hipGetDevice(&dev) != hipSuccess || hipDeviceGetAttribute(&cus, hipDeviceAttributeMultiprocessorCount, dev) != hipSuccess) { grid = -1; return; }
        if (hipFuncSetAttribute((const void*)trunk_fwd, hipFuncAttributeMaxDynamicSharedMemorySize, LDS_BYTES) != hipSuccess) { fprintf(stderr, "kernel_launch: hipFuncSetAttribute failed\n"); grid = -1; return; }
        if (hipOccupancyMaxActiveBlocksPerMultiprocessor(&per_cu, (const void*)trunk_fwd, NWAVES * 64, LDS_BYTES) != hipSuccess || per_cu < 1) fprintf(stderr, "kernel_launch: occupancy query reports %d\n", per_cu);
        (void)hipGetLastError();
        grid = cus;
    }
    if (grid < 0) return;
    if (hipMemsetAsync((char*)d_ws + WS_CTL, 0, CTL_ZERO_BYTES, stream) != hipSuccess) return;
    Args a{};
    for (int i = 0; i < 33; ++i) a.in[i] = (const float*)d_in[i];
    a.out = (float*)d_out; a.ws = (unsigned char*)d_ws;
#if MK_PER_PHASE
    for (int p = 0; p < NPH; ++p) { a.ph_lo = p; a.ph_hi = p + 1; hipLaunchKernelGGL(trunk_fwd, dim3(grid), dim3(NWAVES * 64), LDS_BYTES, stream, a); }
#elif defined(PROBE_PRE_LO)
    for (int rp = 0; rp < PROBE_PRE_N; ++rp) { a.ph_lo = PROBE_PRE_LO; a.ph_hi = PROBE_PRE_HI; hipLaunchKernelGGL(trunk_fwd, dim3(grid), dim3(NWAVES * 64), LDS_BYTES, stream, a);
        (void)hipMemsetAsync((char*)d_ws + WS_CTL, 0, CTL_ZERO_BYTES, stream); }
    a.ph_lo = 0; a.ph_hi = NPH;
    hipLaunchKernelGGL(trunk_fwd, dim3(grid), dim3(NWAVES * 64), LDS_BYTES, stream, a);
#elif defined(PROBE_POST_LO)
    a.ph_lo = 0; a.ph_hi = NPH;
    hipLaunchKernelGGL(trunk_fwd, dim3(grid), dim3(NWAVES * 64), LDS_BYTES, stream, a);
    for (int rp = 0; rp < PROBE_POST_N; ++rp) { (void)hipMemsetAsync((char*)d_ws + WS_CTL, 0, CTL_ZERO_BYTES, stream);
        a.ph_lo = PROBE_POST_LO; a.ph_hi = PROBE_POST_HI; hipLaunchKernelGGL(trunk_fwd, dim3(grid), dim3(NWAVES * 64), LDS_BYTES, stream, a); }
#else
    a.ph_lo = 0; a.ph_hi = NPH;
    hipLaunchKernelGGL(trunk_fwd, dim3(grid), dim3(NWAVES * 64), LDS_BYTES, stream, a);
#endif
}
```

```cpp
#include <hip/hip_runtime.h>
#include <cstdio>
#include <cstdint>

namespace pg8 {
#define PG8_LAS __attribute__((address_space(3)))
typedef unsigned short bf16_t;
typedef short bf16x8 __attribute__((ext_vector_type(8)));
typedef float f32x4 __attribute__((ext_vector_type(4)));
typedef float f32x2 __attribute__((ext_vector_type(2)));
typedef unsigned u32x4 __attribute__((ext_vector_type(4)));
typedef unsigned u32x2 __attribute__((ext_vector_type(2)));
constexpr int BM = 256, BK = 64, HALF = 128, HTB = HALF * BK * 2  , STAGE_BYTES = 8 * HTB, NXCD = 8, WGM = 8;

__host__ __device__ __forceinline__ int lds_byte(int r, int c) { const int st = (r >> 4) * 2 + (c >> 5), rr = r & 15, cc = c & 31, ob = rr * 64 + cc * 2; return st * 1024 + (ob ^ (((ob >> 9) & 1) << 5)); }
__host__ __device__ __forceinline__ void stage_rc(int b, int& R, int& C) { const int st = b / 1024, sb = b % 1024, swz = sb ^ (((sb >> 9) & 1) << 5); R = (st >> 1) * 16 + swz / 64; C = (st & 1) * 32 + (swz % 64) / 2; }
__host__ __device__ __forceinline__ int perm32(int rho) { const int n = rho >> 4, i = rho & 15; return 8 * (i >> 2) + 4 * n + (i & 3); }

typedef int i32x4 __attribute__((ext_vector_type(4)));
typedef int i32x8 __attribute__((ext_vector_type(8)));
__device__ __forceinline__ i32x8 cat8(const bf16x8 a, const bf16x8 b) { return __builtin_shufflevector(__builtin_bit_cast(i32x4, a), __builtin_bit_cast(i32x4, b), 0, 1, 2, 3, 4, 5, 6, 7); }
__device__ __forceinline__ unsigned pk4_fp8(float a, float b, float c, float d) {
    a = __builtin_fminf(__builtin_fmaxf(a, -448.f), 448.f); b = __builtin_fminf(__builtin_fmaxf(b, -448.f), 448.f); c = __builtin_fminf(__builtin_fmaxf(c, -448.f), 448.f); d = __builtin_fminf(__builtin_fmaxf(d, -448.f), 448.f);
    int p = __builtin_amdgcn_cvt_pk_fp8_f32(a, b, 0, false); p = __builtin_amdgcn_cvt_pk_fp8_f32(c, d, p, true); return (unsigned)p;
}
struct Unit { int pm, pn, idx; };

struct Order {
    int nM, nN, nwg, G, c;
    __device__ __forceinline__ void init(int nM_, int nN_, int G_, int c_) { nM = nM_; nN = nN_; nwg = nM * nN; G = G_; c = c_; }
    __device__ __forceinline__ bool next(int i, Unit& u) const {
        const long L = (long)i * G + c; if (L >= nwg) return false;
        int wgid = (int)L; { const int q = nwg / NXCD, r = nwg % NXCD, xcd = wgid % NXCD, off = wgid / NXCD; wgid = (xcd < r ? xcd * (q + 1) : r * (q + 1) + (xcd - r) * q) + off; }
        const int nig = WGM * nN, gid = wgid / nig, fm = gid * WGM, gsz = (nM - fm) < WGM ? (nM - fm) : WGM;
        u.pm = fm + ((wgid % nig) % gsz); u.pn = (wgid % nig) / gsz; u.idx = i; return true;
    }
    __device__ __forceinline__ void a_ready(const Unit&) const {}
    __device__ __forceinline__ void done(const Unit&) const {}
};

struct GDs {
    const bf16_t* A; const bf16_t* Bt; int lda, ldb, K, gshift; size_t gstride;
    __device__ __forceinline__ const char* a_ptr(const Unit& u) const { return (const char*)(A + (size_t)u.pm * BM * lda); }
    __device__ __forceinline__ const char* b_ptr(const Unit& u) const { return (const char*)(Bt + (size_t)(u.pm >> gshift) * gstride + (size_t)u.pn * BM * ldb); }
};
struct GDh {
    const bf16_t* A; const bf16_t* Bt; int lda, ldb, K, gshift; size_t gstride;
    __device__ __forceinline__ const char* a_ptr(const Unit& u) const { return (const char*)(A + (size_t)u.pm * BM * lda); }
    __device__ __forceinline__ const char* b_ptr(const Unit& u) const { return (const char*)(Bt + (size_t)(u.pm >> gshift) * gstride + (size_t)u.pn * HALF * ldb); }
};
struct GDt {
    const bf16_t* A; const bf16_t* Bt; int lda, ldb, K; size_t gstride; const PG8_LAS int* tab;
    __device__ __forceinline__ const char* a_ptr(const Unit& u) const { return (const char*)(A + (size_t)u.pm * BM * lda); }
    __device__ __forceinline__ const char* b_ptr(const Unit& u) const { const int grp = __builtin_amdgcn_readfirstlane(tab[u.pm]); return (const char*)(Bt + (size_t)grp * gstride + (size_t)u.pn * BM * ldb); }
};

struct GDk {
    const bf16_t* A; const bf16_t* Bt; int lda, ldb, K; size_t gstride; const PG8_LAS int* tab; int pm0, ksl;
    __device__ __forceinline__ const char* a_ptr(const Unit& u) const { return (const char*)(A + (size_t)(pm0 + u.pm) * BM * lda + (size_t)(u.pn >> 2) * ksl); }
    __device__ __forceinline__ const char* b_ptr(const Unit& u) const { const int grp = __builtin_amdgcn_readfirstlane(tab[pm0 + u.pm]); return (const char*)(Bt + (size_t)grp * gstride + (size_t)(u.pn & 3) * BM * ldb + (size_t)(u.pn >> 2) * ksl); }
};

__device__ __forceinline__ unsigned cvt_pk_bf16(float lo, float hi) { unsigned r; asm volatile("v_cvt_pk_bf16_f32 %0, %1, %2" : "=v"(r) : "v"(lo), "v"(hi)); return r; }
__device__ __forceinline__ float bf_lo(unsigned w) { return __uint_as_float(w << 16); }
__device__ __forceinline__ float bf_hi(unsigned w) { return __uint_as_float(w & 0xffff0000u); }
__device__ __forceinline__ float sigmoid_f(float x) { return __builtin_amdgcn_rcpf(1.0f + __expf(-x)); }
__device__ __forceinline__ float silu_f(float x) { return x * sigmoid_f(x); }
__device__ __forceinline__ float gelu_f(float x) { const float z2 = 1.5957691216057308f * (x + 0.044715f * x * x * x); return x * sigmoid_f(z2); }

constexpr float RMS_EPS_F = 1e-5f;
__device__ __forceinline__ float row_rstd(const float* ssq, int row, int fq) {
    const f32x4 p = *(const f32x4*)(ssq + (size_t)row * 16 + 4 * fq);
    float s = (p[0] + p[1]) + (p[2] + p[3]);
    s += __shfl_xor(s, 16); s += __shfl_xor(s, 32);
    return 1.0f / sqrtf(s * (1.0f / 1024.0f) + RMS_EPS_F);
}
__device__ __forceinline__ void rows_rstd(const float* ssq, int row0, int fq, float (&rs)[2][4]) {
    f32x4 p[2][4];
#pragma unroll
    for (int ai = 0; ai < 2; ++ai)
#pragma unroll
        for (int m = 0; m < 4; ++m) p[ai][m] = *(const f32x4*)(ssq + (size_t)(row0 + ai * HALF + m * 16) * 16 + 4 * fq);
#pragma unroll
    for (int ai = 0; ai < 2; ++ai)
#pragma unroll
        for (int m = 0; m < 4; ++m) { float s = (p[ai][m][0] + p[ai][m][1]) + (p[ai][m][2] + p[ai][m][3]); s += __shfl_xor(s, 16); s += __shfl_xor(s, 32); rs[ai][m] = 1.0f / sqrtf(s * (1.0f / 1024.0f) + RMS_EPS_F); }
}
__device__ __forceinline__ void rows_rstd_lds(const PG8_LAS float* t, float (&rs)[2][4]) {
#pragma unroll
    for (int ai = 0; ai < 2; ++ai)
#pragma unroll
        for (int m = 0; m < 4; ++m) rs[ai][m] = t[ai * HALF + m * 16];
}
__device__ __forceinline__ u32x4 pack8(const f32x4& a, const f32x4& b) { u32x4 w; w.x = cvt_pk_bf16(a[0], a[1]); w.y = cvt_pk_bf16(a[2], a[3]); w.z = cvt_pk_bf16(b[0], b[1]); w.w = cvt_pk_bf16(b[2], b[3]); return w; }

struct EpiScaleBf16 {
    static constexpr bool PERM = true, AFTER_DRAIN = false;
    bf16_t* O; int ldc; const PG8_LAS float* rst;
    __device__ __forceinline__ void operator()(const f32x4 (&acc)[2][2][4][2], const Unit& u, int wr, int wc, int fr, int fq) const {
        const int row0 = u.pm * BM + wr * 64 + fr, col0 = u.pn * BM + wc * 32 + 8 * fq;
        float rsv[2][4]; rows_rstd_lds(rst + u.idx * 256 + wr * 64 + fr, rsv);
#pragma unroll
        for (int ai = 0; ai < 2; ++ai)
#pragma unroll
            for (int m = 0; m < 4; ++m) { const int row = row0 + ai * HALF + m * 16; const float rs = rsv[ai][m]; bf16_t* rowp = O + (size_t)row * ldc + col0;
#pragma unroll
                for (int bj = 0; bj < 2; ++bj) *(u32x4*)(rowp + bj * HALF) = pack8(acc[ai][bj][m][0] * rs, acc[ai][bj][m][1] * rs); }
    }
};
template <bool SCALED> struct EpiResid {
    static constexpr bool PERM = false, AFTER_DRAIN = false;
    const float* resid; float* H; bf16_t* HB; float* ssq; float sc; unsigned char* H8;
    __device__ __forceinline__ void operator()(const f32x4 (&acc)[2][2][4][2], const Unit& u, int wr, int wc, int fr, int fq) const {
        const int row0 = u.pm * BM + wr * 64 + fr, col0 = u.pn * BM + wc * 32 + 4 * fq;
#pragma unroll
        for (int ai = 0; ai < 2; ++ai)
#pragma unroll
            for (int m = 0; m < 4; ++m) { const int row = row0 + ai * HALF + m * 16; const size_t off = (size_t)row * 1024 + col0; float q = 0.f;
#pragma unroll
                for (int bj = 0; bj < 2; ++bj)
#pragma unroll
                    for (int n = 0; n < 2; ++n) { const f32x4 bs = *(const f32x4*)(resid + off + bj * HALF + n * 16); f32x4 o; if (SCALED) { const f32x4 a4 = acc[ai][bj][m][n]; o[0] = __builtin_fmaf(a4[0], sc, bs[0]); o[1] = __builtin_fmaf(a4[1], sc, bs[1]); o[2] = __builtin_fmaf(a4[2], sc, bs[2]); o[3] = __builtin_fmaf(a4[3], sc, bs[3]); } else o = bs + acc[ai][bj][m][n];
                        *(f32x4*)(H + off + bj * HALF + n * 16) = o;
                        if (HB) { u32x2 w; w.x = cvt_pk_bf16(o[0], o[1]); w.y = cvt_pk_bf16(o[2], o[3]); *(u32x2*)(HB + off + bj * HALF + n * 16) = w; q += (o[0] * o[0] + o[1] * o[1]) + (o[2] * o[2] + o[3] * o[3]); }
                        if (H8) *(unsigned*)(H8 + off + bj * HALF + n * 16) = pk4_fp8(o[0], o[1], o[2], o[3]); }
                if (HB) { q += __shfl_xor(q, 16); q += __shfl_xor(q, 32); if (fq == 0) ssq[(size_t)row * 16 + u.pn * 4 + wc] = q; }
                asm volatile("" ::: "memory"); }
    }
};
template <bool MOE> struct EpiSwiGLU {
    static constexpr bool PERM = true, AFTER_DRAIN = false;
    bf16_t* U; int ldc; const PG8_LAS float* rst;
    __device__ __forceinline__ void operator()(const f32x4 (&acc)[2][2][4][2], const Unit& u, int wr, int wc, int fr, int fq) const {
        const int row0 = u.pm * BM + wr * 64 + fr, col0 = u.pn * HALF + wc * 32 + 8 * fq;
        float rsv[2][4];
        if (!MOE) rows_rstd_lds(rst + u.idx * 256 + wr * 64 + fr, rsv);
#pragma unroll
        for (int ai = 0; ai < 2; ++ai)
#pragma unroll
            for (int m = 0; m < 4; ++m) { const int row = row0 + ai * HALF + m * 16;
                const float rs = MOE ? 1.0f : rsv[ai][m], gw = 1.0f;
                f32x4 o0, o1;
#pragma unroll
                for (int j = 0; j < 4; ++j) { o0[j] = silu_f(acc[ai][0][m][0][j] * rs) * (acc[ai][1][m][0][j] * rs) * gw; o1[j] = silu_f(acc[ai][0][m][1][j] * rs) * (acc[ai][1][m][1][j] * rs) * gw; }
                *(u32x4*)(U + (size_t)row * ldc + col0) = pack8(o0, o1); }
    }
};
template <bool RS> struct EpiSwiGLUF8 {
    static constexpr bool PERM = true, AFTER_DRAIN = false;
    unsigned char* U; int ldc; float isc, osc; const PG8_LAS float* rst;
    __device__ __forceinline__ void operator()(const f32x4 (&acc)[2][2][4][2], const Unit& u, int wr, int wc, int fr, int fq) const {
        const int row0 = u.pm * BM + wr * 64 + fr, col0 = u.pn * HALF + wc * 32 + 8 * fq;
        float rsv[2][4];
        if (RS) rows_rstd_lds(rst + u.idx * 256 + wr * 64 + fr, rsv);
#pragma unroll
        for (int ai = 0; ai < 2; ++ai)
#pragma unroll
            for (int m = 0; m < 4; ++m) { const int row = row0 + ai * HALF + m * 16; float o[8]; const float is = RS ? isc * rsv[ai][m] : isc;
#pragma unroll
                for (int j = 0; j < 4; ++j) { o[j] = silu_f(acc[ai][0][m][0][j] * is) * (acc[ai][1][m][0][j] * is) * osc; o[4 + j] = silu_f(acc[ai][0][m][1][j] * is) * (acc[ai][1][m][1][j] * is) * osc; }
                u32x2 w; w.x = pk4_fp8(o[0], o[1], o[2], o[3]); w.y = pk4_fp8(o[4], o[5], o[6], o[7]);
                *(u32x2*)(U + (size_t)row * ldc + col0) = w; }
    }
};
struct EpiOddIn {
    static constexpr bool PERM = true, AFTER_DRAIN = false;
    bf16_t* AG; bf16_t* ZUV; const PG8_LAS float* rst;
    __device__ __forceinline__ void operator()(const f32x4 (&acc)[2][2][4][2], const Unit& u, int wr, int wc, int fr, int fq) const {
        const int row0 = u.pm * BM + wr * 64 + fr;
        float rsv[2][4]; rows_rstd_lds(rst + u.idx * 256 + wr * 64 + fr, rsv);
#pragma unroll
        for (int ai = 0; ai < 2; ++ai)
#pragma unroll
            for (int m = 0; m < 4; ++m) { const int row = row0 + ai * HALF + m * 16; const float rs = rsv[ai][m];
#pragma unroll
                for (int bj = 0; bj < 2; ++bj) { f32x4 v0 = acc[ai][bj][m][0] * rs, v1 = acc[ai][bj][m][1] * rs;
                    if (u.pn < 2) { const int cc = u.pn * BM + bj * HALF + wc * 32 + 8 * fq, g = cc >> 4, h0 = cc & 15;
                        *(u32x4*)(AG + ((size_t)g * 512 + (row >> 5)) * 640 + 128 + (row & 31) * 16 + h0) = pack8(v0, v1); }
                    else { const int cc = (u.pn - 2) * BM + bj * HALF + wc * 32 + 8 * fq;
#pragma unroll
                        for (int j = 0; j < 4; ++j) { v0[j] = gelu_f(v0[j]); v1[j] = gelu_f(v1[j]); }
                        *(u32x4*)(ZUV + (size_t)row * 1024 + cc) = pack8(v0, v1); } } }
    }
};
struct EpiS5Scan {
    static constexpr bool PERM = false, AFTER_DRAIN = true;
    bf16_t* AG; const float* AT;
    __device__ __forceinline__ void operator()(const f32x4 (&)[2][2][4][2], const Unit&, int, int, int, int) const {}
    __device__ __forceinline__ void fused(const f32x4 (&acc)[2][2][4][2], const Unit& u, int wr, int wc, int fr, int fq, PG8_LAS unsigned char* lds, int wid, int lane) const {
#pragma unroll
        for (int ai = 0; ai < 2; ++ai)
#pragma unroll
            for (int m = 0; m < 4; ++m) { const int r = ai * HALF + wr * 64 + m * 16 + fr;
#pragma unroll
                for (int n = 0; n < 2; ++n) { const int gq = (wc * 32 + n * 16 + 4 * fq) >> 2; *(PG8_LAS f32x4*)(lds + r * 512 + ((gq ^ (r & 15)) << 4)) = acc[ai][0][m][n]; } }
        asm volatile("s_waitcnt lgkmcnt(0)" ::: "memory"); __builtin_amdgcn_s_barrier(); asm volatile("" ::: "memory");
        if (wid == 0) { const int g = u.pm >> 1, p = lane;
            const float ar = AT[(g * 64 + p) * 2], ai_ = AT[(g * 64 + p) * 2 + 1]; float hr = 0.f, hi = 0.f;
            bf16_t* ap = AG + (size_t)u.pm * BM * 640 + p;
            const int g0 = p >> 2, g1 = (64 + p) >> 2, sub = (p & 3) << 2;
            for (int c0 = 0; c0 < 256; c0 += 8) { float sr[8], si[8];
#pragma unroll
                for (int e = 0; e < 8; ++e) { const int c = c0 + e; sr[e] = *(const PG8_LAS float*)(lds + c * 512 + ((g0 ^ (c & 15)) << 4) + sub); si[e] = *(const PG8_LAS float*)(lds + c * 512 + ((g1 ^ (c & 15)) << 4) + sub); }
#pragma unroll
                for (int e = 0; e < 8; ++e) { const unsigned w = cvt_pk_bf16(hr, hi); ap[(size_t)(c0 + e) * 640] = (bf16_t)(w & 0xffffu); ap[(size_t)(c0 + e) * 640 + 64] = (bf16_t)(w >> 16);
                    const float nr = ar * hr - ai_ * hi + sr[e], ni = ar * hi + ai_ * hr + si[e]; hr = nr; hi = ni; } }
        }
    }
};
struct EpiS5Y {
    static constexpr bool PERM = true, AFTER_DRAIN = false;
    const bf16_t* AG; const float* dskip; bf16_t* GY;
    __device__ __forceinline__ void operator()(const f32x4 (&acc)[2][2][4][2], const Unit& u, int wr, int wc, int fr, int fq) const {
        const int row0 = u.pm * BM + wr * 64 + fr, g = u.pm >> 1;
        const int n0 = u.pn * HALF + wc * 32 + 8 * fq, jl = n0 >> 4, h0 = n0 & 15;
        const f32x4 d0 = *(const f32x4*)(dskip + g * 16 + h0), d1 = *(const f32x4*)(dskip + g * 16 + h0 + 4);
#pragma unroll
        for (int ai = 0; ai < 2; ++ai)
#pragma unroll
            for (int m = 0; m < 4; ++m) { const int row = row0 + ai * HALF + m * 16;
                const u32x4 uu = *(const u32x4*)(AG + (size_t)row * 640 + 128 + n0);
                f32x4 y0 = acc[ai][0][m][0], y1 = acc[ai][0][m][1];
                y0[0] += d0[0] * bf_lo(uu.x); y0[1] += d0[1] * bf_hi(uu.x); y0[2] += d0[2] * bf_lo(uu.y); y0[3] += d0[3] * bf_hi(uu.y);
                y1[0] += d1[0] * bf_lo(uu.z); y1[1] += d1[1] * bf_hi(uu.z); y1[2] += d1[2] * bf_lo(uu.w); y1[3] += d1[3] * bf_hi(uu.w);
#pragma unroll
                for (int j = 0; j < 4; ++j) { y0[j] = gelu_f(y0[j]); y1[j] = gelu_f(y1[j]); }
                const int chunk = row & 511, token = chunk * 32 + jl;
                *(u32x4*)(GY + (size_t)token * 512 + g * 16 + h0) = pack8(y0, y1); }
    }
};
struct EpiGLU {
    static constexpr bool PERM = true, AFTER_DRAIN = false;
    const bf16_t* GY; const float* bias; bf16_t* MIX;
    __device__ __forceinline__ void operator()(const f32x4 (&acc)[2][2][4][2], const Unit& u, int wr, int wc, int fr, int fq) const {
        const int row0 = u.pm * BM + wr * 64 + fr, c0 = u.pn * HALF + wc * 32 + 8 * fq;
        const f32x4 b0 = *(const f32x4*)(bias + c0), b1 = *(const f32x4*)(bias + c0 + 4);
#pragma unroll
        for (int ai = 0; ai < 2; ++ai)
#pragma unroll
            for (int m = 0; m < 4; ++m) { const int row = row0 + ai * HALF + m * 16;
                const u32x4 gg = *(const u32x4*)(GY + (size_t)row * 512 + c0);
                const f32x4 a0 = acc[ai][0][m][0] + b0, a1 = acc[ai][0][m][1] + b1; f32x4 o0, o1;
                o0[0] = bf_lo(gg.x) * sigmoid_f(a0[0]); o0[1] = bf_hi(gg.x) * sigmoid_f(a0[1]); o0[2] = bf_lo(gg.y) * sigmoid_f(a0[2]); o0[3] = bf_hi(gg.y) * sigmoid_f(a0[3]);
                o1[0] = bf_lo(gg.z) * sigmoid_f(a1[0]); o1[1] = bf_hi(gg.z) * sigmoid_f(a1[1]); o1[2] = bf_lo(gg.w) * sigmoid_f(a1[2]); o1[3] = bf_hi(gg.w) * sigmoid_f(a1[3]);
                *(u32x4*)(MIX + (size_t)row * 1024 + c0) = pack8(o0, o1); }
    }
};
struct EpiBf16 {
    static constexpr bool PERM = true, AFTER_DRAIN = false;
    bf16_t* O; int ldc; float sc;
    __device__ __forceinline__ void operator()(const f32x4 (&acc)[2][2][4][2], const Unit& u, int wr, int wc, int fr, int fq) const {
        const int row0 = u.pm * BM + wr * 64 + fr, col0 = u.pn * BM + wc * 32 + 8 * fq;
#pragma unroll
        for (int ai = 0; ai < 2; ++ai)
#pragma unroll
            for (int m = 0; m < 4; ++m) { bf16_t* rowp = O + (size_t)(row0 + ai * HALF + m * 16) * ldc + col0;
#pragma unroll
                for (int bj = 0; bj < 2; ++bj) *(u32x4*)(rowp + bj * HALF) = pack8(acc[ai][bj][m][0] * sc, acc[ai][bj][m][1] * sc); }
    }
};

struct EpiPartF32 {
    static constexpr bool PERM = false, AFTER_DRAIN = false;
    float* P; float sc;
    __device__ __forceinline__ void operator()(const f32x4 (&acc)[2][2][4][2], const Unit& u, int wr, int wc, int fr, int fq) const {
        float* base = P + ((size_t)(u.pm * 7 + (u.pn >> 2)) * 256 + wr * 64 + fr) * 1024 + (u.pn & 3) * BM + wc * 32 + 4 * fq;
#pragma unroll
        for (int ai = 0; ai < 2; ++ai)
#pragma unroll
            for (int m = 0; m < 4; ++m) { float* rowp = base + (size_t)(ai * HALF + m * 16) * 1024;
#pragma unroll
                for (int bj = 0; bj < 2; ++bj)
#pragma unroll
                    for (int n = 0; n < 2; ++n) *(f32x4*)(rowp + bj * HALF + n * 16) = acc[ai][bj][m][n] * sc; }
    }
};

template <class Epi, class Sched, class GD, int MMODE = 0, bool ALIGN_EPI = true, bool SP2 = true>
__device__ __forceinline__ void gemm_phase(PG8_LAS unsigned char* lds, const GD& g, const Sched& S, const Epi& E, const int wid) {
    int lane_o; asm volatile("v_mbcnt_lo_u32_b32 %0, -1, 0\n\tv_mbcnt_hi_u32_b32 %0, -1, %0" : "=v"(lane_o));
    const int lane = lane_o, tid = wid * 64 + lane, wr = wid >> 2, wc = wid & 3, fr = lane & 15, fq = lane >> 4;
    const int K = g.K, nt = K / BK, lda = g.lda, ldb = g.ldb;
    unsigned voffA[2], voffB[2];
#pragma unroll
    for (int i = 0; i < 2; ++i) { int R, C; stage_rc(tid * 16 + i * 8192, R, C); const int Rb = Epi::PERM ? ((R & ~31) + perm32(R & 31)) : R;
        voffA[i] = (unsigned)(R * lda + C) * 2u; voffB[i] = (unsigned)(Rb * ldb + C) * 2u; }
    const size_t kstep = (size_t)(BK * 2);
    const size_t hstepA = (size_t)HALF * lda * 2, hstepB = (size_t)HALF * ldb * 2;
    const unsigned ldsw = (unsigned)wid * 1024u;
    const int aoff = lds_byte(wr * 64 + fr, fq * 8), boff = lds_byte(wc * 32 + fr, fq * 8);
#define PG8_SA(b, h) (((b) * 2 + (h)) * HTB)
#define PG8_SB(b, h) ((4 + (b) * 2 + (h)) * HTB)
#define PG8_STAGE(bufoff, gbase, voff) do { _Pragma("unroll") for (int _i = 0; _i < 2; ++_i) \
        __builtin_amdgcn_global_load_lds((const unsigned*)((const char*)(gbase) + (voff)[_i]), (PG8_LAS unsigned*)(lds + (bufoff) + ldsw + _i * 8192), 16, 0, 0); } while (0)
#define PG8_LDA(dst, b, h) do { if constexpr (MMODE == 0) { _Pragma("unroll") for (int m = 0; m < 4; ++m) _Pragma("unroll") for (int k = 0; k < 2; ++k) dst[m][k] = *(const PG8_LAS bf16x8*)(lds + PG8_SA(b, h) + aoff + m * 2048 + k * 1024); } \
        else { _Pragma("unroll") for (int m = 0; m < 4; ++m) dst##8[m] = cat8(*(const PG8_LAS bf16x8*)(lds + PG8_SA(b, h) + aoff + m * 2048), *(const PG8_LAS bf16x8*)(lds + PG8_SA(b, h) + aoff + m * 2048 + 1024)); } } while (0)
#define PG8_LDB(dst, b, h) do { if constexpr (MMODE == 0) { _Pragma("unroll") for (int n = 0; n < 2; ++n) _Pragma("unroll") for (int k = 0; k < 2; ++k) dst[n][k] = *(const PG8_LAS bf16x8*)(lds + PG8_SB(b, h) + boff + n * 2048 + k * 1024); } \
        else { _Pragma("unroll") for (int n = 0; n < 2; ++n) dst##8[n] = cat8(*(const PG8_LAS bf16x8*)(lds + PG8_SB(b, h) + boff + n * 2048), *(const PG8_LAS bf16x8*)(lds + PG8_SB(b, h) + boff + n * 2048 + 1024)); } } while (0)
#define PG8_MMA(ai, bj, At, Bt) do { __builtin_amdgcn_s_setprio(1); \
        if constexpr (MMODE == 0) { _Pragma("unroll") for (int m = 0; m < 4; ++m) _Pragma("unroll") for (int n = 0; n < 2; ++n) _Pragma("unroll") for (int k = 0; k < 2; ++k) \
            acc[ai][bj][m][n] = __builtin_amdgcn_mfma_f32_16x16x32_bf16(Bt[n][k], At[m][k], acc[ai][bj][m][n], 0, 0, 0); } \
        else { asm volatile("s_nop 1"); _Pragma("unroll") for (int m = 0; m < 4; ++m) _Pragma("unroll") for (int n = 0; n < 2; ++n) \
            asm volatile("v_mfma_scale_f32_16x16x128_f8f6f4 %0, %1, %2, %0, %3, %3 op_sel_hi:[0,0,0]" : "+v"(acc[ai][bj][m][n]) : "v"(Bt##8[n]), "v"(At##8[m]), "v"(f8one)); } \
        __builtin_amdgcn_s_setprio(0); } while (0)
#define PG8_WAIT_V(n) asm volatile("s_waitcnt vmcnt(" #n ")" ::: "memory")
#define PG8_WAIT_L(n) asm volatile("s_waitcnt lgkmcnt(" #n ")" ::: "memory")
#define PG8_BAR __builtin_amdgcn_s_barrier()
#define PG8_SCHED __builtin_amdgcn_sched_barrier(0)
    Unit cur, nxt; int ui = 0;
    if (!S.next(0, cur)) return;
    f32x4 acc[2][2][4][2];
#pragma unroll
    for (int a = 0; a < 2; ++a)
#pragma unroll
        for (int b = 0; b < 2; ++b)
#pragma unroll
            for (int m = 0; m < 4; ++m)
#pragma unroll
                for (int n = 0; n < 2; ++n) acc[a][b][m][n] = (f32x4){0.f, 0.f, 0.f, 0.f};
    const int f8one = 0x7f7f7f7f;
    bf16x8 At[4][2], B0[2][2], B1[2][2]; i32x8 At8[4], B08[2], B18[2];
    const char* cA = g.a_ptr(cur); const char* cB = g.b_ptr(cur);
    S.a_ready(cur);
    if constexpr (SP2) {
        PG8_STAGE(PG8_SB(0, 0), cB, voffB); PG8_STAGE(PG8_SB(0, 1), cB + hstepB, voffB); PG8_STAGE(PG8_SA(0, 0), cA, voffA); PG8_STAGE(PG8_SA(0, 1), cA + hstepA, voffA);
        if (wr == 1) PG8_BAR;
        PG8_WAIT_V(2); PG8_BAR;
        PG8_STAGE(PG8_SB(1, 0), cB + kstep, voffB); PG8_STAGE(PG8_SA(1, 0), cA + kstep, voffA); PG8_STAGE(PG8_SB(1, 1), cB + hstepB + kstep, voffB);
        PG8_WAIT_V(6); PG8_BAR;
    } else {
        PG8_STAGE(PG8_SB(0, 0), cB, voffB); PG8_STAGE(PG8_SA(0, 0), cA, voffA); PG8_STAGE(PG8_SB(0, 1), cB + hstepB, voffB); PG8_STAGE(PG8_SA(0, 1), cA + hstepA, voffA);
        if (wr == 1) PG8_BAR;
        PG8_WAIT_V(4); PG8_BAR;
        PG8_STAGE(PG8_SB(1, 0), cB + kstep, voffB); PG8_STAGE(PG8_SA(1, 0), cA + kstep, voffA); PG8_STAGE(PG8_SB(1, 1), cB + hstepB + kstep, voffB);
        PG8_WAIT_V(6); PG8_BAR;
    }
    for (;;) {
        const bool has_next = S.next(ui + 1, nxt);
        const char* nA = has_next ? g.a_ptr(nxt) : cA; const char* nB = has_next ? g.b_ptr(nxt) : cB;
        for (int t = 0; t < nt; t += 2) {
            const bool last = (t == nt - 2);
            const char* a1 = cA + (size_t)(t + 1) * kstep;
            const char* a2 = last ? nA : cA + (size_t)(t + 2) * kstep; const char* b2 = last ? nB : cB + (size_t)(t + 2) * kstep;
            const char* a3 = a2 + kstep; const char* b3 = b2 + kstep;
            if (last && has_next) S.a_ready(nxt);
            if constexpr (SP2) {
            PG8_LDB(B0, 0, 0); PG8_LDB(B1, 0, 1); PG8_SCHED; PG8_LDA(At, 0, 0); PG8_STAGE(PG8_SA(1, 1), a1 + hstepA, voffA);
            PG8_WAIT_V(8); PG8_WAIT_L(0); PG8_BAR; PG8_MMA(0, 0, At, B0); PG8_MMA(0, 1, At, B1); PG8_BAR; PG8_SCHED;
            PG8_LDA(At, 0, 1); PG8_STAGE(PG8_SB(0, 0), b2, voffB); PG8_STAGE(PG8_SB(0, 1), b2 + hstepB, voffB); PG8_STAGE(PG8_SA(0, 0), a2, voffA);
            PG8_WAIT_V(8); PG8_WAIT_L(0); PG8_BAR; PG8_MMA(1, 0, At, B0); PG8_MMA(1, 1, At, B1); PG8_BAR; PG8_SCHED;
            PG8_LDB(B0, 1, 0); PG8_LDB(B1, 1, 1); PG8_SCHED; PG8_LDA(At, 1, 0); PG8_STAGE(PG8_SA(0, 1), a2 + hstepA, voffA);
            PG8_WAIT_V(8); PG8_WAIT_L(0); PG8_BAR; PG8_MMA(0, 0, At, B0); PG8_MMA(0, 1, At, B1); PG8_BAR; PG8_SCHED;
            PG8_LDA(At, 1, 1); PG8_STAGE(PG8_SB(1, 0), b3, voffB); PG8_STAGE(PG8_SB(1, 1), b3 + hstepB, voffB); PG8_STAGE(PG8_SA(1, 0), a3, voffA);
            PG8_WAIT_V(8); PG8_WAIT_L(0); PG8_BAR; PG8_MMA(1, 0, At, B0); PG8_MMA(1, 1, At, B1); PG8_BAR; PG8_SCHED;
            } else {
            PG8_LDB(B0, 0, 0); PG8_SCHED; PG8_LDA(At, 0, 0); PG8_STAGE(PG8_SA(1, 1), a1 + hstepA, voffA);
            PG8_WAIT_L(8); PG8_BAR; PG8_WAIT_L(0); PG8_MMA(0, 0, At, B0); PG8_BAR; PG8_SCHED;
            PG8_LDB(B1, 0, 1); PG8_STAGE(PG8_SB(0, 0), b2, voffB);
            PG8_BAR; PG8_WAIT_L(0); PG8_MMA(0, 1, At, B1); PG8_BAR;
            PG8_LDA(At, 0, 1); PG8_STAGE(PG8_SA(0, 0), a2, voffA);
            PG8_BAR; PG8_WAIT_L(0); PG8_MMA(1, 0, At, B0); PG8_BAR; PG8_SCHED;
            PG8_STAGE(PG8_SB(0, 1), b2 + hstepB, voffB);
            PG8_WAIT_V(6); PG8_BAR; PG8_MMA(1, 1, At, B1); PG8_BAR;
            PG8_LDB(B0, 1, 0); PG8_SCHED; PG8_LDA(At, 1, 0); PG8_STAGE(PG8_SA(0, 1), a2 + hstepA, voffA);
            PG8_WAIT_L(8); PG8_BAR; PG8_WAIT_L(0); PG8_MMA(0, 0, At, B0); PG8_BAR; PG8_SCHED;
            PG8_LDB(B1, 1, 1); PG8_STAGE(PG8_SB(1, 0), b3, voffB);
            PG8_BAR; PG8_WAIT_L(0); PG8_MMA(0, 1, At, B1); PG8_BAR;
            PG8_LDA(At, 1, 1); PG8_STAGE(PG8_SA(1, 0), a3, voffA);
            PG8_BAR; PG8_WAIT_L(0); PG8_MMA(1, 0, At, B0); PG8_BAR; PG8_SCHED;
            PG8_STAGE(PG8_SB(1, 1), b3 + hstepB, voffB);
            PG8_WAIT_V(6); PG8_BAR; PG8_MMA(1, 1, At, B1); PG8_BAR;
            }
        }
        if constexpr (MMODE == 1) asm volatile("s_nop 15\n\ts_nop 15" ::: "memory");
        if constexpr (ALIGN_EPI) { if (wr == 0) PG8_BAR; }
        if constexpr (!Epi::AFTER_DRAIN) { E(acc, cur, wr, wc, fr, fq); S.done(cur); }
        if (!has_next) break;
#pragma unroll
        for (int a = 0; a < 2; ++a)
#pragma unroll
            for (int b = 0; b < 2; ++b)
#pragma unroll
                for (int m = 0; m < 4; ++m)
#pragma unroll
                    for (int n = 0; n < 2; ++n) acc[a][b][m][n] = (f32x4){0.f, 0.f, 0.f, 0.f};
        cur = nxt; cA = nA; cB = nB; ++ui;
        if constexpr (ALIGN_EPI) { if (wr == 1) PG8_BAR; }
    }
    PG8_WAIT_V(0);
    if constexpr (!ALIGN_EPI) { if (wr == 0) PG8_BAR; }
    PG8_BAR;
    if constexpr (Epi::AFTER_DRAIN) { E.fused(acc, cur, wr, wc, fr, fq, lds, wid, lane); S.done(cur); }
#undef PG8_SA
#undef PG8_SB
#undef PG8_STAGE
#undef PG8_LDA
#undef PG8_LDB
#undef PG8_MMA
#undef PG8_WAIT_V
#undef PG8_WAIT_L
#undef PG8_BAR
#undef PG8_SCHED
}
}

constexpr int NWAVES = 8;
constexpr int D = 1024, SEQ = 8192, M = 16384;
constexpr int FFN = 2816, EXD = 3584, NEXP = 8;
constexpr int XS_ROWS = 2 * M + NEXP * 256;
constexpr int MAXPAN = XS_ROWS / 256;
constexpr int NPH = 31;

constexpr size_t MiB = 1u << 20;
constexpr size_t WS_CTL = 0, CTL_ZERO_BYTES = 1 * MiB;
constexpr size_t WS_SMALL = 1 * MiB;
constexpr size_t SM_AT = 0;
constexpr size_t SM_TOKE = 64 * 1024;
constexpr size_t SM_TOKW = SM_TOKE + 128 * 1024;
constexpr size_t SM_TOKR = SM_TOKW + 128 * 1024;
constexpr size_t SM_TOKP = SM_TOKR + 128 * 1024;
constexpr size_t SM_RSTD = SM_TOKP + 128 * 1024;
constexpr size_t SM_WGCNT = SM_RSTD + 64 * 1024;
constexpr size_t SM_ROWG = SM_WGCNT + 8 * 1024;
constexpr size_t SM_PANEL = SM_ROWG + 192 * 1024;
constexpr size_t SM_SSQ = 1 * MiB;
constexpr size_t WS_WEIN = 9 * MiB;
constexpr size_t EV_EIN = 0, EV_EOUT = 4 * MiB, EV_E13 = 6 * MiB, EV_E2 = 17 * MiB, EV_STRIDE = 23 * MiB;
constexpr size_t WS_WODD = WS_WEIN + 2 * EV_STRIDE;
constexpr size_t OD_OIN = 0, OD_GLU = 3 * MiB, OD_OOUT = 4 * MiB, OD_SGU = 6 * MiB, OD_WST = 7 * MiB, OD_MY = 15 * MiB, OD_M13 = 35 * MiB, OD_M2 = 147 * MiB, OD_STRIDE = 203 * MiB;
constexpr size_t WS_HB = WS_WODD + 2 * OD_STRIDE;
constexpr size_t WS_ARENA = WS_HB + 32 * MiB;
constexpr size_t AR_UM = 0;
constexpr size_t AR_Z = 0, AR_MIX = 64 * MiB, AR_UF = 96 * MiB;
constexpr size_t AR_AG = 0, AR_SST = 20 * MiB, AR_ZUV = 32 * MiB, AR_GY = 96 * MiB;
constexpr size_t AR_XS = 238 * MiB;
constexpr size_t WS_PART = WS_ARENA + 306 * MiB;
constexpr size_t WS_END = WS_PART + 56 * MiB;
static_assert((size_t)XS_ROWS * EXD * 2 <= 238 * MiB && (size_t)XS_ROWS * D * 2 <= 68 * MiB, "arena");
static_assert(SM_PANEL + 1024 <= SM_SSQ && SM_SSQ + (size_t)M * 16 * 4 <= 8 * MiB, "small tables");
constexpr int CW_TMO = 0;
constexpr int CW_BAR = 4096;
constexpr int CW_QUEUE = 64;

constexpr int RING_OFF = 0, RING_BYTES = 131072;
constexpr int LDSCTL_OFF = RING_BYTES, MISC_OFF = LDSCTL_OFF + 320;
constexpr int PTAB_OFF = LDSCTL_OFF + 1024;
constexpr int RST_OFF = LDSCTL_OFF + 2048;
constexpr int RST_UNITS = 6;
constexpr int LDS_BYTES = 147456;

#define GAS __attribute__((address_space(1)))
#define LAS __attribute__((address_space(3)))
typedef unsigned short bf16;
typedef unsigned v4u __attribute__((ext_vector_type(4)));
typedef unsigned v2u __attribute__((ext_vector_type(2)));
typedef float f32x4 __attribute__((ext_vector_type(4)));
typedef short bf16x8 __attribute__((ext_vector_type(8)));
#define RLX_AGENT __ATOMIC_RELAXED, __HIP_MEMORY_SCOPE_AGENT
#define LDS_WAIT() asm volatile("s_waitcnt lgkmcnt(0)" ::: "memory")
#define VM_WAIT() asm volatile("s_waitcnt vmcnt(0)" ::: "memory")
__device__ __forceinline__ unsigned f2bf(float f) { unsigned u = __builtin_bit_cast(unsigned, f); return (u + 0x7fffu + ((u >> 16) & 1u)) >> 16; }
__device__ __forceinline__ unsigned pk2(float lo, float hi) { return f2bf(lo) | (f2bf(hi) << 16); }
__device__ __forceinline__ float bflo(unsigned w) { return __uint_as_float(w << 16); }
__device__ __forceinline__ float bfhi(unsigned w) { return __uint_as_float(w & 0xffff0000u); }

#define XB_TMO      128
#define XB_XCNT(j)  (256  + 64 * (j))
#define XB_XSUB(j)  (1280 + 64 * (j))
#define XB_XGEN(j)  (2304 + 64 * (j))
#define XB_TOP      3328
#define XB_TOPGEN   3392
#define XCD_BAR_WORDS 3456
#define XB_SPIN_CAP (1u << 22)

__device__ __forceinline__ unsigned xb_ld(unsigned* p)              { return __hip_atomic_load(p, __ATOMIC_RELAXED, __HIP_MEMORY_SCOPE_AGENT); }
__device__ __forceinline__ unsigned xb_add(unsigned* p, unsigned v) { return __hip_atomic_fetch_add(p, v, __ATOMIC_RELAXED, __HIP_MEMORY_SCOPE_AGENT); }
__device__ __forceinline__ unsigned xb_xcc_id() { return (unsigned)__builtin_amdgcn_s_getreg((3 << 11) | 20) & 0xFu; }
#define XB_SPIN(cond, bar) do { unsigned _sp = 0; while (cond) { __builtin_amdgcn_s_sleep(1); \
    if ((++_sp & 255u) == 0u) { if (xb_ld(&(bar)[XB_TMO])) break; if (_sp > XB_SPIN_CAP) { atomicAdd(&(bar)[XB_TMO], 1u); break; } } } } while (0)

struct XcdBarrier { unsigned* bar; unsigned x; volatile LAS unsigned* st; };

__device__ __forceinline__ XcdBarrier xcd_barrier_post(unsigned* bar, volatile LAS unsigned* st) {
    XcdBarrier b; b.bar = bar; b.x = xb_xcc_id(); b.st = st;
    if (threadIdx.x == 0) (void)xb_add(&bar[XB_XCNT(b.x)], 1u);
    return b;
}
__device__ __forceinline__ void xcd_barrier_complete(unsigned* bar, unsigned x, unsigned& nloc, unsigned& nx) {
    const unsigned G = gridDim.x * gridDim.y * gridDim.z;
    unsigned sum, cnt, mine, sp = 0u;
    for (;;) {
        sum = 0u; cnt = 0u; mine = 0u;
#pragma unroll
        for (unsigned j = 0; j < 16; ++j) { const unsigned c = xb_ld(&bar[XB_XCNT(j)]); sum += c; cnt += (c > 0u) ? 1u : 0u; mine = (j == x) ? c : mine; }
        if (sum == G) break;
        __builtin_amdgcn_s_sleep(1);
        if ((++sp & 255u) == 0u) { if (xb_ld(&bar[XB_TMO])) break; if (sp > XB_SPIN_CAP) { atomicAdd(&bar[XB_TMO], 1u); break; } }
    }
    nloc = mine > 0u ? mine : 1u; nx = cnt > 0u ? cnt : 1u;
}
__device__ __forceinline__ void xcd_barrier(const XcdBarrier& b, const int wave_idx) {
    asm volatile("s_waitcnt vmcnt(0)" ::: "memory");
    __syncthreads();
    unsigned lane_b_; asm volatile("v_mbcnt_lo_u32_b32 %0, -1, 0\n\tv_mbcnt_hi_u32_b32 %0, -1, %0" : "=v"(lane_b_));
    if (wave_idx == 0 && lane_b_ == 0u) {
        unsigned* bar = b.bar;
        __builtin_amdgcn_s_waitcnt(0);
        unsigned nloc = b.st[0], nx = b.st[1];
        if (nloc == 0u) { xcd_barrier_complete(bar, b.x, nloc, nx); b.st[0] = nloc; b.st[1] = nx; }
        const unsigned old = __hip_atomic_fetch_add(&bar[XB_XSUB(b.x)], 1u, __ATOMIC_RELAXED, __HIP_MEMORY_SCOPE_WORKGROUP);
        const unsigned gen = old / nloc;
        if (old + 1u == (gen + 1u) * nloc) {
            __builtin_amdgcn_fence(__ATOMIC_RELEASE, "agent");
            asm volatile("s_waitcnt vmcnt(0)" ::: "memory");
            (void)xb_add(&bar[XB_TOP], 1u);
        }
        const unsigned target = (gen + 1u) * nx;
        asm volatile("buffer_inv sc1" ::: "memory");
        XB_SPIN(xb_ld(&bar[XB_TOP]) < target, bar);
        asm volatile("s_waitcnt vmcnt(0)" ::: "memory");
    }
    __syncthreads();
}

__device__ __forceinline__ float wave_sum(float v) {
#pragma unroll
    for (int o = 1; o < 64; o <<= 1) v += __shfl_xor(v, o);
    return v;
}
struct TTile { const float* src; const float* gain; unsigned char* dst; int ldw, ldo_b; float f8sc; };
__device__ __forceinline__ void sincos_turns(double turns, float& c, float& s) {
    const double fr = turns - __builtin_rint(turns);
    const float x = (float)fr * 6.283185307179586f;
    c = cosf(x); s = sinf(x);
}

#ifndef REP_P0
#define REP_P0 1
#endif
#ifndef REP_E2
#define REP_E2 1
#endif
#ifndef REP_SGU
#define REP_SGU 1
#endif
#ifndef REP_ROUTE
#define REP_ROUTE 1
#endif
#ifndef REP_BAR
#define REP_BAR 1
#endif
struct Args { const float* in[33]; float* out; unsigned char* ws; int ph_lo, ph_hi; };

__device__ __forceinline__ const float* in_ptr(int k) {
    const __attribute__((address_space(4))) char* ka = (const __attribute__((address_space(4))) char*)__builtin_amdgcn_kernarg_segment_ptr();
    int off = k * 8; asm volatile("" : "+s"(off));
    return *(const float* const __attribute__((address_space(4)))*)(ka + off);
}
#define INP(k) in_ptr(k)
#ifndef F8_LAST
#define F8_LAST 1
#endif
#ifndef F8_FROM
#define F8_FROM 0
#endif
#ifndef F8_FFN_FROM
#define F8_FFN_FROM 1
#endif
constexpr float F8_W13_SC = 32.f, F8_W2_SC = 64.f, F8_UM_SC = 16.f;
constexpr int TT_EV = 688, TT_OD = 5552, TT_LAYER = TT_EV + TT_OD, TT_EXP = 672, TT_TOTAL = 2 * TT_LAYER;
__device__ __forceinline__ TTile decode_tile(const Args& args, unsigned char* ws, int it) {
    const int li = it / TT_LAYER; int r = it % TT_LAYER;
    const float* W; const float* gain = nullptr; int ldw, nbn, ldo, mode = 0; unsigned char* WT; float f8sc = 0.f; int esz = 2;
    if (r < TT_EV) {
        unsigned char* wb = ws + WS_WEIN + li * EV_STRIDE;
        if (r < 96) { W = args.in[2] + (size_t)li * D * 2048; ldw = 2048; nbn = 12; gain = args.in[1] + li * D; WT = wb + EV_EIN; ldo = D; }
        else if (r < 160) { r -= 96; W = args.in[6] + (size_t)li * D * D; ldw = D; nbn = 8; WT = wb + EV_EOUT; ldo = D; }
        else if (r < 336) { r -= 160; W = args.in[8] + (size_t)li * D * FFN; ldw = FFN; nbn = 22; gain = args.in[7] + li * D; WT = wb + EV_E13; ldo = D; mode = 1; if (F8_LAST && li >= F8_FFN_FROM) { esz = 1; f8sc = F8_W13_SC; } }
        else if (r < 512) { r -= 336; W = args.in[9] + (size_t)li * D * FFN; ldw = FFN; nbn = 22; gain = args.in[7] + li * D; WT = wb + EV_E13; ldo = D; mode = 2; if (F8_LAST && li >= F8_FFN_FROM) { esz = 1; f8sc = F8_W13_SC; } }
        else { r -= 512; W = args.in[10] + (size_t)li * FFN * D; ldw = D; nbn = 8; WT = wb + EV_E2; ldo = FFN; if (F8_LAST && li >= F8_FFN_FROM) { esz = 1; f8sc = F8_W2_SC; } }
    } else {
        r -= TT_EV; unsigned char* wb = ws + WS_WODD + li * OD_STRIDE;
        if (r < 96) { W = args.in[12] + (size_t)li * D * 1536; ldw = 1536; nbn = 12; gain = args.in[11] + li * D; WT = wb + OD_OIN; ldo = D; }
        else if (r < 112) { r -= 96; W = args.in[21] + (size_t)li * 512 * 512; ldw = 512; nbn = 4; WT = wb + OD_GLU; ldo = 512; }
        else if (r < 176) { r -= 112; W = args.in[26] + (size_t)li * D * D; ldw = D; nbn = 8; WT = wb + OD_OOUT; ldo = D; }
        else { r -= 176; const int e = r / TT_EXP; r %= TT_EXP; const bool f8 = F8_LAST && li >= F8_FROM; if (f8) esz = 1;
            if (r < 224) { W = args.in[29] + ((size_t)li * NEXP + e) * D * EXD; ldw = EXD; nbn = 28; gain = args.in[27] + li * D; WT = wb + OD_M13 + (size_t)e * 2 * EXD * D * esz; ldo = D; mode = 1; if (f8) f8sc = F8_W13_SC; }
            else if (r < 448) { r -= 224; W = args.in[30] + ((size_t)li * NEXP + e) * D * EXD; ldw = EXD; nbn = 28; gain = args.in[27] + li * D; WT = wb + OD_M13 + (size_t)e * 2 * EXD * D * esz; ldo = D; mode = 2; if (f8) f8sc = F8_W13_SC; }
            else { r -= 448; W = args.in[31] + ((size_t)li * NEXP + e) * EXD * D; ldw = D; nbn = 8; WT = wb + OD_M2 + (size_t)e * D * EXD * esz; ldo = EXD; if (f8) f8sc = F8_W2_SC; } }
    }
    const int kb = r / nbn, nb = r % nbn, k0 = 128 * kb, n0 = 128 * nb;
    const size_t orow0 = mode == 0 ? (size_t)n0 : (size_t)(nb * 256 + (mode == 2 ? 128 : 0));
    TTile d; d.src = W + (size_t)k0 * ldw + n0; d.gain = gain ? gain + k0 : nullptr; d.ldw = ldw; d.f8sc = f8sc;
    d.dst = WT + (orow0 * ldo + k0) * esz; d.ldo_b = ldo * esz; return d;
}

__global__ void __launch_bounds__(NWAVES * 64, 2) trunk_fwd(Args args) {
    extern __shared__ __attribute__((aligned(16))) unsigned char lds_raw[];
    LAS unsigned char* lds = (LAS unsigned char*)lds_raw;
    volatile LAS unsigned* MISC = (volatile LAS unsigned*)(lds + MISC_OFF);
    const int G = gridDim.x, bx = blockIdx.x;
#define G_O ({ int g_ = G; asm volatile("" : "+s"(g_)); g_; })
#define BX_O ({ int b_ = bx; asm volatile("" : "+s"(b_)); b_; })
    const int wave_s = __builtin_amdgcn_readfirstlane((int)threadIdx.x >> 6);
#define PHASE_IDS int lane_o_; asm volatile("v_mbcnt_lo_u32_b32 %0, -1, 0\n\tv_mbcnt_hi_u32_b32 %0, -1, %0" : "=v"(lane_o_)); const int lane = lane_o_, wave = wave_s, tid = wave * 64 + lane; (void)tid;
#define P_ws ({ unsigned char* w_ = args.ws; asm volatile("" : "+s"(w_)); w_; })
#define P_ctl ((unsigned*)(P_ws + WS_CTL))
#define P_sm (P_ws + WS_SMALL)
#define P_SSQ ((float*)(P_ws + WS_SMALL + SM_SSQ))
#define P_HB ((bf16*)(P_ws + WS_HB))
#define P_arena (P_ws + WS_ARENA)
#define P_H ({ float* h_ = args.out; asm volatile("" : "+s"(h_)); h_; })
#define P_x_in INP(0)
#define P_wev (P_ws + WS_WEIN + lp * EV_STRIDE)
#define P_wod (P_ws + WS_WODD + lp * OD_STRIDE)
#define P_Z ((bf16*)(P_arena + AR_Z))
#define P_MIX ((bf16*)(P_arena + AR_MIX))
#define P_UF ((bf16*)(P_arena + AR_UF))
#define P_AG ((bf16*)(P_arena + AR_AG))
#define P_ZUV ((bf16*)(P_arena + AR_ZUV))
#define P_GY ((bf16*)(P_arena + AR_GY))
#define P_XS ((bf16*)(P_arena + AR_XS))
#define P_UM ((bf16*)(P_arena + AR_UM))
#define P_TOKE ((int*)(P_sm + SM_TOKE))
#define P_TOKW ((float*)(P_sm + SM_TOKW))
#define P_TOKR ((int*)(P_sm + SM_TOKR))
#define P_TOKP ((int*)(P_sm + SM_TOKP))
#define P_RSTD ((float*)(P_sm + SM_RSTD))
#define P_WGCNT ((int*)(P_sm + SM_WGCNT))
#define P_PANEL ((int*)(P_sm + SM_PANEL))
#define P_ROWT ((int*)(P_sm + SM_ROWG))

    for (int u = threadIdx.x; u < (LDS_BYTES - LDSCTL_OFF) / 4; u += NWAVES * 64) ((LAS unsigned*)(lds + LDSCTL_OFF))[u] = 0u;
    __syncthreads();
    (void)xcd_barrier_post(P_ctl + CW_BAR, MISC + 8);
    const int lo = args.ph_lo, hi = args.ph_hi;
#define IN(k) (lo <= (k) && (k) < hi)
#define RST_PREAMBLE(S) do { PHASE_IDS LAS float* rst_ = (LAS float*)(lds + RST_OFF); pg8::Unit u_; \
        for (int i_ = 0; i_ < RST_UNITS && (S).next(i_, u_); ++i_) { const int row_ = u_.pm * 256 + (tid >> 1); \
            const f32x4 a_ = *(const f32x4*)(P_SSQ + (size_t)row_ * 16 + (tid & 1) * 8), b_ = *(const f32x4*)(P_SSQ + (size_t)row_ * 16 + (tid & 1) * 8 + 4); \
            float s_ = ((a_[0] + a_[1]) + (a_[2] + a_[3])) + ((b_[0] + b_[1]) + (b_[2] + b_[3])); s_ += __shfl_xor(s_, 1); \
            if ((tid & 1) == 0) rst_[i_ * 256 + (tid >> 1)] = 1.0f / sqrtf(s_ * (1.0f / 1024.0f) + 1e-5f); } \
        __syncthreads(); } while (0)
#define SEAM(k) do { if (IN(k) && IN((k) + 1)) { for (int rb_ = 0; rb_ < REP_BAR; ++rb_) { XcdBarrier bar_; bar_.bar = P_ctl + CW_BAR; bar_.x = xb_xcc_id(); bar_.st = (volatile LAS unsigned*)(lds + MISC_OFF) + 8; xcd_barrier(bar_, wave_s); } } } while (0)

    for (int rep_ = 0; rep_ < REP_P0; ++rep_)
    if (IN(0)) {
        PHASE_IDS
        LAS float* scr = (LAS float*)(lds + RING_OFF + wave * 16384);
        const int gw = bx * NWAVES + wave, NGW = G * NWAVES;
        for (int task = bx; task < 64; task += G) {
            const int li = task >> 5, g = task & 31;
            LAS float* PWr = (LAS float*)(lds + RING_OFF);
            LAS float* PWi = PWr + 33 * 64;
            LAS float* BBr = PWi + 33 * 64;
            LAS float* BBi = BBr + 1024;
            LAS float* CRe = BBi + 1024;
            LAS float* CIm = CRe + 1024;
            LAS float* KT = CIm + 1024;
            __syncthreads();
            if (tid < 64) {
                const int p = tid; const int gp = (li * 32 + g) * 64 + p;
                const float lr = args.in[13][gp], lim = args.in[14][gp], dt = expf(args.in[15][li * 32 + g]);
                const float rho = lr * dt; const double td = (double)lim * (double)dt * 0.15915494309189535;
                for (int tau = 0; tau <= 32; ++tau) { float c, s; sincos_turns(td * (double)tau, c, s); const float mg = expf(rho * (float)tau); PWr[tau * 64 + p] = mg * c; PWi[tau * 64 + p] = mg * s; }
                float c1, s1, ch, sh; sincos_turns(td, c1, s1); sincos_turns(td * 0.5, ch, sh);
                const float mg = expf(rho), qr = expm1f(rho) * c1 - 2.0f * sh * sh, qi = mg * s1, den = lr * lr + lim * lim;
                const float fre = (qr * lr + qi * lim) / den, fim = (qi * lr - qr * lim) / den;
                for (int h = 0; h < 16; ++h) { const float br = args.in[16][(size_t)gp * 16 + h], bi = args.in[17][(size_t)gp * 16 + h]; BBr[p * 16 + h] = fre * br - fim * bi; BBi[p * 16 + h] = fre * bi + fim * br; }
                float* AT = (float*)(P_sm + SM_AT) + (size_t)gp * 2; AT[0] = PWr[32 * 64 + p]; AT[1] = PWi[32 * 64 + p];
            }
            for (int e = tid; e < 1024; e += 512) { CRe[e] = args.in[18][(size_t)(li * 32 + g) * 1024 + e]; CIm[e] = args.in[19][(size_t)(li * 32 + g) * 1024 + e]; }
            __syncthreads();
            for (int r = 0; r < 16; ++r) { const int o = tid + 512 * r, tau = o >> 8, hp = (o >> 4) & 15, h = o & 15; float a = 0.f;
                for (int p = 0; p < 64; ++p) { const float cr = CRe[hp * 64 + p], ci = CIm[hp * 64 + p], wr_ = PWr[tau * 64 + p], wi_ = PWi[tau * 64 + p];
                    const float car = cr * wr_ - ci * wi_, cai = cr * wi_ + ci * wr_; a += car * BBr[p * 16 + h] - cai * BBi[p * 16 + h]; }
                KT[o] = a; }
            __syncthreads();
            bf16* MY = (bf16*)(P_ws + WS_WODD + li * OD_STRIDE + OD_MY) + (size_t)g * 512 * 640;
            for (int r = 0; r < 80; ++r) { const int q = tid + 512 * r, n = q / 80, k0 = (q % 80) * 8, j = n >> 4, hp = n & 15; float v[8];
                if (k0 < 64) {
#pragma unroll
                    for (int e = 0; e < 8; ++e) { const int p = k0 + e; v[e] = CRe[hp * 64 + p] * PWr[(j + 1) * 64 + p] - CIm[hp * 64 + p] * PWi[(j + 1) * 64 + p]; }
                } else if (k0 < 128) {
#pragma unroll
                    for (int e = 0; e < 8; ++e) { const int p = k0 - 64 + e; v[e] = -(CRe[hp * 64 + p] * PWi[(j + 1) * 64 + p] + CIm[hp * 64 + p] * PWr[(j + 1) * 64 + p]); }
                } else { const int s = (k0 - 128) >> 4, h0 = (k0 - 128) & 15;
#pragma unroll
                    for (int e = 0; e < 8; ++e) v[e] = (s <= j) ? KT[(j - s) * 256 + hp * 16 + h0 + e] : 0.f; }
                v4u o; o.x = pk2(v[0], v[1]); o.y = pk2(v[2], v[3]); o.z = pk2(v[4], v[5]); o.w = pk2(v[6], v[7]);
                *(GAS v4u*)(MY + (size_t)n * 640 + k0) = o; }
            bf16* WST = (bf16*)(P_ws + WS_WODD + li * OD_STRIDE + OD_WST) + (size_t)g * 256 * 512;
            for (int r = 0; r < 32; ++r) { const int q = tid + 512 * r, n = q >> 6, k0 = (q & 63) * 8, s = k0 >> 4, h0 = k0 & 15; float v[8];
                if (n < 64) {
#pragma unroll
                    for (int e = 0; e < 8; ++e) v[e] = PWr[(31 - s) * 64 + n] * BBr[n * 16 + h0 + e] - PWi[(31 - s) * 64 + n] * BBi[n * 16 + h0 + e];
                } else if (n < 128) { const int p = n - 64;
#pragma unroll
                    for (int e = 0; e < 8; ++e) v[e] = PWr[(31 - s) * 64 + p] * BBi[p * 16 + h0 + e] + PWi[(31 - s) * 64 + p] * BBr[p * 16 + h0 + e];
                } else {
#pragma unroll
                    for (int e = 0; e < 8; ++e) v[e] = 0.f; }
                v4u o; o.x = pk2(v[0], v[1]); o.y = pk2(v[2], v[3]); o.z = pk2(v[4], v[5]); o.w = pk2(v[6], v[7]);
                *(GAS v4u*)(WST + (size_t)n * 512 + k0) = o; }
            __syncthreads();
        }
        for (int it = gw; it < 2 * 256; it += NGW) {
            const int li = it >> 8, r = it & 255, kb = r >> 4, gi = (r >> 2) & 3, db = r & 3, k = kb * 64 + lane;
            const float* wrow = args.in[2] + ((size_t)li * D + k) * 2048 + 1536 + gi * 128;
            const float* pw = args.in[4] + ((size_t)li * 4 + gi) * 128 * 128 + db * 32;
            float a[32];
#pragma unroll
            for (int d = 0; d < 32; ++d) a[d] = 0.f;
            for (int c4 = 0; c4 < 32; ++c4) { const f32x4 xv = *(const f32x4*)(wrow + c4 * 4);
#pragma unroll
                for (int cc = 0; cc < 4; ++cc) { const float xs = xv[cc]; const float* pr = pw + (size_t)(c4 * 4 + cc) * 128;
#pragma unroll
                    for (int d = 0; d < 32; ++d) a[d] += xs * pr[d]; } }
            const float gk = args.in[1][li * D + k];
            bf16* WT = (bf16*)(P_ws + WS_WEIN + li * EV_STRIDE + EV_EIN);
#pragma unroll
            for (int d = 0; d < 32; ++d) { const int n = gi * 128 + db * 32 + d; WT[(size_t)(1536 + n) * D + k] = (bf16)f2bf(a[d] * gk * args.in[5][li * 512 + n]); }
        }
        for (int q = bx * 512 + tid; q < 2 * 4 * 128 * 16; q += G * 512) {
            const int li = q >> 13, rem = q & 8191, hh = rem >> 11, i = (rem >> 4) & 127, j0 = (rem & 15) * 8;
            const float* src = args.in[24] + (((size_t)li * 4 + hh) * 128 + i) * 128 + j0;
            const f32x4 a = *(const f32x4*)src, b = *(const f32x4*)(src + 4);
            const bool keep = (j0 >> 6) <= (i >> 6);
            v4u o; o.x = keep ? pk2(a[0], a[1]) : 0u; o.y = keep ? pk2(a[2], a[3]) : 0u; o.z = keep ? pk2(b[0], b[1]) : 0u; o.w = keep ? pk2(b[2], b[3]) : 0u;
            *(GAS v4u*)((bf16*)(P_ws + WS_WODD + li * OD_STRIDE + OD_SGU) + ((size_t)hh * 128 + i) * 128 + j0) = o;
        }
        for (int m = gw; m < M; m += NGW) {
            const GAS f32x4* xr = (const GAS f32x4*)(args.in[0] + (size_t)m * D) + lane; f32x4 v[4]; float s = 0.f;
#pragma unroll
            for (int j = 0; j < 4; ++j) { v[j] = xr[64 * j]; s += (v[j].x * v[j].x + v[j].y * v[j].y) + (v[j].z * v[j].z + v[j].w * v[j].w); }
            s = wave_sum(s);
            GAS v2u* o8 = (GAS v2u*)(P_HB + (size_t)m * D) + lane;
#pragma unroll
            for (int j = 0; j < 4; ++j) { v2u w; w.x = pk2(v[j].x, v[j].y); w.y = pk2(v[j].z, v[j].w); o8[64 * j] = w; }
            if (lane < 16) P_SSQ[(size_t)m * 16 + lane] = lane == 0 ? s : 0.f;
        }
        {
            LAS float* tile = (LAS float*)(lds + RING_OFF); volatile LAS int* nxt = (volatile LAS int*)(lds + RING_OFF + 65536);
            unsigned* qctr = P_ctl + CW_QUEUE; int it = bx;
            const int lr = lane >> 5, nc4 = (lane & 31) * 4;
            const int cch = lane & 15, nro = lane >> 4;
#define TT_LOAD(RG, DD) do { _Pragma("unroll") for (int i = 0; i < 8; ++i) RG[i] = *(const f32x4*)((DD).src + (size_t)(wave * 16 + 2 * i + lr) * (DD).ldw + nc4); } while (0)
#define TT_STEP(RG, DD, ITC) do { \
                __syncthreads();                                                \
                _Pragma("unroll") for (int i = 0; i < 8; ++i) { const int k = wave * 16 + 2 * i + lr; *(LAS f32x4*)(tile + k * 128 + (nc4 ^ (((k >> 3) & 7) << 2))) = RG[i]; } \
                if (tid == 0) { nxt[0] = tk; tk = 2 * G + (int)__hip_atomic_fetch_add(qctr, 1u, RLX_AGENT); }     \
                __syncthreads(); \
                const int itn_ = nxt[0]; const TTile dc_ = DD; DD = decode_tile(args, P_ws, itn_ < TT_TOTAL ? itn_ : 0); \
                if (itn_ < TT_TOTAL) TT_LOAD(RG, DD); \
                f32x4 g0 = {1.f, 1.f, 1.f, 1.f}, g1 = {1.f, 1.f, 1.f, 1.f}; \
                if (dc_.gain) { g0 = *(const f32x4*)(dc_.gain + 8 * cch); g1 = *(const f32x4*)(dc_.gain + 8 * cch + 4); } \
                _Pragma("unroll") for (int i = 0; i < 4; ++i) { const int n = wave * 16 + i * 4 + nro; const int sw = n ^ ((cch & 7) << 2); const LAS float* s = tile + (8 * cch) * 128 + sw; \
                    const float e0 = s[0 * 128] * g0[0], e1 = s[1 * 128] * g0[1], e2 = s[2 * 128] * g0[2], e3 = s[3 * 128] * g0[3], e4 = s[4 * 128] * g1[0], e5 = s[5 * 128] * g1[1], e6 = s[6 * 128] * g1[2], e7 = s[7 * 128] * g1[3]; \
                    if (dc_.f8sc != 0.f) { const float q = dc_.f8sc; v2u o; o.x = pg8::pk4_fp8(e0 * q, e1 * q, e2 * q, e3 * q); o.y = pg8::pk4_fp8(e4 * q, e5 * q, e6 * q, e7 * q); \
                        *(GAS v2u*)(dc_.dst + (size_t)n * dc_.ldo_b + 8 * cch) = o; } \
                    else { v4u o; o.x = pk2(e0, e1); o.y = pk2(e2, e3); o.z = pk2(e4, e5); o.w = pk2(e6, e7); \
                        *(GAS v4u*)(dc_.dst + (size_t)n * dc_.ldo_b + 16 * cch) = o; } } \
                ITC = itn_; } while (0)
            int tk = 0; if (tid == 0) tk = 2 * G + (int)__hip_atomic_fetch_add(qctr, 1u, RLX_AGENT);
            f32x4 rgA[8], rgB[8]; int itA = bx, itB = bx + G;
            TTile dA = decode_tile(args, P_ws, itA < TT_TOTAL ? itA : 0), dB = decode_tile(args, P_ws, itB < TT_TOTAL ? itB : 0);
            if (itA < TT_TOTAL) TT_LOAD(rgA, dA);
            if (itB < TT_TOTAL) TT_LOAD(rgB, dB);
            for (;;) {
                if (itA < TT_TOTAL) TT_STEP(rgA, dA, itA);
                if (itB < TT_TOTAL) TT_STEP(rgB, dB, itB);
                if (itA >= TT_TOTAL && itB >= TT_TOTAL) break;
            }
#undef TT_LOAD
#undef TT_STEP
            __syncthreads();
        }
    }
    SEAM(0);

    for (int lp = 0; lp < 2; ++lp) {
        const int pb = 1 + lp * 15;
        if (IN(pb + 0)) {
            pg8::GDs g{P_HB, (const bf16*)(P_wev + EV_EIN), D, D, D, 30, 0}; pg8::Order S; S.init(M / 256, 2048 / 256, G_O, BX_O);
            RST_PREAMBLE(S);
            pg8::EpiScaleBf16 E{P_Z, 2048, (const LAS float*)(lds + RST_OFF)};
            pg8::gemm_phase<pg8::EpiScaleBf16, pg8::Order, pg8::GDs>(lds + RING_OFF, g, S, E, wave_s);
        }
        SEAM(pb + 0);
        for (int rep_ = 0; rep_ < REP_E2; ++rep_)
        if (IN(pb + 1)) {
            PHASE_IDS
            const float* cw = INP(3) + (size_t)lp * 3 * 512;
            const int cv = tid & 63, c0 = 8 * cv;
            f32x4 cwv[3][2];
#pragma unroll
            for (int k = 0; k < 3; ++k) { cwv[k][0] = *(const f32x4*)(cw + (2 - k) * 512 + c0); cwv[k][1] = *(const f32x4*)(cw + (2 - k) * 512 + c0 + 4); }
            const int gi = wave & 3;
            for (int vb = bx; vb < 256; vb += G) {
                for (int itx = 0; itx < 8; ++itx) {
                    const int tc = vb * 64 + itx * 8 + (tid >> 6), lc = tc & (SEQ - 1);
                    const bf16* zr = P_Z + (size_t)tc * 2048 + c0; const bool v1 = lc >= 1, v2 = lc >= 2;
                    const bf16* zr1 = v1 ? zr - 2048 : zr; const bf16* zr2 = v2 ? zr - 4096 : zr;
                    const v4u gb = *(const GAS v4u*)(zr), gc0 = *(const GAS v4u*)(zr + 512), xa0 = *(const GAS v4u*)(zr + 1024);
                    const v4u gc1 = *(const GAS v4u*)(zr1 + 512), xa1 = *(const GAS v4u*)(zr1 + 1024), gc2 = *(const GAS v4u*)(zr2 + 512), xa2 = *(const GAS v4u*)(zr2 + 1024);
                    const int t = vb * 64 + itx * 8 + 4 * (wave >> 2) + (lane >> 4), l = t & (SEQ - 1), pc0 = gi * 128 + 8 * (lane & 15);
                    const bf16* qr = P_Z + (size_t)t * 2048 + 1536 + pc0; float s[8];
#pragma unroll
                    for (int e = 0; e < 8; ++e) s[e] = 0.f;
                    v4u q0;
#define POOLW(WN) { v4u q[WN]; _Pragma("unroll") for (int k = 0; k < WN; ++k) q[k] = *(const GAS v4u*)(k <= l ? qr - (size_t)k * 2048 : qr); q0 = q[0]; \
                        _Pragma("unroll") for (int k = 0; k < WN; ++k) { const float mk = k <= l ? 1.f : 0.f; s[0] += mk * bflo(q[k].x); s[1] += mk * bfhi(q[k].x); s[2] += mk * bflo(q[k].y); s[3] += mk * bfhi(q[k].y); \
                            s[4] += mk * bflo(q[k].z); s[5] += mk * bfhi(q[k].z); s[6] += mk * bflo(q[k].w); s[7] += mk * bfhi(q[k].w); } }
                    if (gi == 0) POOLW(2) else if (gi == 1) POOLW(4) else if (gi == 2) POOLW(8) else POOLW(16)
#undef POOLW
                    {
                        const float m1 = v1 ? 1.f : 0.f, m2 = v2 ? 1.f : 0.f; float o[8];
#define CONV1(e, G0, X0, G1, X1, G2, X2, W) o[e] = cwv[0][(e) >> 2][(e) & 3] * W(G0) * W(X0) + m1 * cwv[1][(e) >> 2][(e) & 3] * W(G1) * W(X1) + m2 * cwv[2][(e) >> 2][(e) & 3] * W(G2) * W(X2)
                        CONV1(0, gc0.x, xa0.x, gc1.x, xa1.x, gc2.x, xa2.x, bflo); CONV1(1, gc0.x, xa0.x, gc1.x, xa1.x, gc2.x, xa2.x, bfhi);
                        CONV1(2, gc0.y, xa0.y, gc1.y, xa1.y, gc2.y, xa2.y, bflo); CONV1(3, gc0.y, xa0.y, gc1.y, xa1.y, gc2.y, xa2.y, bfhi);
                        CONV1(4, gc0.z, xa0.z, gc1.z, xa1.z, gc2.z, xa2.z, bflo); CONV1(5, gc0.z, xa0.z, gc1.z, xa1.z, gc2.z, xa2.z, bfhi);
                        CONV1(6, gc0.w, xa0.w, gc1.w, xa1.w, gc2.w, xa2.w, bflo); CONV1(7, gc0.w, xa0.w, gc1.w, xa1.w, gc2.w, xa2.w, bfhi);
#undef CONV1
                        v4u ov; ov.x = pk2(bflo(gb.x) * o[0], bfhi(gb.x) * o[1]); ov.y = pk2(bflo(gb.y) * o[2], bfhi(gb.y) * o[3]); ov.z = pk2(bflo(gb.z) * o[4], bfhi(gb.z) * o[5]); ov.w = pk2(bflo(gb.w) * o[6], bfhi(gb.w) * o[7]);
                        *(GAS v4u*)(P_MIX + (size_t)tc * 1024 + c0) = ov;
                    }
                    {
                        const int w = 2 << gi, cnt = (l + 1) < w ? (l + 1) : w; const float inv = 1.0f / (float)cnt;
                        v4u ov; ov.x = pk2(s[0] * inv - bflo(q0.x), s[1] * inv - bfhi(q0.x)); ov.y = pk2(s[2] * inv - bflo(q0.y), s[3] * inv - bfhi(q0.y));
                        ov.z = pk2(s[4] * inv - bflo(q0.z), s[5] * inv - bfhi(q0.z)); ov.w = pk2(s[6] * inv - bflo(q0.w), s[7] * inv - bfhi(q0.w));
                        *(GAS v4u*)(P_MIX + (size_t)t * 1024 + 512 + pc0) = ov;
                    }
                }
            }
        }
        SEAM(pb + 1);
        const bool ffn8 = F8_LAST && lp >= F8_FFN_FROM;
        if (IN(pb + 2)) {
            pg8::GDs g{P_MIX, (const bf16*)(P_wev + EV_EOUT), D, D, D, 30, 0}; pg8::Order S; S.init(M / 256, D / 256, G_O, BX_O);
            pg8::EpiResid<false> E{lp == 0 ? P_x_in : (const float*)P_H, P_H, P_HB, P_SSQ, 1.0f, ffn8 ? (unsigned char*)P_Z : nullptr};
            pg8::gemm_phase<pg8::EpiResid<false>, pg8::Order, pg8::GDs>(lds + RING_OFF, g, S, E, wave_s);
        }
        SEAM(pb + 2);
        if (IN(pb + 3)) {
            pg8::Order S; S.init(M / 256, FFN / 128, G_O, BX_O);
            RST_PREAMBLE(S);
            if (ffn8) {
                pg8::GDs g{P_Z, (const bf16*)(P_wev + EV_E13), D / 2, D / 2, D / 2, 30, 0};
                pg8::EpiSwiGLUF8<true> E{(unsigned char*)P_UF, FFN, 1.0f / F8_W13_SC, F8_UM_SC, (const LAS float*)(lds + RST_OFF)};
                pg8::gemm_phase<pg8::EpiSwiGLUF8<true>, pg8::Order, pg8::GDs, 1>(lds + RING_OFF, g, S, E, wave_s);
            } else {
                pg8::GDs g{P_HB, (const bf16*)(P_wev + EV_E13), D, D, D, 30, 0};
                pg8::EpiSwiGLU<false> E{P_UF, FFN, (const LAS float*)(lds + RST_OFF)};
                pg8::gemm_phase<pg8::EpiSwiGLU<false>, pg8::Order, pg8::GDs>(lds + RING_OFF, g, S, E, wave_s);
            }
        }
        SEAM(pb + 3);
        if (IN(pb + 4)) {
            pg8::Order S; S.init(M / 256, D / 256, G_O, BX_O);
            if (ffn8) {
                pg8::GDs g{P_UF, (const bf16*)(P_wev + EV_E2), FFN / 2, FFN / 2, FFN / 2, 30, 0};
                pg8::EpiResid<true> E{P_H, P_H, P_HB, P_SSQ, 1.0f / (F8_UM_SC * F8_W2_SC), nullptr};
                pg8::gemm_phase<pg8::EpiResid<true>, pg8::Order, pg8::GDs, 1>(lds + RING_OFF, g, S, E, wave_s);
            } else {
                pg8::GDs g{P_UF, (const bf16*)(P_wev + EV_E2), FFN, FFN, FFN, 30, 0};
                pg8::EpiResid<false> E{P_H, P_H, P_HB, P_SSQ, 1.0f, nullptr};
                pg8::gemm_phase<pg8::EpiResid<false>, pg8::Order, pg8::GDs>(lds + RING_OFF, g, S, E, wave_s);
            }
        }
        SEAM(pb + 4);
        if (IN(pb + 5)) {
            pg8::GDs g{P_HB, (const bf16*)(P_wod + OD_OIN), D, D, D, 30, 0}; pg8::Order S; S.init(M / 256, 1536 / 256, G_O, BX_O);
            RST_PREAMBLE(S);
            pg8::EpiOddIn E{P_AG, P_ZUV, (const LAS float*)(lds + RST_OFF)};
            pg8::gemm_phase<pg8::EpiOddIn, pg8::Order, pg8::GDs>(lds + RING_OFF, g, S, E, wave_s);
        }
        SEAM(pb + 5);
        if (IN(pb + 6)) {
            const int NS5 = G >= 128 ? 64 : 0;
            if (NS5 == 0 || bx < NS5) {
                pg8::GDs g{P_AG + 128, (const bf16*)(P_wod + OD_WST), 640, 512, 512, 1, (size_t)256 * 512}; pg8::Order S; S.init(64, 1, NS5 ? NS5 : G_O, BX_O);
                pg8::EpiS5Scan E{P_AG, (const float*)(P_sm + SM_AT) + (size_t)lp * 32 * 64 * 2};
                pg8::gemm_phase<pg8::EpiS5Scan, pg8::Order, pg8::GDs>(lds + RING_OFF, g, S, E, wave_s);
            }
            for (int rep_ = 0; rep_ < REP_SGU; ++rep_)
            if (NS5 == 0 || bx >= NS5) {
                PHASE_IDS
                const int nwk = NS5 ? G - NS5 : G, wk = NS5 ? bx - NS5 : bx;
                LAS bf16* vT = (LAS bf16*)(lds + RING_OFF);
                const bf16* Wm = (const bf16*)(P_wod + OD_SGU);
                const float* lng = INP(23) + lp * 512; const float* sb = INP(25) + lp * 512;
                const int j_ln = tid >> 2, cq = tid & 3, fr = lane & 15, fq = lane >> 4, i_pos = wave * 16 + fr;
                for (int un = wk; un < 512; un += nwk) {
                    const int nb = un >> 2, hh = un & 3;
                    v4u vraw[4];
                    { const bf16* src = P_ZUV + (size_t)(nb * 128 + j_ln) * 1024 + 512 + hh * 128 + cq * 32;
#pragma unroll
                      for (int q4 = 0; q4 < 4; ++q4) vraw[q4] = *(const GAS v4u*)(src + q4 * 8); }
                    bf16x8 wf[4];
#pragma unroll
                    for (int ks = 0; ks < 4; ++ks) wf[ks] = *(const GAS bf16x8*)(Wm + ((size_t)hh * 128 + i_pos) * 128 + ks * 32 + fq * 8);
                    const float bias = sb[hh * 128 + i_pos]; const size_t tok = (size_t)(nb * 128 + i_pos);
                    v2u uu[8];
#pragma unroll
                    for (int ct = 0; ct < 8; ++ct) uu[ct] = *(const GAS v2u*)(P_ZUV + tok * 1024 + hh * 128 + ct * 16 + fq * 4);
                    __syncthreads();
                    {
                        float v[32]; float s = 0.f;
#pragma unroll
                        for (int q4 = 0; q4 < 4; ++q4) { const v4u w = vraw[q4];
                            v[q4 * 8 + 0] = bflo(w.x); v[q4 * 8 + 1] = bfhi(w.x); v[q4 * 8 + 2] = bflo(w.y); v[q4 * 8 + 3] = bfhi(w.y);
                            v[q4 * 8 + 4] = bflo(w.z); v[q4 * 8 + 5] = bfhi(w.z); v[q4 * 8 + 6] = bflo(w.w); v[q4 * 8 + 7] = bfhi(w.w); }
#pragma unroll
                        for (int e = 0; e < 32; ++e) s += v[e];
                        s += __shfl_xor(s, 1); s += __shfl_xor(s, 2);
                        const float mu = s * (1.0f / 128.0f); float q = 0.f;
#pragma unroll
                        for (int e = 0; e < 32; ++e) { v[e] -= mu; q += v[e] * v[e]; }
                        q += __shfl_xor(q, 1); q += __shfl_xor(q, 2);
                        const float rstd = 1.0f / sqrtf(q * (1.0f / 128.0f) + 1e-5f);
#pragma unroll
                        for (int e = 0; e < 32; ++e) { const int c = cq * 32 + e; vT[c * 136 + j_ln] = (bf16)f2bf(v[e] * rstd * lng[hh * 128 + c]); }
                    }
                    __syncthreads();
                    {
                        f32x4 acc[8];
#pragma unroll
                        for (int ct = 0; ct < 8; ++ct) acc[ct] = (f32x4){0.f, 0.f, 0.f, 0.f};
#pragma unroll
                        for (int ks = 0; ks < 4; ++ks) {
#pragma unroll
                            for (int ct = 0; ct < 8; ++ct) { const bf16x8 vf = *(const LAS bf16x8*)(vT + (ct * 16 + fr) * 136 + ks * 32 + fq * 8);
                                acc[ct] = __builtin_amdgcn_mfma_f32_16x16x32_bf16(vf, wf[ks], acc[ct], 0, 0, 0); }
                        }
#pragma unroll
                        for (int ct = 0; ct < 8; ++ct) { const int c = ct * 16 + fq * 4;
                            v2u o; o.x = pk2(bflo(uu[ct].x) * (acc[ct][0] + bias), bfhi(uu[ct].x) * (acc[ct][1] + bias)); o.y = pk2(bflo(uu[ct].y) * (acc[ct][2] + bias), bfhi(uu[ct].y) * (acc[ct][3] + bias));
                            *(GAS v2u*)(P_MIX + tok * 1024 + 512 + hh * 128 + c) = o; }
                    }
                }
                __syncthreads();
            }
        }
        SEAM(pb + 6);
        if (IN(pb + 7)) {
            pg8::GDh g{P_AG, (const bf16*)(P_wod + OD_MY), 640, 640, 640, 1, (size_t)512 * 640}; pg8::Order S; S.init(64, 4, G_O, BX_O);
            pg8::EpiS5Y E{P_AG, INP(20) + lp * 512, P_GY};
            pg8::gemm_phase<pg8::EpiS5Y, pg8::Order, pg8::GDh>(lds + RING_OFF, g, S, E, wave_s);
        }
        SEAM(pb + 7);
        if (IN(pb + 8)) {
            pg8::GDh g{P_GY, (const bf16*)(P_wod + OD_GLU), 512, 512, 512, 30, 0}; pg8::Order S; S.init(M / 256, 4, G_O, BX_O);
            pg8::EpiGLU E{P_GY, INP(22) + lp * 512, P_MIX};
            pg8::gemm_phase<pg8::EpiGLU, pg8::Order, pg8::GDh>(lds + RING_OFF, g, S, E, wave_s);
        }
        SEAM(pb + 8);
        if (IN(pb + 9)) {
            pg8::GDs g{P_MIX, (const bf16*)(P_wod + OD_OOUT), D, D, D, 30, 0}; pg8::Order S; S.init(M / 256, D / 256, G_O, BX_O);
            pg8::EpiResid<false> E{P_H, P_H, nullptr, nullptr, 1.0f, nullptr};
            pg8::gemm_phase<pg8::EpiResid<false>, pg8::Order, pg8::GDs>(lds + RING_OFF, g, S, E, wave_s);
        }
        SEAM(pb + 9);
        for (int rep_ = 0; rep_ < REP_ROUTE; ++rep_)
        if (IN(pb + 10)) {
            PHASE_IDS
            LAS int* tE = (LAS int*)(lds + RING_OFF);
            const float* Wr = INP(28) + (size_t)lp * D * 8; const float* g2 = INP(27) + lp * D;
            float gw[4][4][8];
#pragma unroll
            for (int j = 0; j < 4; ++j) { const f32x4 gv = *(const f32x4*)(g2 + 256 * j + 4 * lane);
#pragma unroll
                for (int i = 0; i < 4; ++i) { const float* wp = Wr + (size_t)(256 * j + 4 * lane + i) * 8; const f32x4 w0 = *(const f32x4*)wp, w1 = *(const f32x4*)(wp + 4);
#pragma unroll
                    for (int e = 0; e < 4; ++e) { gw[j][i][e] = w0[e] * gv[i]; gw[j][i][4 + e] = w1[e] * gv[i]; } } }
            const bool b0 = lane & 1, b1 = lane & 2, b2 = lane & 4;
            __syncthreads();
            for (int vb = bx; vb < 256; vb += G) {
                for (int tt = 0; tt < 8; tt += 2) {
                    const int tl = wave * 8 + tt, t = vb * 64 + tl;
                    const GAS f32x4* hr = (const GAS f32x4*)(P_H + (size_t)t * D) + lane;
                    f32x4 hv2[2][4];
#pragma unroll
                    for (int q = 0; q < 2; ++q)
#pragma unroll
                        for (int j = 0; j < 4; ++j) hv2[q][j] = hr[q * 256 + 64 * j];
#pragma unroll
                    for (int q = 0; q < 2; ++q) {
                        float lg[8]; float ss = 0.f;
#pragma unroll
                        for (int e = 0; e < 8; ++e) lg[e] = 0.f;
#pragma unroll
                        for (int j = 0; j < 4; ++j) { const f32x4 hv = hv2[q][j]; ss += (hv.x * hv.x + hv.y * hv.y) + (hv.z * hv.z + hv.w * hv.w);
#pragma unroll
                            for (int i = 0; i < 4; ++i) { const float hvi = hv[i];
#pragma unroll
                                for (int e = 0; e < 8; ++e) lg[e] += hvi * gw[j][i][e]; } }
                        ss = wave_sum(ss);
                        float ra[4], rb[2], rc;
#pragma unroll
                        for (int qq = 0; qq < 4; ++qq) { const float mine = b0 ? lg[4 + qq] : lg[qq], oth = b0 ? lg[qq] : lg[4 + qq]; ra[qq] = mine + __shfl_xor(oth, 1); }
#pragma unroll
                        for (int r = 0; r < 2; ++r) { const float mine = b1 ? ra[2 + r] : ra[r], oth = b1 ? ra[r] : ra[2 + r]; rb[r] = mine + __shfl_xor(oth, 2); }
                        { const float mine = b2 ? rb[1] : rb[0], oth = b2 ? rb[0] : rb[1]; rc = mine + __shfl_xor(oth, 4); }
                        rc += __shfl_xor(rc, 8); rc += __shfl_xor(rc, 16); rc += __shfl_xor(rc, 32);
                        const float rstd = 1.0f / sqrtf(ss * (1.0f / 1024.0f) + 1e-5f);
                        float lv[8];
#pragma unroll
                        for (int e = 0; e < 8; ++e) lv[e] = __shfl(rc, (e >> 2) + 2 * ((e >> 1) & 1) + 4 * (e & 1)) * rstd;
                        int e0 = 0; float v0 = lv[0];
#pragma unroll
                        for (int e = 1; e < 8; ++e) { if (lv[e] > v0) { v0 = lv[e]; e0 = e; } }
                        int e1 = -1; float v1 = 0.f;
#pragma unroll
                        for (int e = 0; e < 8; ++e) { if (e != e0 && (e1 < 0 || lv[e] > v1)) { v1 = lv[e]; e1 = e; } }
                        const float ex = __expf(v1 - v0), w0 = 1.0f / (1.0f + ex), w1 = ex * w0;
                        if (lane == 0) { tE[(tl + q) * 2] = e0; tE[(tl + q) * 2 + 1] = e1; P_TOKE[(t + q) * 2] = e0; P_TOKE[(t + q) * 2 + 1] = e1; P_TOKW[(t + q) * 2] = w0; P_TOKW[(t + q) * 2 + 1] = w1; P_RSTD[t + q] = rstd; }
                    }
                }
                __syncthreads();
                if (wave == 0) { const int e0 = tE[lane * 2], e1 = tE[lane * 2 + 1], t = vb * 64 + lane; int r0 = 0, r1 = 0;
#pragma unroll
                    for (int e = 0; e < 8; ++e) { const unsigned long long mk = __ballot(e0 == e || e1 == e); const int rk = __popcll(mk & ((1ull << lane) - 1ull));
                        if (e0 == e) r0 = rk; if (e1 == e) r1 = rk; if (lane == 0) P_WGCNT[vb * 8 + e] = __popcll(mk); }
                    P_TOKR[t * 2] = r0; P_TOKR[t * 2 + 1] = r1; }
                __syncthreads();
            }
        }
        SEAM(pb + 10);
        for (int rep_ = 0; rep_ < REP_ROUTE; ++rep_)
        if (IN(pb + 11)) {
            PHASE_IDS
            const bool f8 = F8_LAST && lp >= F8_FROM;
            LAS int* cntT = (LAS int*)(lds + RING_OFF);
            LAS int* pre = cntT + 32;
            __syncthreads();
            {
                const int e = wave; int s = 0;
#pragma unroll
                for (int i = 0; i < 4; ++i) s += P_WGCNT[(lane * 4 + i) * 8 + e];
#pragma unroll
                for (int o = 1; o < 64; o <<= 1) s += __shfl_xor(s, o);
                if (lane == 0) { cntT[e] = s; cntT[16 + e] = (s + 255) & ~255; }
            }
            __syncthreads();
            if (tid == 0) { int b = 0; for (int e = 0; e < 8; ++e) { cntT[8 + e] = b; b += cntT[16 + e]; } cntT[24] = b >> 8; }
            __syncthreads();
            if (bx == 0) { const int np = cntT[24];
                if (tid < MAXPAN) { int ex = 0; for (int e = 0; e < 8; ++e) if (tid * 256 >= cntT[8 + e]) ex = e; P_PANEL[tid] = tid < np ? ex : 0; }
                if (tid == 0) P_PANEL[MAXPAN] = np; }
            for (int e = bx; e < 8; e += G) {
                const int r0 = cntT[8 + e] + cntT[e], r1 = cntT[8 + e] + cntT[16 + e];
                if (tid < r1 - r0 && r0 + tid >= 128 * 256) P_ROWT[r0 + tid] = -1;
                if (f8) { for (int q = tid; q < (r1 - r0) * 64; q += 512) { const int r = r0 + (q >> 6); *(GAS v4u*)((unsigned char*)P_XS + (size_t)r * D + (q & 63) * 16) = (v4u){0u, 0u, 0u, 0u}; } }
                else { for (int q = tid; q < (r1 - r0) * 128; q += 512) { const int r = r0 + (q >> 7); *(GAS v4u*)(P_XS + (size_t)r * D + (q & 127) * 8) = (v4u){0u, 0u, 0u, 0u}; } }
            }
            for (int vb = bx; vb < 256; vb += G) {
                __syncthreads();
                {   const int e = wave; int s = 0;
#pragma unroll
                    for (int i = 0; i < 4; ++i) { const int b2 = lane * 4 + i; s += b2 < vb ? P_WGCNT[b2 * 8 + e] : 0; }
#pragma unroll
                    for (int o = 1; o < 64; o <<= 1) s += __shfl_xor(s, o);
                    if (lane == 0) pre[e] = s; }
                __syncthreads();
                int mp0 = 0, mp1 = 0; float mrs = 0.f;
                if (lane < 8) { const int t = vb * 64 + wave * 8 + lane; const int e0 = P_TOKE[t * 2], e1 = P_TOKE[t * 2 + 1];
                    mp0 = cntT[8 + e0] + pre[e0] + P_TOKR[t * 2]; mp1 = cntT[8 + e1] + pre[e1] + P_TOKR[t * 2 + 1]; mrs = P_RSTD[t];
                    P_TOKP[t * 2] = mp0; P_TOKP[t * 2 + 1] = mp1; if (mp0 >= 128 * 256) P_ROWT[mp0] = t; if (mp1 >= 128 * 256) P_ROWT[mp1] = t; }
                for (int tt = 0; tt < 8; tt += 2) {
                    const int t = vb * 64 + wave * 8 + tt;
                    const GAS f32x4* hr = (const GAS f32x4*)(P_H + (size_t)t * D) + lane;
                    f32x4 hv2[2][4];
#pragma unroll
                    for (int q = 0; q < 2; ++q)
#pragma unroll
                        for (int j = 0; j < 4; ++j) hv2[q][j] = hr[q * 256 + 64 * j];
#pragma unroll
                    for (int q = 0; q < 2; ++q) {
                        const int p0 = __shfl(mp0, tt + q), p1 = __shfl(mp1, tt + q); const float rstd = __shfl(mrs, tt + q);
                        if (f8) { GAS unsigned* o0 = (GAS unsigned*)((unsigned char*)P_XS + (size_t)p0 * D) + lane; GAS unsigned* o1 = (GAS unsigned*)((unsigned char*)P_XS + (size_t)p1 * D) + lane;
#pragma unroll
                            for (int j = 0; j < 4; ++j) { const f32x4 hv = hv2[q][j]; const unsigned w = pg8::pk4_fp8(hv.x * rstd, hv.y * rstd, hv.z * rstd, hv.w * rstd); o0[64 * j] = w; o1[64 * j] = w; }
                        } else { GAS v2u* o0 = (GAS v2u*)(P_XS + (size_t)p0 * D) + lane; GAS v2u* o1 = (GAS v2u*)(P_XS + (size_t)p1 * D) + lane;
#pragma unroll
                            for (int j = 0; j < 4; ++j) { const f32x4 hv = hv2[q][j]; v2u w; w.x = pk2(hv.x * rstd, hv.y * rstd); w.y = pk2(hv.z * rstd, hv.w * rstd); o0[64 * j] = w; o1[64 * j] = w; } }
                    }
                }
            }
        }
        SEAM(pb + 11);
        LAS int* ptab = (LAS int*)(lds + PTAB_OFF);
        if (IN(pb + 12) || IN(pb + 13)) {
            PHASE_IDS
            __syncthreads();
            if (tid <= MAXPAN) ptab[tid] = (int)__hip_atomic_load((unsigned*)P_PANEL + tid, RLX_AGENT);
            __syncthreads();
        }
        if (IN(pb + 12)) {
            const int np = __builtin_amdgcn_readfirstlane(ptab[MAXPAN]);
            pg8::Order S; S.init(np, EXD / 128, G_O, BX_O);
            if (F8_LAST && lp >= F8_FROM) {
                pg8::GDt g{P_XS, (const bf16*)(P_wod + OD_M13), D / 2, D / 2, D / 2, (size_t)EXD * D, ptab};
                pg8::EpiSwiGLUF8<false> E{(unsigned char*)P_UM, EXD, 1.0f / F8_W13_SC, F8_UM_SC, nullptr};
                pg8::gemm_phase<pg8::EpiSwiGLUF8<false>, pg8::Order, pg8::GDt, 1>(lds + RING_OFF, g, S, E, wave_s);
            } else {
                pg8::GDt g{P_XS, (const bf16*)(P_wod + OD_M13), D, D, D, (size_t)2 * EXD * D, ptab};
                pg8::EpiSwiGLU<true> E{P_UM, EXD, nullptr};
                pg8::gemm_phase<pg8::EpiSwiGLU<true>, pg8::Order, pg8::GDt>(lds + RING_OFF, g, S, E, wave_s);
            }
        }
        SEAM(pb + 12);
        if (IN(pb + 13)) {
            const int np = __builtin_amdgcn_readfirstlane(ptab[MAXPAN]);
            if (F8_LAST && lp >= F8_FROM) {
                const float osc = 1.0f / (F8_UM_SC * F8_W2_SC);
                {   pg8::GDt g{P_UM, (const bf16*)(P_wod + OD_M2), EXD / 2, EXD / 2, EXD / 2, (size_t)D * EXD / 2, ptab}; pg8::Order S; S.init(np < 128 ? np : 128, D / 256, G_O, BX_O);
                    pg8::EpiBf16 E{P_XS, D, osc};
                    pg8::gemm_phase<pg8::EpiBf16, pg8::Order, pg8::GDt, 1>(lds + RING_OFF, g, S, E, wave_s); }
                if (np > 128) {
                    pg8::GDk g{P_UM, (const bf16*)(P_wod + OD_M2), EXD / 2, EXD / 2, 256, (size_t)D * EXD / 2, ptab, 128, 256}; pg8::Order S; S.init(np - 128, 28, G_O, BX_O);
                    pg8::EpiPartF32 E{(float*)(P_ws + WS_PART), osc};
                    pg8::gemm_phase<pg8::EpiPartF32, pg8::Order, pg8::GDk, 1>(lds + RING_OFF, g, S, E, wave_s); }
            } else {
                {
                    pg8::GDt g{P_UM, (const bf16*)(P_wod + OD_M2), EXD, EXD, EXD, (size_t)D * EXD, ptab}; pg8::Order S; S.init(np < 128 ? np : 128, D / 256, G_O, BX_O);
                    pg8::EpiBf16 E{P_XS, D, 1.0f};
                    pg8::gemm_phase<pg8::EpiBf16, pg8::Order, pg8::GDt>(lds + RING_OFF, g, S, E, wave_s); }
                if (np > 128) {
                    pg8::GDk g{P_UM, (const bf16*)(P_wod + OD_M2), EXD, EXD, 512, (size_t)D * EXD, ptab, 128, 512}; pg8::Order S; S.init(np - 128, 28, G_O, BX_O);
                    pg8::EpiPartF32 E{(float*)(P_ws + WS_PART), 1.0f};
                    pg8::gemm_phase<pg8::EpiPartF32, pg8::Order, pg8::GDk>(lds + RING_OFF, g, S, E, wave_s); }
            }
        }
        SEAM(pb + 13);
        if (IN(pb + 14)) {
            PHASE_IDS
            const int gw = bx * NWAVES + wave, NGW = G * NWAVES; const bf16* YC = P_XS; const float* fg = INP(32); const float* PART = (const float*)(P_ws + WS_PART);
            int mp0 = 0, mp1 = 0; float mw0 = 0.f, mw1 = 0.f;
            if (lane < 8 && gw + lane * NGW < M) { const int t = gw + lane * NGW; mp0 = P_TOKP[t * 2]; mp1 = P_TOKP[t * 2 + 1]; mw0 = P_TOKW[t * 2]; mw1 = P_TOKW[t * 2 + 1]; }
#define COMBINE_FIN(T, V, AV, BV, FAST, PP0, PP1, GW0, GW1) do { GAS f32x4* hr_ = (GAS f32x4*)(P_H + (size_t)(T) * D) + lane; float s_ = 0.f; \
                if (FAST) { _Pragma("unroll") for (int j = 0; j < 4; ++j) { V[j].x += GW0 * bflo(AV[j].x) + GW1 * bflo(BV[j].x); V[j].y += GW0 * bfhi(AV[j].x) + GW1 * bfhi(BV[j].x); V[j].z += GW0 * bflo(AV[j].y) + GW1 * bflo(BV[j].y); V[j].w += GW0 * bfhi(AV[j].y) + GW1 * bfhi(BV[j].y); } } \
                else { _Pragma("unroll") for (int sl = 0; sl < 2; ++sl) { const int p_ = sl ? PP1 : PP0; const float gwt_ = sl ? GW1 : GW0; \
                        if (p_ < 128 * 256) { const GAS v2u* y_ = (const GAS v2u*)(YC + (size_t)p_ * D) + lane; \
                            _Pragma("unroll") for (int j = 0; j < 4; ++j) { const v2u a_ = y_[64 * j]; V[j].x += gwt_ * bflo(a_.x); V[j].y += gwt_ * bfhi(a_.x); V[j].z += gwt_ * bflo(a_.y); V[j].w += gwt_ * bfhi(a_.y); } } \
                        else { const int q_ = (p_ - 128 * 256) >> 8, r_ = p_ & 255; \
                            for (int ks = 0; ks < 7; ++ks) { const GAS f32x4* y_ = (const GAS f32x4*)(PART + ((size_t)(q_ * 7 + ks) * 256 + r_) * D) + lane; \
                                _Pragma("unroll") for (int j = 0; j < 4; ++j) V[j] += gwt_ * y_[64 * j]; } } } } \
                _Pragma("unroll") for (int j = 0; j < 4; ++j) s_ += (V[j].x * V[j].x + V[j].y * V[j].y) + (V[j].z * V[j].z + V[j].w * V[j].w); \
                s_ = wave_sum(s_); \
                if (lp == 1) { const float rstd_ = 1.0f / sqrtf(s_ * (1.0f / 1024.0f) + 1e-5f); \
                    _Pragma("unroll") for (int j = 0; j < 4; ++j) { const f32x4 gv_ = *((const GAS f32x4*)fg + lane + 64 * j); f32x4 o_; o_.x = V[j].x * rstd_ * gv_.x; o_.y = V[j].y * rstd_ * gv_.y; o_.z = V[j].z * rstd_ * gv_.z; o_.w = V[j].w * rstd_ * gv_.w; hr_[64 * j] = o_; } } \
                else { GAS v2u* o8_ = (GAS v2u*)(P_HB + (size_t)(T) * D) + lane; \
                    _Pragma("unroll") for (int j = 0; j < 4; ++j) { hr_[64 * j] = V[j]; v2u w_; w_.x = pk2(V[j].x, V[j].y); w_.y = pk2(V[j].z, V[j].w); o8_[64 * j] = w_; } \
                    if (lane < 16) P_SSQ[(size_t)(T) * 16 + lane] = lane == 0 ? s_ : 0.f; } } while (0)
            for (int it = 0; it < 8; it += 2) {
                const int t0 = gw + it * NGW, t1 = t0 + NGW; if (t0 >= M) break;
                const bool ok1 = t1 < M;
                const int p00 = __shfl(mp0, it), p01 = __shfl(mp1, it), p10 = __shfl(mp0, it + 1), p11 = __shfl(mp1, it + 1);
                const float g00 = __shfl(mw0, it), g01 = __shfl(mw1, it), g10 = __shfl(mw0, it + 1), g11 = __shfl(mw1, it + 1);
                const bool fast0 = p00 < 128 * 256 && p01 < 128 * 256, fast1 = ok1 && p10 < 128 * 256 && p11 < 128 * 256;
                f32x4 v0[4], v1[4]; v2u a0[4], b0[4], a1[4], b1[4];
                const int t1c = ok1 ? t1 : t0;
                const GAS f32x4* hr0 = (const GAS f32x4*)(P_H + (size_t)t0 * D) + lane; const GAS f32x4* hr1 = (const GAS f32x4*)(P_H + (size_t)t1c * D) + lane;
                const GAS v2u* y00 = (const GAS v2u*)(YC + (size_t)(fast0 ? p00 : 0) * D) + lane; const GAS v2u* y01 = (const GAS v2u*)(YC + (size_t)(fast0 ? p01 : 0) * D) + lane;
                const GAS v2u* y10 = (const GAS v2u*)(YC + (size_t)(fast1 ? p10 : 0) * D) + lane; const GAS v2u* y11 = (const GAS v2u*)(YC + (size_t)(fast1 ? p11 : 0) * D) + lane;
#pragma unroll
                for (int j = 0; j < 4; ++j) { v0[j] = hr0[64 * j]; a0[j] = y00[64 * j]; b0[j] = y01[64 * j]; }
#pragma unroll
                for (int j = 0; j < 4; ++j) { v1[j] = hr1[64 * j]; a1[j] = y10[64 * j]; b1[j] = y11[64 * j]; }
                if (fast0) COMBINE_FIN(t0, v0, a0, b0, true, p00, p01, g00, g01);
                if (fast1) COMBINE_FIN(t1, v1, a1, b1, true, p10, p11, g10, g11);
            }
            {
                const int nrow = (int)__hip_atomic_load((unsigned*)P_PANEL + MAXPAN, RLX_AGENT) * 256;
                for (int r = 128 * 256 + gw; r < nrow; r += NGW) {
                    const int t = __builtin_amdgcn_readfirstlane(P_ROWT[r]); if (t < 0) continue;
                    const int q0 = __builtin_amdgcn_readfirstlane(P_TOKP[t * 2]), q1 = __builtin_amdgcn_readfirstlane(P_TOKP[t * 2 + 1]);
                    if ((q0 >= 128 * 256 ? q0 : q1) != r) continue;
                    const float h0 = P_TOKW[t * 2], h1 = P_TOKW[t * 2 + 1];
                    f32x4 v[4]; v2u ax[4], bx_[4]; const GAS f32x4* hrr = (const GAS f32x4*)(P_H + (size_t)t * D) + lane;
#pragma unroll
                    for (int j = 0; j < 4; ++j) { v[j] = hrr[64 * j]; ax[j] = (v2u){0u, 0u}; bx_[j] = (v2u){0u, 0u}; }
                    COMBINE_FIN(t, v, ax, bx_, false, q0, q1, h0, h1);
                }
            }
#undef COMBINE_FIN
        }
        if (lp == 0) SEAM(pb + 14);
    }
#undef IN
#undef SEAM
}

#ifndef MK_PER_PHASE
#define MK_PER_PHASE 0
#endif
extern "C" void kernel_launch(void* const* d_in, const int* in_sizes, int n_in, void* d_out, int out_size, void* d_ws, size_t ws_size, hipStream_t stream) {
    static int grid = 0;
    if (grid == 0) {
        if (n_in != 33 || out_size != M * D || ws_size < WS_END) { fprintf(stderr, "kernel_launch: unexpected shapes (n_in %d, out %d, ws %zu, need %zu)\n", n_in, out_size, ws_size, (size_t)WS_END); grid = -1; return; }
        int dev = 0, cus = 0, per_cu = 0;
        if (hipGetDevice(&dev) != hipSuccess || hipDeviceGetAttribute(&cus, hipDeviceAttributeMultiprocessorCount, dev) != hipSuccess) { grid = -1; return; }
        if (hipFuncSetAttribute((const void*)trunk_fwd, hipFuncAttributeMaxDynamicSharedMemorySize, LDS_BYTES) != hipSuccess) { fprintf(stderr, "kernel_launch: hipFuncSetAttribute failed\n"); grid = -1; return; }
        if (hipOccupancyMaxActiveBlocksPerMultiprocessor(&per_cu, (const void*)trunk_fwd, NWAVES * 64, LDS_BYTES) != hipSuccess || per_cu < 1) fprintf(stderr, "kernel_launch: occupancy query reports %d\n", per_cu);
        (void)hipGetLastError();
        grid = cus;
    }
    if (grid < 0) return;
    if (hipMemsetAsync((char*)d_ws + WS_CTL, 0, CTL_ZERO_BYTES, stream) != hipSuccess) return;
    Args a{};
    for (int i = 0; i < 33; ++i) a.in[i] = (const float*)d_in[i];
    a.out = (float*)d_out; a.ws = (unsigned char*)d_ws;
#if MK_PER_PHASE
    for (int p = 0; p < NPH; ++p) { a.ph_lo = p; a.ph_hi = p + 1; hipLaunchKernelGGL(trunk_fwd, dim3(grid), dim3(NWAVES * 64), LDS_BYTES, stream, a); }
#elif defined(PROBE_PRE_LO)
    for (int rp = 0; rp < PROBE_PRE_N; ++rp) { a.ph_lo = PROBE_PRE_LO; a.ph_hi = PROBE_PRE_HI; hipLaunchKernelGGL(trunk_fwd, dim3(grid), dim3(NWAVES * 64), LDS_BYTES, stream, a);
        (void)hipMemsetAsync((char*)d_ws + WS_CTL, 0, CTL_ZERO_BYTES, stream); }
    a.ph_lo = 0; a.ph_hi = NPH;
    hipLaunchKernelGGL(trunk_fwd, dim3(grid), dim3(NWAVES * 64), LDS_BYTES, stream, a);
#elif defined(PROBE_POST_LO)
    a.ph_lo = 0; a.ph_hi = NPH;
    hipLaunchKernelGGL(trunk_fwd, dim3(grid), dim3(NWAVES * 64), LDS_BYTES, stream, a);
    for (int rp = 0; rp < PROBE_POST_N; ++rp) { (void)hipMemsetAsync((char*)d_ws + WS_CTL, 0, CTL_ZERO_BYTES, stream);
        a.ph_lo = PROBE_POST_LO; a.ph_hi = PROBE_POST_HI; hipLaunchKernelGGL(trunk_fwd, dim3(grid), dim3(NWAVES * 64), LDS_BYTES, stream, a); }
#else
    a.ph_lo = 0; a.ph_hi = NPH;
    hipLaunchKernelGGL(trunk_fwd, dim3(grid), dim3(NWAVES * 64), LDS_BYTES, stream, a);
#endif
}
```

```cpp
#include <hip/hip_runtime.h>
#include <cstdio>
#include <cstdint>

namespace pg8 {
#define PG8_LAS __attribute__((address_space(3)))
typedef unsigned short bf16_t;
typedef short bf16x8 __attribute__((ext_vector_type(8)));
typedef float f32x4 __attribute__((ext_vector_type(4)));
typedef float f32x2 __attribute__((ext_vector_type(2)));
typedef unsigned u32x4 __attribute__((ext_vector_type(4)));
typedef unsigned u32x2 __attribute__((ext_vector_type(2)));
constexpr int BM = 256, BK = 64, HALF = 128, HTB = HALF * BK * 2  , STAGE_BYTES = 8 * HTB, NXCD = 8, WGM = 8;

__host__ __device__ __forceinline__ int lds_byte(int r, int c) { const int st = (r >> 4) * 2 + (c >> 5), rr = r & 15, cc = c & 31, ob = rr * 64 + cc * 2; return st * 1024 + (ob ^ (((ob >> 9) & 1) << 5)); }
__host__ __device__ __forceinline__ void stage_rc(int b, int& R, int& C) { const int st = b / 1024, sb = b % 1024, swz = sb ^ (((sb >> 9) & 1) << 5); R = (st >> 1) * 16 + swz / 64; C = (st & 1) * 32 + (swz % 64) / 2; }
__host__ __device__ __forceinline__ int perm32(int rho) { const int n = rho >> 4, i = rho & 15; return 8 * (i >> 2) + 4 * n + (i & 3); }

typedef int i32x4 __attribute__((ext_vector_type(4)));
typedef int i32x8 __attribute__((ext_vector_type(8)));
__device__ __forceinline__ i32x8 cat8(const bf16x8 a, const bf16x8 b) { return __builtin_shufflevector(__builtin_bit_cast(i32x4, a), __builtin_bit_cast(i32x4, b), 0, 1, 2, 3, 4, 5, 6, 7); }
__device__ __forceinline__ unsigned pk4_fp8(float a, float b, float c, float d) {
    a = __builtin_fminf(__builtin_fmaxf(a, -448.f), 448.f); b = __builtin_fminf(__builtin_fmaxf(b, -448.f), 448.f); c = __builtin_fminf(__builtin_fmaxf(c, -448.f), 448.f); d = __builtin_fminf(__builtin_fmaxf(d, -448.f), 448.f);
    int p = __builtin_amdgcn_cvt_pk_fp8_f32(a, b, 0, false); p = __builtin_amdgcn_cvt_pk_fp8_f32(c, d, p, true); return (unsigned)p;
}
struct Unit { int pm, pn, idx; };

struct Order {
    int nM, nN, nwg, G, c;
    __device__ __forceinline__ void init(int nM_, int nN_, int G_, int c_) { nM = nM_; nN = nN_; nwg = nM * nN; G = G_; c = c_; }
    __device__ __forceinline__ bool next(int i, Unit& u) const {
        const long L = (long)i * G + c; if (L >= nwg) return false;
        int wgid = (int)L; { const int q = nwg / NXCD, r = nwg % NXCD, xcd = wgid % NXCD, off = wgid / NXCD; wgid = (xcd < r ? xcd * (q + 1) : r * (q + 1) + (xcd - r) * q) + off; }
        const int nig = WGM * nN, gid = wgid / nig, fm = gid * WGM, gsz = (nM - fm) < WGM ? (nM - fm) : WGM;
        u.pm = fm + ((wgid % nig) % gsz); u.pn = (wgid % nig) / gsz; u.idx = i; return true;
    }
    __device__ __forceinline__ void a_ready(const Unit&) const {}
    __device__ __forceinline__ void done(const Unit&) const {}
};

struct GDs {
    const bf16_t* A; const bf16_t* Bt; int lda, ldb, K, gshift; size_t gstride;
    __device__ __forceinline__ const char* a_ptr(const Unit& u) const { return (const char*)(A + (size_t)u.pm * BM * lda); }
    __device__ __forceinline__ const char* b_ptr(const Unit& u) const { return (const char*)(Bt + (size_t)(u.pm >> gshift) * gstride + (size_t)u.pn * BM * ldb); }
};
struct GDh {
    const bf16_t* A; const bf16_t* Bt; int lda, ldb, K, gshift; size_t gstride;
    __device__ __forceinline__ const char* a_ptr(const Unit& u) const { return (const char*)(A + (size_t)u.pm * BM * lda); }
    __device__ __forceinline__ const char* b_ptr(const Unit& u) const { return (const char*)(Bt + (size_t)(u.pm >> gshift) * gstride + (size_t)u.pn * HALF * ldb); }
};
struct GDt {
    const bf16_t* A; const bf16_t* Bt; int lda, ldb, K; size_t gstride; const PG8_LAS int* tab;
    __device__ __forceinline__ const char* a_ptr(const Unit& u) const { return (const char*)(A + (size_t)u.pm * BM * lda); }
    __device__ __forceinline__ const char* b_ptr(const Unit& u) const { const int grp = __builtin_amdgcn_readfirstlane(tab[u.pm]); return (const char*)(Bt + (size_t)grp * gstride + (size_t)u.pn * BM * ldb); }
};

struct GDk {
    const bf16_t* A; const bf16_t* Bt; int lda, ldb, K; size_t gstride; const PG8_LAS int* tab; int pm0, ksl;
    __device__ __forceinline__ const char* a_ptr(const Unit& u) const { return (const char*)(A + (size_t)(pm0 + u.pm) * BM * lda + (size_t)(u.pn >> 2) * ksl); }
    __device__ __forceinline__ const char* b_ptr(const Unit& u) const { const int grp = __builtin_amdgcn_readfirstlane(tab[pm0 + u.pm]); return (const char*)(Bt + (size_t)grp * gstride + (size_t)(u.pn & 3) * BM * ldb + (size_t)(u.pn >> 2) * ksl); }
};

__device__ __forceinline__ unsigned cvt_pk_bf16(float lo, float hi) { unsigned r; asm volatile("v_cvt_pk_bf16_f32 %0, %1, %2" : "=v"(r) : "v"(lo), "v"(hi)); return r; }
__device__ __forceinline__ float bf_lo(unsigned w) { return __uint_as_float(w << 16); }
__device__ __forceinline__ float bf_hi(unsigned w) { return __uint_as_float(w & 0xffff0000u); }
__device__ __forceinline__ float sigmoid_f(float x) { return __builtin_amdgcn_rcpf(1.0f + __expf(-x)); }
__device__ __forceinline__ float silu_f(float x) { return x * sigmoid_f(x); }
__device__ __forceinline__ float gelu_f(float x) { const float z2 = 1.5957691216057308f * (x + 0.044715f * x * x * x); return x * sigmoid_f(z2); }

constexpr float RMS_EPS_F = 1e-5f;
__device__ __forceinline__ float row_rstd(const float* ssq, int row, int fq) {
    const f32x4 p = *(const f32x4*)(ssq + (size_t)row * 16 + 4 * fq);
    float s = (p[0] + p[1]) + (p[2] + p[3]);
    s += __shfl_xor(s, 16); s += __shfl_xor(s, 32);
    return 1.0f / sqrtf(s * (1.0f / 1024.0f) + RMS_EPS_F);
}
__device__ __forceinline__ void rows_rstd(const float* ssq, int row0, int fq, float (&rs)[2][4]) {
    f32x4 p[2][4];
#pragma unroll
    for (int ai = 0; ai < 2; ++ai)
#pragma unroll
        for (int m = 0; m < 4; ++m) p[ai][m] = *(const f32x4*)(ssq + (size_t)(row0 + ai * HALF + m * 16) * 16 + 4 * fq);
#pragma unroll
    for (int ai = 0; ai < 2; ++ai)
#pragma unroll
        for (int m = 0; m < 4; ++m) { float s = (p[ai][m][0] + p[ai][m][1]) + (p[ai][m][2] + p[ai][m][3]); s += __shfl_xor(s, 16); s += __shfl_xor(s, 32); rs[ai][m] = 1.0f / sqrtf(s * (1.0f / 1024.0f) + RMS_EPS_F); }
}
__device__ __forceinline__ void rows_rstd_lds(const PG8_LAS float* t, float (&rs)[2][4]) {
#pragma unroll
    for (int ai = 0; ai < 2; ++ai)
#pragma unroll
        for (int m = 0; m < 4; ++m) rs[ai][m] = t[ai * HALF + m * 16];
}
__device__ __forceinline__ u32x4 pack8(const f32x4& a, const f32x4& b) { u32x4 w; w.x = cvt_pk_bf16(a[0], a[1]); w.y = cvt_pk_bf16(a[2], a[3]); w.z = cvt_pk_bf16(b[0], b[1]); w.w = cvt_pk_bf16(b[2], b[3]); return w; }

struct EpiScaleBf16 {
    static constexpr bool PERM = true, AFTER_DRAIN = false;
    bf16_t* O; int ldc; const PG8_LAS float* rst;
    __device__ __forceinline__ void operator()(const f32x4 (&acc)[2][2][4][2], const Unit& u, int wr, int wc, int fr, int fq) const {
        const int row0 = u.pm * BM + wr * 64 + fr, col0 = u.pn * BM + wc * 32 + 8 * fq;
        float rsv[2][4]; rows_rstd_lds(rst + u.idx * 256 + wr * 64 + fr, rsv);
#pragma unroll
        for (int ai = 0; ai < 2; ++ai)
#pragma unroll
            for (int m = 0; m < 4; ++m) { const int row = row0 + ai * HALF + m * 16; const float rs = rsv[ai][m]; bf16_t* rowp = O + (size_t)row * ldc + col0;
#pragma unroll
                for (int bj = 0; bj < 2; ++bj) *(u32x4*)(rowp + bj * HALF) = pack8(acc[ai][bj][m][0] * rs, acc[ai][bj][m][1] * rs); }
    }
};
template <bool SCALED> struct EpiResid {
    static constexpr bool PERM = false, AFTER_DRAIN = false;
    const float* resid; float* H; bf16_t* HB; float* ssq; float sc; unsigned char* H8;
    __device__ __forceinline__ void operator()(const f32x4 (&acc)[2][2][4][2], const Unit& u, int wr, int wc, int fr, int fq) const {
        const int row0 = u.pm * BM + wr * 64 + fr, col0 = u.pn * BM + wc * 32 + 4 * fq;
#pragma unroll
        for (int ai = 0; ai < 2; ++ai)
#pragma unroll
            for (int m = 0; m < 4; ++m) { const int row = row0 + ai * HALF + m * 16; const size_t off = (size_t)row * 1024 + col0; float q = 0.f;
#pragma unroll
                for (int bj = 0; bj < 2; ++bj)
#pragma unroll
                    for (int n = 0; n < 2; ++n) { const f32x4 bs = *(const f32x4*)(resid + off + bj * HALF + n * 16); f32x4 o; if (SCALED) { const f32x4 a4 = acc[ai][bj][m][n]; o[0] = __builtin_fmaf(a4[0], sc, bs[0]); o[1] = __builtin_fmaf(a4[1], sc, bs[1]); o[2] = __builtin_fmaf(a4[2], sc, bs[2]); o[3] = __builtin_fmaf(a4[3], sc, bs[3]); } else o = bs + acc[ai][bj][m][n];
                        *(f32x4*)(H + off + bj * HALF + n * 16) = o;
                        if (HB) { u32x2 w; w.x = cvt_pk_bf16(o[0], o[1]); w.y = cvt_pk_bf16(o[2], o[3]); *(u32x2*)(HB + off + bj * HALF + n * 16) = w; q += (o[0] * o[0] + o[1] * o[1]) + (o[2] * o[2] + o[3] * o[3]); }
                        if (H8) *(unsigned*)(H8 + off + bj * HALF + n * 16) = pk4_fp8(o[0], o[1], o[2], o[3]); }
                if (HB) { q += __shfl_xor(q, 16); q += __shfl_xor(q, 32); if (fq == 0) ssq[(size_t)row * 16 + u.pn * 4 + wc] = q; }
                asm volatile("" ::: "memory"); }
    }
};
template <bool SCALED> struct EpiResidB {
    static constexpr bool PERM = true, AFTER_DRAIN = false;
    bf16_t* HB; float* ssq; float sc; unsigned char* H8;
    __device__ __forceinline__ void operator()(const f32x4 (&acc)[2][2][4][2], const Unit& u, int wr, int wc, int fr, int fq) const {
        const int row0 = u.pm * BM + wr * 64 + fr, col0 = u.pn * BM + wc * 32 + 8 * fq;
        u32x4 rs[2][2][2];
#define PG8_RLOAD(P, B) do { _Pragma("unroll") for (int g_ = 0; g_ < 2; ++g_) { const int gi_ = 2 * (P) + g_; \
            _Pragma("unroll") for (int bj = 0; bj < 2; ++bj) rs[B][g_][bj] = *(const u32x4*)(HB + (size_t)(row0 + (gi_ >> 2) * HALF + (gi_ & 3) * 16) * 1024 + col0 + bj * HALF); } } while (0)
        PG8_RLOAD(0, 0);
#pragma unroll
        for (int p = 0; p < 4; ++p) {
            if (p < 3) PG8_RLOAD(p + 1, (p + 1) & 1);
            asm volatile("" ::: "memory");
#pragma unroll
            for (int g = 0; g < 2; ++g) { const int gi = 2 * p + g, ai = gi >> 2, m = gi & 3; const int row = row0 + ai * HALF + m * 16; const size_t off = (size_t)row * 1024 + col0; float q = 0.f;
#pragma unroll
                for (int bj = 0; bj < 2; ++bj) { const u32x4 r = rs[p & 1][g][bj]; const f32x4 a0 = acc[ai][bj][m][0], a1 = acc[ai][bj][m][1]; f32x4 o0, o1;
                    if (SCALED) { o0[0] = __builtin_fmaf(a0[0], sc, bf_lo(r.x)); o0[1] = __builtin_fmaf(a0[1], sc, bf_hi(r.x)); o0[2] = __builtin_fmaf(a0[2], sc, bf_lo(r.y)); o0[3] = __builtin_fmaf(a0[3], sc, bf_hi(r.y));
                        o1[0] = __builtin_fmaf(a1[0], sc, bf_lo(r.z)); o1[1] = __builtin_fmaf(a1[1], sc, bf_hi(r.z)); o1[2] = __builtin_fmaf(a1[2], sc, bf_lo(r.w)); o1[3] = __builtin_fmaf(a1[3], sc, bf_hi(r.w)); }
                    else { o0[0] = a0[0] + bf_lo(r.x); o0[1] = a0[1] + bf_hi(r.x); o0[2] = a0[2] + bf_lo(r.y); o0[3] = a0[3] + bf_hi(r.y); o1[0] = a1[0] + bf_lo(r.z); o1[1] = a1[1] + bf_hi(r.z); o1[2] = a1[2] + bf_lo(r.w); o1[3] = a1[3] + bf_hi(r.w); }
                    *(u32x4*)(HB + off + bj * HALF) = pack8(o0, o1);
                    q += ((o0[0] * o0[0] + o0[1] * o0[1]) + (o0[2] * o0[2] + o0[3] * o0[3])) + ((o1[0] * o1[0] + o1[1] * o1[1]) + (o1[2] * o1[2] + o1[3] * o1[3]));
                    if (H8) { u32x2 w; w.x = pk4_fp8(o0[0], o0[1], o0[2], o0[3]); w.y = pk4_fp8(o1[0], o1[1], o1[2], o1[3]); *(u32x2*)(H8 + off + bj * HALF) = w; } }
                q += __shfl_xor(q, 16); q += __shfl_xor(q, 32); if (fq == 0) ssq[(size_t)row * 16 + u.pn * 4 + wc] = q; }
            asm volatile("" ::: "memory");
        }
#undef PG8_RLOAD
    }
};
template <bool MOE> struct EpiSwiGLU {
    static constexpr bool PERM = true, AFTER_DRAIN = false;
    bf16_t* U; int ldc; const PG8_LAS float* rst;
    __device__ __forceinline__ void operator()(const f32x4 (&acc)[2][2][4][2], const Unit& u, int wr, int wc, int fr, int fq) const {
        const int row0 = u.pm * BM + wr * 64 + fr, col0 = u.pn * HALF + wc * 32 + 8 * fq;
        float rsv[2][4];
        if (!MOE) rows_rstd_lds(rst + u.idx * 256 + wr * 64 + fr, rsv);
#pragma unroll
        for (int ai = 0; ai < 2; ++ai)
#pragma unroll
            for (int m = 0; m < 4; ++m) { const int row = row0 + ai * HALF + m * 16;
                const float rs = MOE ? 1.0f : rsv[ai][m], gw = 1.0f;
                f32x4 o0, o1;
#pragma unroll
                for (int j = 0; j < 4; ++j) { o0[j] = silu_f(acc[ai][0][m][0][j] * rs) * (acc[ai][1][m][0][j] * rs) * gw; o1[j] = silu_f(acc[ai][0][m][1][j] * rs) * (acc[ai][1][m][1][j] * rs) * gw; }
                *(u32x4*)(U + (size_t)row * ldc + col0) = pack8(o0, o1); }
    }
};
template <bool RS> struct EpiSwiGLUF8 {
    static constexpr bool PERM = true, AFTER_DRAIN = false;
    unsigned char* U; int ldc; float isc, osc; const PG8_LAS float* rst;
    __device__ __forceinline__ void operator()(const f32x4 (&acc)[2][2][4][2], const Unit& u, int wr, int wc, int fr, int fq) const {
        const int row0 = u.pm * BM + wr * 64 + fr, col0 = u.pn * HALF + wc * 32 + 8 * fq;
        float rsv[2][4];
        if (RS) rows_rstd_lds(rst + u.idx * 256 + wr * 64 + fr, rsv);
#pragma unroll
        for (int ai = 0; ai < 2; ++ai)
#pragma unroll
            for (int m = 0; m < 4; ++m) { const int row = row0 + ai * HALF + m * 16; float o[8]; const float is = RS ? isc * rsv[ai][m] : isc;
#pragma unroll
                for (int j = 0; j < 4; ++j) { o[j] = silu_f(acc[ai][0][m][0][j] * is) * (acc[ai][1][m][0][j] * is) * osc; o[4 + j] = silu_f(acc[ai][0][m][1][j] * is) * (acc[ai][1][m][1][j] * is) * osc; }
                u32x2 w; w.x = pk4_fp8(o[0], o[1], o[2], o[3]); w.y = pk4_fp8(o[4], o[5], o[6], o[7]);
                *(u32x2*)(U + (size_t)row * ldc + col0) = w; }
    }
};
struct EpiOddIn {
    static constexpr bool PERM = true, AFTER_DRAIN = false;
    bf16_t* AG; bf16_t* ZUV; const PG8_LAS float* rst;
    __device__ __forceinline__ void operator()(const f32x4 (&acc)[2][2][4][2], const Unit& u, int wr, int wc, int fr, int fq) const {
        const int row0 = u.pm * BM + wr * 64 + fr;
        float rsv[2][4]; rows_rstd_lds(rst + u.idx * 256 + wr * 64 + fr, rsv);
#pragma unroll
        for (int ai = 0; ai < 2; ++ai)
#pragma unroll
            for (int m = 0; m < 4; ++m) { const int row = row0 + ai * HALF + m * 16; const float rs = rsv[ai][m];
#pragma unroll
                for (int bj = 0; bj < 2; ++bj) { f32x4 v0 = acc[ai][bj][m][0] * rs, v1 = acc[ai][bj][m][1] * rs;
                    if (u.pn < 2) { const int cc = u.pn * BM + bj * HALF + wc * 32 + 8 * fq, g = cc >> 4, h0 = cc & 15;
                        *(u32x4*)(AG + ((size_t)g * 512 + (row >> 5)) * 640 + 128 + (row & 31) * 16 + h0) = pack8(v0, v1); }
                    else { const int cc = (u.pn - 2) * BM + bj * HALF + wc * 32 + 8 * fq;
#pragma unroll
                        for (int j = 0; j < 4; ++j) { v0[j] = gelu_f(v0[j]); v1[j] = gelu_f(v1[j]); }
                        *(u32x4*)(ZUV + (size_t)row * 1024 + cc) = pack8(v0, v1); } } }
    }
};
struct EpiS5Scan {
    static constexpr bool PERM = false, AFTER_DRAIN = true;
    bf16_t* AG; const float* AT;
    __device__ __forceinline__ void operator()(const f32x4 (&)[2][2][4][2], const Unit&, int, int, int, int) const {}
    __device__ __forceinline__ void fused(const f32x4 (&acc)[2][2][4][2], const Unit& u, int wr, int wc, int fr, int fq, PG8_LAS unsigned char* lds, int wid, int lane) const {
#pragma unroll
        for (int ai = 0; ai < 2; ++ai)
#pragma unroll
            for (int m = 0; m < 4; ++m) { const int r = ai * HALF + wr * 64 + m * 16 + fr;
#pragma unroll
                for (int n = 0; n < 2; ++n) { const int gq = (wc * 32 + n * 16 + 4 * fq) >> 2; *(PG8_LAS f32x4*)(lds + r * 512 + ((gq ^ (r & 15)) << 4)) = acc[ai][0][m][n]; } }
        asm volatile("s_waitcnt lgkmcnt(0)" ::: "memory"); __builtin_amdgcn_s_barrier(); asm volatile("" ::: "memory");
        if (wid == 0) { const int g = u.pm >> 1, p = lane;
            const float ar = AT[(g * 64 + p) * 2], ai_ = AT[(g * 64 + p) * 2 + 1]; float hr = 0.f, hi = 0.f;
            bf16_t* ap = AG + (size_t)u.pm * BM * 640 + p;
            const int g0 = p >> 2, g1 = (64 + p) >> 2, sub = (p & 3) << 2;
            for (int c0 = 0; c0 < 256; c0 += 8) { float sr[8], si[8];
#pragma unroll
                for (int e = 0; e < 8; ++e) { const int c = c0 + e; sr[e] = *(const PG8_LAS float*)(lds + c * 512 + ((g0 ^ (c & 15)) << 4) + sub); si[e] = *(const PG8_LAS float*)(lds + c * 512 + ((g1 ^ (c & 15)) << 4) + sub); }
#pragma unroll
                for (int e = 0; e < 8; ++e) { const unsigned w = cvt_pk_bf16(hr, hi); ap[(size_t)(c0 + e) * 640] = (bf16_t)(w & 0xffffu); ap[(size_t)(c0 + e) * 640 + 64] = (bf16_t)(w >> 16);
                    const float nr = ar * hr - ai_ * hi + sr[e], ni = ar * hi + ai_ * hr + si[e]; hr = nr; hi = ni; } }
        }
    }
};
struct EpiS5Y {
    static constexpr bool PERM = true, AFTER_DRAIN = false;
    const bf16_t* AG; const float* dskip; bf16_t* GY;
    __device__ __forceinline__ void operator()(const f32x4 (&acc)[2][2][4][2], const Unit& u, int wr, int wc, int fr, int fq) const {
        const int row0 = u.pm * BM + wr * 64 + fr, g = u.pm >> 1;
        const int n0 = u.pn * HALF + wc * 32 + 8 * fq, jl = n0 >> 4, h0 = n0 & 15;
        const f32x4 d0 = *(const f32x4*)(dskip + g * 16 + h0), d1 = *(const f32x4*)(dskip + g * 16 + h0 + 4);
#pragma unroll
        for (int ai = 0; ai < 2; ++ai)
#pragma unroll
            for (int m = 0; m < 4; ++m) { const int row = row0 + ai * HALF + m * 16;
                const u32x4 uu = *(const u32x4*)(AG + (size_t)row * 640 + 128 + n0);
                f32x4 y0 = acc[ai][0][m][0], y1 = acc[ai][0][m][1];
                y0[0] += d0[0] * bf_lo(uu.x); y0[1] += d0[1] * bf_hi(uu.x); y0[2] += d0[2] * bf_lo(uu.y); y0[3] += d0[3] * bf_hi(uu.y);
                y1[0] += d1[0] * bf_lo(uu.z); y1[1] += d1[1] * bf_hi(uu.z); y1[2] += d1[2] * bf_lo(uu.w); y1[3] += d1[3] * bf_hi(uu.w);
#pragma unroll
                for (int j = 0; j < 4; ++j) { y0[j] = gelu_f(y0[j]); y1[j] = gelu_f(y1[j]); }
                const int chunk = row & 511, token = chunk * 32 + jl;
                *(u32x4*)(GY + (size_t)token * 512 + g * 16 + h0) = pack8(y0, y1); }
    }
};
struct EpiGLU {
    static constexpr bool PERM = true, AFTER_DRAIN = false;
    const bf16_t* GY; const float* bias; bf16_t* MIX;
    __device__ __forceinline__ void operator()(const f32x4 (&acc)[2][2][4][2], const Unit& u, int wr, int wc, int fr, int fq) const {
        const int row0 = u.pm * BM + wr * 64 + fr, c0 = u.pn * HALF + wc * 32 + 8 * fq;
        const f32x4 b0 = *(const f32x4*)(bias + c0), b1 = *(const f32x4*)(bias + c0 + 4);
#pragma unroll
        for (int ai = 0; ai < 2; ++ai)
#pragma unroll
            for (int m = 0; m < 4; ++m) { const int row = row0 + ai * HALF + m * 16;
                const u32x4 gg = *(const u32x4*)(GY + (size_t)row * 512 + c0);
                const f32x4 a0 = acc[ai][0][m][0] + b0, a1 = acc[ai][0][m][1] + b1; f32x4 o0, o1;
                o0[0] = bf_lo(gg.x) * sigmoid_f(a0[0]); o0[1] = bf_hi(gg.x) * sigmoid_f(a0[1]); o0[2] = bf_lo(gg.y) * sigmoid_f(a0[2]); o0[3] = bf_hi(gg.y) * sigmoid_f(a0[3]);
                o1[0] = bf_lo(gg.z) * sigmoid_f(a1[0]); o1[1] = bf_hi(gg.z) * sigmoid_f(a1[1]); o1[2] = bf_lo(gg.w) * sigmoid_f(a1[2]); o1[3] = bf_hi(gg.w) * sigmoid_f(a1[3]);
                *(u32x4*)(MIX + (size_t)row * 1024 + c0) = pack8(o0, o1); }
    }
};
struct EpiBf16 {
    static constexpr bool PERM = true, AFTER_DRAIN = false;
    bf16_t* O; int ldc; float sc;
    __device__ __forceinline__ void operator()(const f32x4 (&acc)[2][2][4][2], const Unit& u, int wr, int wc, int fr, int fq) const {
        const int row0 = u.pm * BM + wr * 64 + fr, col0 = u.pn * BM + wc * 32 + 8 * fq;
#pragma unroll
        for (int ai = 0; ai < 2; ++ai)
#pragma unroll
            for (int m = 0; m < 4; ++m) { bf16_t* rowp = O + (size_t)(row0 + ai * HALF + m * 16) * ldc + col0;
#pragma unroll
                for (int bj = 0; bj < 2; ++bj) *(u32x4*)(rowp + bj * HALF) = pack8(acc[ai][bj][m][0] * sc, acc[ai][bj][m][1] * sc); }
    }
};

struct EpiPartF32 {
    static constexpr bool PERM = false, AFTER_DRAIN = false;
    float* P; float sc;
    __device__ __forceinline__ void operator()(const f32x4 (&acc)[2][2][4][2], const Unit& u, int wr, int wc, int fr, int fq) const {
        float* base = P + ((size_t)(u.pm * 7 + (u.pn >> 2)) * 256 + wr * 64 + fr) * 1024 + (u.pn & 3) * BM + wc * 32 + 4 * fq;
#pragma unroll
        for (int ai = 0; ai < 2; ++ai)
#pragma unroll
            for (int m = 0; m < 4; ++m) { float* rowp = base + (size_t)(ai * HALF + m * 16) * 1024;
#pragma unroll
                for (int bj = 0; bj < 2; ++bj)
#pragma unroll
                    for (int n = 0; n < 2; ++n) *(f32x4*)(rowp + bj * HALF + n * 16) = acc[ai][bj][m][n] * sc; }
    }
};

template <class Epi, class Sched, class GD, int MMODE = 0, bool ALIGN_EPI = true, bool SP2 = true>
__device__ __forceinline__ void gemm_phase(PG8_LAS unsigned char* lds, const GD& g, const Sched& S, const Epi& E, const int wid) {
    int lane_o; asm volatile("v_mbcnt_lo_u32_b32 %0, -1, 0\n\tv_mbcnt_hi_u32_b32 %0, -1, %0" : "=v"(lane_o));
    const int lane = lane_o, tid = wid * 64 + lane, wr = wid >> 2, wc = wid & 3, fr = lane & 15, fq = lane >> 4;
    const int K = g.K, nt = K / BK, lda = g.lda, ldb = g.ldb;
    unsigned voffA[2], voffB[2];
#pragma unroll
    for (int i = 0; i < 2; ++i) { int R, C; stage_rc(tid * 16 + i * 8192, R, C); const int Rb = Epi::PERM ? ((R & ~31) + perm32(R & 31)) : R;
        voffA[i] = (unsigned)(R * lda + C) * 2u; voffB[i] = (unsigned)(Rb * ldb + C) * 2u; }
    const size_t kstep = (size_t)(BK * 2);
    const size_t hstepA = (size_t)HALF * lda * 2, hstepB = (size_t)HALF * ldb * 2;
    const unsigned ldsw = (unsigned)wid * 1024u;
    const int aoff = lds_byte(wr * 64 + fr, fq * 8), boff = lds_byte(wc * 32 + fr, fq * 8);
#define PG8_SA(b, h) (((b) * 2 + (h)) * HTB)
#define PG8_SB(b, h) ((4 + (b) * 2 + (h)) * HTB)
#define PG8_STAGE(bufoff, gbase, voff) do { _Pragma("unroll") for (int _i = 0; _i < 2; ++_i) \
        __builtin_amdgcn_global_load_lds((const unsigned*)((const char*)(gbase) + (voff)[_i]), (PG8_LAS unsigned*)(lds + (bufoff) + ldsw + _i * 8192), 16, 0, 0); } while (0)
#define PG8_LDA(dst, b, h) do { if constexpr (MMODE == 0) { _Pragma("unroll") for (int m = 0; m < 4; ++m) _Pragma("unroll") for (int k = 0; k < 2; ++k) dst[m][k] = *(const PG8_LAS bf16x8*)(lds + PG8_SA(b, h) + aoff + m * 2048 + k * 1024); } \
        else { _Pragma("unroll") for (int m = 0; m < 4; ++m) dst##8[m] = cat8(*(const PG8_LAS bf16x8*)(lds + PG8_SA(b, h) + aoff + m * 2048), *(const PG8_LAS bf16x8*)(lds + PG8_SA(b, h) + aoff + m * 2048 + 1024)); } } while (0)
#define PG8_LDB(dst, b, h) do { if constexpr (MMODE == 0) { _Pragma("unroll") for (int n = 0; n < 2; ++n) _Pragma("unroll") for (int k = 0; k < 2; ++k) dst[n][k] = *(const PG8_LAS bf16x8*)(lds + PG8_SB(b, h) + boff + n * 2048 + k * 1024); } \
        else { _Pragma("unroll") for (int n = 0; n < 2; ++n) dst##8[n] = cat8(*(const PG8_LAS bf16x8*)(lds + PG8_SB(b, h) + boff + n * 2048), *(const PG8_LAS bf16x8*)(lds + PG8_SB(b, h) + boff + n * 2048 + 1024)); } } while (0)
#define PG8_MMA(ai, bj, At, Bt) do { __builtin_amdgcn_s_setprio(1); \
        if constexpr (MMODE == 0) { _Pragma("unroll") for (int m = 0; m < 4; ++m) _Pragma("unroll") for (int n = 0; n < 2; ++n) _Pragma("unroll") for (int k = 0; k < 2; ++k) \
            acc[ai][bj][m][n] = __builtin_amdgcn_mfma_f32_16x16x32_bf16(Bt[n][k], At[m][k], acc[ai][bj][m][n], 0, 0, 0); } \
        else { asm volatile("s_nop 1"); _Pragma("unroll") for (int m = 0; m < 4; ++m) _Pragma("unroll") for (int n = 0; n < 2; ++n) \
            asm volatile("v_mfma_scale_f32_16x16x128_f8f6f4 %0, %1, %2, %0, %3, %3 op_sel_hi:[0,0,0]" : "+v"(acc[ai][bj][m][n]) : "v"(Bt##8[n]), "v"(At##8[m]), "v"(f8one)); } \
        __builtin_amdgcn_s_setprio(0); } while (0)
#define PG8_WAIT_V(n) asm volatile("s_waitcnt vmcnt(" #n ")" ::: "memory")
#define PG8_WAIT_L(n) asm volatile("s_waitcnt lgkmcnt(" #n ")" ::: "memory")
#define PG8_BAR __builtin_amdgcn_s_barrier()
#define PG8_SCHED __builtin_amdgcn_sched_barrier(0)
    Unit cur, nxt; int ui = 0;
    if (!S.next(0, cur)) return;
    f32x4 acc[2][2][4][2];
#pragma unroll
    for (int a = 0; a < 2; ++a)
#pragma unroll
        for (int b = 0; b < 2; ++b)
#pragma unroll
            for (int m = 0; m < 4; ++m)
#pragma unroll
                for (int n = 0; n < 2; ++n) acc[a][b][m][n] = (f32x4){0.f, 0.f, 0.f, 0.f};
    const int f8one = 0x7f7f7f7f;
    bf16x8 At[4][2], B0[2][2], B1[2][2]; i32x8 At8[4], B08[2], B18[2];
    const char* cA = g.a_ptr(cur); const char* cB = g.b_ptr(cur);
    S.a_ready(cur);
    if constexpr (SP2) {
        PG8_STAGE(PG8_SB(0, 0), cB, voffB); PG8_STAGE(PG8_SB(0, 1), cB + hstepB, voffB); PG8_STAGE(PG8_SA(0, 0), cA, voffA); PG8_STAGE(PG8_SA(0, 1), cA + hstepA, voffA);
        if (wr == 1) PG8_BAR;
        PG8_WAIT_V(2); PG8_BAR;
        PG8_STAGE(PG8_SB(1, 0), cB + kstep, voffB); PG8_STAGE(PG8_SA(1, 0), cA + kstep, voffA); PG8_STAGE(PG8_SB(1, 1), cB + hstepB + kstep, voffB);
        PG8_WAIT_V(6); PG8_BAR;
    } else {
        PG8_STAGE(PG8_SB(0, 0), cB, voffB); PG8_STAGE(PG8_SA(0, 0), cA, voffA); PG8_STAGE(PG8_SB(0, 1), cB + hstepB, voffB); PG8_STAGE(PG8_SA(0, 1), cA + hstepA, voffA);
        if (wr == 1) PG8_BAR;
        PG8_WAIT_V(4); PG8_BAR;
        PG8_STAGE(PG8_SB(1, 0), cB + kstep, voffB); PG8_STAGE(PG8_SA(1, 0), cA + kstep, voffA); PG8_STAGE(PG8_SB(1, 1), cB + hstepB + kstep, voffB);
        PG8_WAIT_V(6); PG8_BAR;
    }
    for (;;) {
        const bool has_next = S.next(ui + 1, nxt);
        const char* nA = has_next ? g.a_ptr(nxt) : cA; const char* nB = has_next ? g.b_ptr(nxt) : cB;
        for (int t = 0; t < nt; t += 2) {
            const bool last = (t == nt - 2);
            const char* a1 = cA + (size_t)(t + 1) * kstep;
            const char* a2 = last ? nA : cA + (size_t)(t + 2) * kstep; const char* b2 = last ? nB : cB + (size_t)(t + 2) * kstep;
            const char* a3 = a2 + kstep; const char* b3 = b2 + kstep;
            if (last && has_next) S.a_ready(nxt);
            if constexpr (SP2) {
            PG8_LDB(B0, 0, 0); PG8_LDB(B1, 0, 1); PG8_SCHED; PG8_LDA(At, 0, 0); PG8_STAGE(PG8_SA(1, 1), a1 + hstepA, voffA);
            PG8_WAIT_V(8); PG8_WAIT_L(0); PG8_BAR; PG8_MMA(0, 0, At, B0); PG8_MMA(0, 1, At, B1); PG8_BAR; PG8_SCHED;
            PG8_LDA(At, 0, 1); PG8_STAGE(PG8_SB(0, 0), b2, voffB); PG8_STAGE(PG8_SB(0, 1), b2 + hstepB, voffB); PG8_STAGE(PG8_SA(0, 0), a2, voffA);
            PG8_WAIT_V(8); PG8_WAIT_L(0); PG8_BAR; PG8_MMA(1, 0, At, B0); PG8_MMA(1, 1, At, B1); PG8_BAR; PG8_SCHED;
            PG8_LDB(B0, 1, 0); PG8_LDB(B1, 1, 1); PG8_SCHED; PG8_LDA(At, 1, 0); PG8_STAGE(PG8_SA(0, 1), a2 + hstepA, voffA);
            PG8_WAIT_V(8); PG8_WAIT_L(0); PG8_BAR; PG8_MMA(0, 0, At, B0); PG8_MMA(0, 1, At, B1); PG8_BAR; PG8_SCHED;
            PG8_LDA(At, 1, 1); PG8_STAGE(PG8_SB(1, 0), b3, voffB); PG8_STAGE(PG8_SB(1, 1), b3 + hstepB, voffB); PG8_STAGE(PG8_SA(1, 0), a3, voffA);
            PG8_WAIT_V(8); PG8_WAIT_L(0); PG8_BAR; PG8_MMA(1, 0, At, B0); PG8_MMA(1, 1, At, B1); PG8_BAR; PG8_SCHED;
            } else {
            PG8_LDB(B0, 0, 0); PG8_SCHED; PG8_LDA(At, 0, 0); PG8_STAGE(PG8_SA(1, 1), a1 + hstepA, voffA);
            PG8_WAIT_L(8); PG8_BAR; PG8_WAIT_L(0); PG8_MMA(0, 0, At, B0); PG8_BAR; PG8_SCHED;
            PG8_LDB(B1, 0, 1); PG8_STAGE(PG8_SB(0, 0), b2, voffB);
            PG8_BAR; PG8_WAIT_L(0); PG8_MMA(0, 1, At, B1); PG8_BAR;
            PG8_LDA(At, 0, 1); PG8_STAGE(PG8_SA(0, 0), a2, voffA);
            PG8_BAR; PG8_WAIT_L(0); PG8_MMA(1, 0, At, B0); PG8_BAR; PG8_SCHED;
            PG8_STAGE(PG8_SB(0, 1), b2 + hstepB, voffB);
            PG8_WAIT_V(6); PG8_BAR; PG8_MMA(1, 1, At, B1); PG8_BAR;
            PG8_LDB(B0, 1, 0); PG8_SCHED; PG8_LDA(At, 1, 0); PG8_STAGE(PG8_SA(0, 1), a2 + hstepA, voffA);
            PG8_WAIT_L(8); PG8_BAR; PG8_WAIT_L(0); PG8_MMA(0, 0, At, B0); PG8_BAR; PG8_SCHED;
            PG8_LDB(B1, 1, 1); PG8_STAGE(PG8_SB(1, 0), b3, voffB);
            PG8_BAR; PG8_WAIT_L(0); PG8_MMA(0, 1, At, B1); PG8_BAR;
            PG8_LDA(At, 1, 1); PG8_STAGE(PG8_SA(1, 0), a3, voffA);
            PG8_BAR; PG8_WAIT_L(0); PG8_MMA(1, 0, At, B0); PG8_BAR; PG8_SCHED;
            PG8_STAGE(PG8_SB(1, 1), b3 + hstepB, voffB);
            PG8_WAIT_V(6); PG8_BAR; PG8_MMA(1, 1, At, B1); PG8_BAR;
            }
        }
        if constexpr (MMODE == 1) asm volatile("s_nop 15\n\ts_nop 15" ::: "memory");
        if constexpr (ALIGN_EPI) { if (wr == 0) PG8_BAR; }
        if constexpr (!Epi::AFTER_DRAIN) { E(acc, cur, wr, wc, fr, fq); S.done(cur); }
        if (!has_next) break;
#pragma unroll
        for (int a = 0; a < 2; ++a)
#pragma unroll
            for (int b = 0; b < 2; ++b)
#pragma unroll
                for (int m = 0; m < 4; ++m)
#pragma unroll
                    for (int n = 0; n < 2; ++n) acc[a][b][m][n] = (f32x4){0.f, 0.f, 0.f, 0.f};
        cur = nxt; cA = nA; cB = nB; ++ui;
        if constexpr (ALIGN_EPI) { if (wr == 1) PG8_BAR; }
    }
    PG8_WAIT_V(0);
    if constexpr (!ALIGN_EPI) { if (wr == 0) PG8_BAR; }
    PG8_BAR;
    if constexpr (Epi::AFTER_DRAIN) { E.fused(acc, cur, wr, wc, fr, fq, lds, wid, lane); S.done(cur); }
#undef PG8_SA
#undef PG8_SB
#undef PG8_STAGE
#undef PG8_LDA
#undef PG8_LDB
#undef PG8_MMA
#undef PG8_WAIT_V
#undef PG8_WAIT_L
#undef PG8_BAR
#undef PG8_SCHED
}
}

constexpr int NWAVES = 8;
constexpr int D = 1024, SEQ = 8192, M = 16384;
constexpr int FFN = 2816, EXD = 3584, NEXP = 8;
constexpr int XS_ROWS = 2 * M + NEXP * 256;
constexpr int MAXPAN = XS_ROWS / 256;
constexpr int NPH = 31;

constexpr size_t MiB = 1u << 20;
constexpr size_t WS_CTL = 0, CTL_ZERO_BYTES = 1 * MiB;
constexpr size_t WS_SMALL = 1 * MiB;
constexpr size_t SM_AT = 0;
constexpr size_t SM_TOKE = 64 * 1024;
constexpr size_t SM_TOKW = SM_TOKE + 128 * 1024;
constexpr size_t SM_TOKR = SM_TOKW + 128 * 1024;
constexpr size_t SM_TOKP = SM_TOKR + 128 * 1024;
constexpr size_t SM_RSTD = SM_TOKP + 128 * 1024;
constexpr size_t SM_WGCNT = SM_RSTD + 64 * 1024;
constexpr size_t SM_ROWG = SM_WGCNT + 8 * 1024;
constexpr size_t SM_PANEL = SM_ROWG + 192 * 1024;
constexpr size_t SM_SSQ = 1 * MiB;
constexpr size_t WS_WEIN = 9 * MiB;
constexpr size_t EV_EIN = 0, EV_EOUT = 4 * MiB, EV_E13 = 6 * MiB, EV_E2 = 17 * MiB, EV_STRIDE = 23 * MiB;
constexpr size_t WS_WODD = WS_WEIN + 2 * EV_STRIDE;
constexpr size_t OD_OIN = 0, OD_GLU = 3 * MiB, OD_OOUT = 4 * MiB, OD_SGU = 6 * MiB, OD_WST = 7 * MiB, OD_MY = 15 * MiB, OD_M13 = 35 * MiB, OD_M2 = 147 * MiB, OD_STRIDE = 203 * MiB;
constexpr size_t WS_HB = WS_WODD + 2 * OD_STRIDE;
constexpr size_t WS_ARENA = WS_HB + 32 * MiB;
constexpr size_t AR_UM = 0;
constexpr size_t AR_Z = 0, AR_MIX = 64 * MiB, AR_UF = 96 * MiB;
constexpr size_t AR_AG = 0, AR_SST = 20 * MiB, AR_ZUV = 32 * MiB, AR_GY = 96 * MiB;
constexpr size_t AR_XS = 238 * MiB;
constexpr size_t WS_PART = WS_ARENA + 306 * MiB;
constexpr size_t WS_END = WS_PART + 56 * MiB;
static_assert((size_t)XS_ROWS * EXD * 2 <= 238 * MiB && (size_t)XS_ROWS * D * 2 <= 68 * MiB, "arena");
static_assert(SM_PANEL + 1024 <= SM_SSQ && SM_SSQ + (size_t)M * 16 * 4 <= 8 * MiB, "small tables");
constexpr int CW_TMO = 0;
constexpr int CW_BAR = 4096;
constexpr int CW_QUEUE = 64;

constexpr int RING_OFF = 0, RING_BYTES = 131072;
constexpr int LDSCTL_OFF = RING_BYTES, MISC_OFF = LDSCTL_OFF + 320;
constexpr int PTAB_OFF = LDSCTL_OFF + 1024;
constexpr int RST_OFF = LDSCTL_OFF + 2048;
constexpr int RST_UNITS = 6;
constexpr int LDS_BYTES = 147456;

#define GAS __attribute__((address_space(1)))
#define LAS __attribute__((address_space(3)))
typedef unsigned short bf16;
typedef unsigned v4u __attribute__((ext_vector_type(4)));
typedef unsigned v2u __attribute__((ext_vector_type(2)));
typedef float f32x4 __attribute__((ext_vector_type(4)));
typedef short bf16x8 __attribute__((ext_vector_type(8)));
#define RLX_AGENT __ATOMIC_RELAXED, __HIP_MEMORY_SCOPE_AGENT
#define LDS_WAIT() asm volatile("s_waitcnt lgkmcnt(0)" ::: "memory")
#define VM_WAIT() asm volatile("s_waitcnt vmcnt(0)" ::: "memory")
__device__ __forceinline__ unsigned f2bf(float f) { unsigned u = __builtin_bit_cast(unsigned, f); return (u + 0x7fffu + ((u >> 16) & 1u)) >> 16; }
__device__ __forceinline__ unsigned pk2(float lo, float hi) { return f2bf(lo) | (f2bf(hi) << 16); }
__device__ __forceinline__ float bflo(unsigned w) { return __uint_as_float(w << 16); }
__device__ __forceinline__ float bfhi(unsigned w) { return __uint_as_float(w & 0xffff0000u); }

#define XB_TMO      128
#define XB_XCNT(j)  (256  + 64 * (j))
#define XB_XSUB(j)  (1280 + 64 * (j))
#define XB_XGEN(j)  (2304 + 64 * (j))
#define XB_TOP      3328
#define XB_TOPGEN   3392
#define XCD_BAR_WORDS 3456
#define XB_SPIN_CAP (1u << 22)

__device__ __forceinline__ unsigned xb_ld(unsigned* p)              { return __hip_atomic_load(p, __ATOMIC_RELAXED, __HIP_MEMORY_SCOPE_AGENT); }
__device__ __forceinline__ unsigned xb_add(unsigned* p, unsigned v) { return __hip_atomic_fetch_add(p, v, __ATOMIC_RELAXED, __HIP_MEMORY_SCOPE_AGENT); }
__device__ __forceinline__ unsigned xb_xcc_id() { return (unsigned)__builtin_amdgcn_s_getreg((3 << 11) | 20) & 0xFu; }
#define XB_SPIN(cond, bar) do { unsigned _sp = 0; while (cond) { __builtin_amdgcn_s_sleep(1); \
    if ((++_sp & 255u) == 0u) { if (xb_ld(&(bar)[XB_TMO])) break; if (_sp > XB_SPIN_CAP) { atomicAdd(&(bar)[XB_TMO], 1u); break; } } } } while (0)

struct XcdBarrier { unsigned* bar; unsigned x; volatile LAS unsigned* st; };

__device__ __forceinline__ XcdBarrier xcd_barrier_post(unsigned* bar, volatile LAS unsigned* st) {
    XcdBarrier b; b.bar = bar; b.x = xb_xcc_id(); b.st = st;
    if (threadIdx.x == 0) (void)xb_add(&bar[XB_XCNT(b.x)], 1u);
    return b;
}
__device__ __forceinline__ void xcd_barrier_complete(unsigned* bar, unsigned x, unsigned& nloc, unsigned& nx) {
    const unsigned G = gridDim.x * gridDim.y * gridDim.z;
    unsigned sum, cnt, mine, sp = 0u;
    for (;;) {
        sum = 0u; cnt = 0u; mine = 0u;
#pragma unroll
        for (unsigned j = 0; j < 16; ++j) { const unsigned c = xb_ld(&bar[XB_XCNT(j)]); sum += c; cnt += (c > 0u) ? 1u : 0u; mine = (j == x) ? c : mine; }
        if (sum == G) break;
        __builtin_amdgcn_s_sleep(1);
        if ((++sp & 255u) == 0u) { if (xb_ld(&bar[XB_TMO])) break; if (sp > XB_SPIN_CAP) { atomicAdd(&bar[XB_TMO], 1u); break; } }
    }
    nloc = mine > 0u ? mine : 1u; nx = cnt > 0u ? cnt : 1u;
}
__device__ __forceinline__ void xcd_barrier(const XcdBarrier& b, const int wave_idx) {
    asm volatile("s_waitcnt vmcnt(0)" ::: "memory");
    __syncthreads();
    unsigned lane_b_; asm volatile("v_mbcnt_lo_u32_b32 %0, -1, 0\n\tv_mbcnt_hi_u32_b32 %0, -1, %0" : "=v"(lane_b_));
    if (wave_idx == 0 && lane_b_ == 0u) {
        unsigned* bar = b.bar;
        __builtin_amdgcn_s_waitcnt(0);
        unsigned nloc = b.st[0], nx = b.st[1];
        if (nloc == 0u) { xcd_barrier_complete(bar, b.x, nloc, nx); b.st[0] = nloc; b.st[1] = nx; }
        const unsigned old = __hip_atomic_fetch_add(&bar[XB_XSUB(b.x)], 1u, __ATOMIC_RELAXED, __HIP_MEMORY_SCOPE_WORKGROUP);
        const unsigned gen = old / nloc;
        if (old + 1u == (gen + 1u) * nloc) {
            __builtin_amdgcn_fence(__ATOMIC_RELEASE, "agent");
            asm volatile("s_waitcnt vmcnt(0)" ::: "memory");
            (void)xb_add(&bar[XB_TOP], 1u);
        }
        const unsigned target = (gen + 1u) * nx;
        asm volatile("buffer_inv sc1" ::: "memory");
        XB_SPIN(xb_ld(&bar[XB_TOP]) < target, bar);
        asm volatile("s_waitcnt vmcnt(0)" ::: "memory");
    }
    __syncthreads();
}

__device__ __forceinline__ float wave_sum(float v) {
#pragma unroll
    for (int o = 1; o < 64; o <<= 1) v += __shfl_xor(v, o);
    return v;
}
struct TTile { const float* src; const float* gain; unsigned char* dst; int ldw, ldo_b; float f8sc; };
__device__ __forceinline__ void sincos_turns(double turns, float& c, float& s) {
    const double fr = turns - __builtin_rint(turns);
    const float x = (float)fr * 6.283185307179586f;
    c = cosf(x); s = sinf(x);
}

#ifndef REP_P0
#define REP_P0 1
#endif
#ifndef REP_E2
#define REP_E2 1
#endif
#ifndef REP_SGU
#define REP_SGU 1
#endif
#ifndef REP_ROUTE
#define REP_ROUTE 1
#endif
#ifndef REP_BAR
#define REP_BAR 1
#endif
struct Args { const float* in[33]; float* out; unsigned char* ws; int ph_lo, ph_hi; };

__device__ __forceinline__ const float* in_ptr(int k) {
    const __attribute__((address_space(4))) char* ka = (const __attribute__((address_space(4))) char*)__builtin_amdgcn_kernarg_segment_ptr();
    int off = k * 8; asm volatile("" : "+s"(off));
    return *(const float* const __attribute__((address_space(4)))*)(ka + off);
}
#define INP(k) in_ptr(k)
#ifndef F8_LAST
#define F8_LAST 1
#endif
#ifndef F8_FROM
#define F8_FROM 0
#endif
#ifndef F8_FFN_FROM
#define F8_FFN_FROM 1
#endif
constexpr float F8_W13_SC = 32.f, F8_W2_SC = 64.f, F8_UM_SC = 16.f;
constexpr int TT_EV = 688, TT_OD = 5552, TT_LAYER = TT_EV + TT_OD, TT_EXP = 672, TT_TOTAL = 2 * TT_LAYER;
__device__ __forceinline__ TTile decode_tile(const Args& args, unsigned char* ws, int it) {
    const int li = it / TT_LAYER; int r = it % TT_LAYER;
    const float* W; const float* gain = nullptr; int ldw, nbn, ldo, mode = 0; unsigned char* WT; float f8sc = 0.f; int esz = 2;
    if (r < TT_EV) {
        unsigned char* wb = ws + WS_WEIN + li * EV_STRIDE;
        if (r < 96) { W = args.in[2] + (size_t)li * D * 2048; ldw = 2048; nbn = 12; gain = args.in[1] + li * D; WT = wb + EV_EIN; ldo = D; }
        else if (r < 160) { r -= 96; W = args.in[6] + (size_t)li * D * D; ldw = D; nbn = 8; WT = wb + EV_EOUT; ldo = D; }
        else if (r < 336) { r -= 160; W = args.in[8] + (size_t)li * D * FFN; ldw = FFN; nbn = 22; gain = args.in[7] + li * D; WT = wb + EV_E13; ldo = D; mode = 1; if (F8_LAST && li >= F8_FFN_FROM) { esz = 1; f8sc = F8_W13_SC; } }
        else if (r < 512) { r -= 336; W = args.in[9] + (size_t)li * D * FFN; ldw = FFN; nbn = 22; gain = args.in[7] + li * D; WT = wb + EV_E13; ldo = D; mode = 2; if (F8_LAST && li >= F8_FFN_FROM) { esz = 1; f8sc = F8_W13_SC; } }
        else { r -= 512; W = args.in[10] + (size_t)li * FFN * D; ldw = D; nbn = 8; WT = wb + EV_E2; ldo = FFN; if (F8_LAST && li >= F8_FFN_FROM) { esz = 1; f8sc = F8_W2_SC; } }
    } else {
        r -= TT_EV; unsigned char* wb = ws + WS_WODD + li * OD_STRIDE;
        if (r < 96) { W = args.in[12] + (size_t)li * D * 1536; ldw = 1536; nbn = 12; gain = args.in[11] + li * D; WT = wb + OD_OIN; ldo = D; }
        else if (r < 112) { r -= 96; W = args.in[21] + (size_t)li * 512 * 512; ldw = 512; nbn = 4; WT = wb + OD_GLU; ldo = 512; }
        else if (r < 176) { r -= 112; W = args.in[26] + (size_t)li * D * D; ldw = D; nbn = 8; WT = wb + OD_OOUT; ldo = D; }
        else { r -= 176; const int e = r / TT_EXP; r %= TT_EXP; const bool f8 = F8_LAST && li >= F8_FROM; if (f8) esz = 1;
            if (r < 224) { W = args.in[29] + ((size_t)li * NEXP + e) * D * EXD; ldw = EXD; nbn = 28; gain = args.in[27] + li * D; WT = wb + OD_M13 + (size_t)e * 2 * EXD * D * esz; ldo = D; mode = 1; if (f8) f8sc = F8_W13_SC; }
            else if (r < 448) { r -= 224; W = args.in[30] + ((size_t)li * NEXP + e) * D * EXD; ldw = EXD; nbn = 28; gain = args.in[27] + li * D; WT = wb + OD_M13 + (size_t)e * 2 * EXD * D * esz; ldo = D; mode = 2; if (f8) f8sc = F8_W13_SC; }
            else { r -= 448; W = args.in[31] + ((size_t)li * NEXP + e) * EXD * D; ldw = D; nbn = 8; WT = wb + OD_M2 + (size_t)e * D * EXD * esz; ldo = EXD; if (f8) f8sc = F8_W2_SC; } }
    }
    const int kb = r / nbn, nb = r % nbn, k0 = 128 * kb, n0 = 128 * nb;
    const size_t orow0 = mode == 0 ? (size_t)n0 : (size_t)(nb * 256 + (mode == 2 ? 128 : 0));
    TTile d; d.src = W + (size_t)k0 * ldw + n0; d.gain = gain ? gain + k0 : nullptr; d.ldw = ldw; d.f8sc = f8sc;
    d.dst = WT + (orow0 * ldo + k0) * esz; d.ldo_b = ldo * esz; return d;
}

__global__ void __launch_bounds__(NWAVES * 64, 2) trunk_fwd(Args args) {
    extern __shared__ __attribute__((aligned(16))) unsigned char lds_raw[];
    LAS unsigned char* lds = (LAS unsigned char*)lds_raw;
    volatile LAS unsigned* MISC = (volatile LAS unsigned*)(lds + MISC_OFF);
    const int G = gridDim.x, bx = blockIdx.x;
#define G_O ({ int g_ = G; asm volatile("" : "+s"(g_)); g_; })
#define BX_O ({ int b_ = bx; asm volatile("" : "+s"(b_)); b_; })
    const int wave_s = __builtin_amdgcn_readfirstlane((int)threadIdx.x >> 6);
#define PHASE_IDS int lane_o_; asm volatile("v_mbcnt_lo_u32_b32 %0, -1, 0\n\tv_mbcnt_hi_u32_b32 %0, -1, %0" : "=v"(lane_o_)); const int lane = lane_o_, wave = wave_s, tid = wave * 64 + lane; (void)tid;
#define P_ws ({ unsigned char* w_ = args.ws; asm volatile("" : "+s"(w_)); w_; })
#define P_ctl ((unsigned*)(P_ws + WS_CTL))
#define P_sm (P_ws + WS_SMALL)
#define P_SSQ ((float*)(P_ws + WS_SMALL + SM_SSQ))
#define P_HB ((bf16*)(P_ws + WS_HB))
#define P_arena (P_ws + WS_ARENA)
#define P_H ({ float* h_ = args.out; asm volatile("" : "+s"(h_)); h_; })
#define P_x_in INP(0)
#define P_wev (P_ws + WS_WEIN + lp * EV_STRIDE)
#define P_wod (P_ws + WS_WODD + lp * OD_STRIDE)
#define P_Z ((bf16*)(P_arena + AR_Z))
#define P_MIX ((bf16*)(P_arena + AR_MIX))
#define P_UF ((bf16*)(P_arena + AR_UF))
#define P_AG ((bf16*)(P_arena + AR_AG))
#define P_ZUV ((bf16*)(P_arena + AR_ZUV))
#define P_GY ((bf16*)(P_arena + AR_GY))
#define P_XS ((bf16*)(P_arena + AR_XS))
#define P_UM ((bf16*)(P_arena + AR_UM))
#define P_TOKE ((int*)(P_sm + SM_TOKE))
#define P_TOKW ((float*)(P_sm + SM_TOKW))
#define P_TOKR ((int*)(P_sm + SM_TOKR))
#define P_TOKP ((int*)(P_sm + SM_TOKP))
#define P_RSTD ((float*)(P_sm + SM_RSTD))
#define P_WGCNT ((int*)(P_sm + SM_WGCNT))
#define P_PANEL ((int*)(P_sm + SM_PANEL))
#define P_ROWT ((int*)(P_sm + SM_ROWG))

    for (int u = threadIdx.x; u < (LDS_BYTES - LDSCTL_OFF) / 4; u += NWAVES * 64) ((LAS unsigned*)(lds + LDSCTL_OFF))[u] = 0u;
    __syncthreads();
    (void)xcd_barrier_post(P_ctl + CW_BAR, MISC + 8);
    const int lo = args.ph_lo, hi = args.ph_hi;
#define IN(k) (lo <= (k) && (k) < hi)
#define RST_PREAMBLE(S) do { PHASE_IDS LAS float* rst_ = (LAS float*)(lds + RST_OFF); pg8::Unit u_; \
        for (int i_ = 0; i_ < RST_UNITS && (S).next(i_, u_); ++i_) { const int row_ = u_.pm * 256 + (tid >> 1); \
            const f32x4 a_ = *(const f32x4*)(P_SSQ + (size_t)row_ * 16 + (tid & 1) * 8), b_ = *(const f32x4*)(P_SSQ + (size_t)row_ * 16 + (tid & 1) * 8 + 4); \
            float s_ = ((a_[0] + a_[1]) + (a_[2] + a_[3])) + ((b_[0] + b_[1]) + (b_[2] + b_[3])); s_ += __shfl_xor(s_, 1); \
            if ((tid & 1) == 0) rst_[i_ * 256 + (tid >> 1)] = 1.0f / sqrtf(s_ * (1.0f / 1024.0f) + 1e-5f); } \
        __syncthreads(); } while (0)
#define SEAM(k) do { if (IN(k) && IN((k) + 1)) { for (int rb_ = 0; rb_ < REP_BAR; ++rb_) { XcdBarrier bar_; bar_.bar = P_ctl + CW_BAR; bar_.x = xb_xcc_id(); bar_.st = (volatile LAS unsigned*)(lds + MISC_OFF) + 8; xcd_barrier(bar_, wave_s); } } } while (0)

    for (int rep_ = 0; rep_ < REP_P0; ++rep_)
    if (IN(0)) {
        PHASE_IDS
        LAS float* scr = (LAS float*)(lds + RING_OFF + wave * 16384);
        const int gw = bx * NWAVES + wave, NGW = G * NWAVES;
        for (int task = bx; task < 64; task += G) {
            const int li = task >> 5, g = task & 31;
            LAS float* PWr = (LAS float*)(lds + RING_OFF);
            LAS float* PWi = PWr + 33 * 64;
            LAS float* BBr = PWi + 33 * 64;
            LAS float* BBi = BBr + 1024;
            LAS float* CRe = BBi + 1024;
            LAS float* CIm = CRe + 1024;
            LAS float* KT = CIm + 1024;
            __syncthreads();
            if (tid < 64) {
                const int p = tid; const int gp = (li * 32 + g) * 64 + p;
                const float lr = args.in[13][gp], lim = args.in[14][gp], dt = expf(args.in[15][li * 32 + g]);
                const float rho = lr * dt; const double td = (double)lim * (double)dt * 0.15915494309189535;
                for (int tau = 0; tau <= 32; ++tau) { float c, s; sincos_turns(td * (double)tau, c, s); const float mg = expf(rho * (float)tau); PWr[tau * 64 + p] = mg * c; PWi[tau * 64 + p] = mg * s; }
                float c1, s1, ch, sh; sincos_turns(td, c1, s1); sincos_turns(td * 0.5, ch, sh);
                const float mg = expf(rho), qr = expm1f(rho) * c1 - 2.0f * sh * sh, qi = mg * s1, den = lr * lr + lim * lim;
                const float fre = (qr * lr + qi * lim) / den, fim = (qi * lr - qr * lim) / den;
                for (int h = 0; h < 16; ++h) { const float br = args.in[16][(size_t)gp * 16 + h], bi = args.in[17][(size_t)gp * 16 + h]; BBr[p * 16 + h] = fre * br - fim * bi; BBi[p * 16 + h] = fre * bi + fim * br; }
                float* AT = (float*)(P_sm + SM_AT) + (size_t)gp * 2; AT[0] = PWr[32 * 64 + p]; AT[1] = PWi[32 * 64 + p];
            }
            for (int e = tid; e < 1024; e += 512) { CRe[e] = args.in[18][(size_t)(li * 32 + g) * 1024 + e]; CIm[e] = args.in[19][(size_t)(li * 32 + g) * 1024 + e]; }
            __syncthreads();
            for (int r = 0; r < 16; ++r) { const int o = tid + 512 * r, tau = o >> 8, hp = (o >> 4) & 15, h = o & 15; float a = 0.f;
                for (int p = 0; p < 64; ++p) { const float cr = CRe[hp * 64 + p], ci = CIm[hp * 64 + p], wr_ = PWr[tau * 64 + p], wi_ = PWi[tau * 64 + p];
                    const float car = cr * wr_ - ci * wi_, cai = cr * wi_ + ci * wr_; a += car * BBr[p * 16 + h] - cai * BBi[p * 16 + h]; }
                KT[o] = a; }
            __syncthreads();
            bf16* MY = (bf16*)(P_ws + WS_WODD + li * OD_STRIDE + OD_MY) + (size_t)g * 512 * 640;
            for (int r = 0; r < 80; ++r) { const int q = tid + 512 * r, n = q / 80, k0 = (q % 80) * 8, j = n >> 4, hp = n & 15; float v[8];
                if (k0 < 64) {
#pragma unroll
                    for (int e = 0; e < 8; ++e) { const int p = k0 + e; v[e] = CRe[hp * 64 + p] * PWr[(j + 1) * 64 + p] - CIm[hp * 64 + p] * PWi[(j + 1) * 64 + p]; }
                } else if (k0 < 128) {
#pragma unroll
                    for (int e = 0; e < 8; ++e) { const int p = k0 - 64 + e; v[e] = -(CRe[hp * 64 + p] * PWi[(j + 1) * 64 + p] + CIm[hp * 64 + p] * PWr[(j + 1) * 64 + p]); }
                } else { const int s = (k0 - 128) >> 4, h0 = (k0 - 128) & 15;
#pragma unroll
                    for (int e = 0; e < 8; ++e) v[e] = (s <= j) ? KT[(j - s) * 256 + hp * 16 + h0 + e] : 0.f; }
                v4u o; o.x = pk2(v[0], v[1]); o.y = pk2(v[2], v[3]); o.z = pk2(v[4], v[5]); o.w = pk2(v[6], v[7]);
                *(GAS v4u*)(MY + (size_t)n * 640 + k0) = o; }
            bf16* WST = (bf16*)(P_ws + WS_WODD + li * OD_STRIDE + OD_WST) + (size_t)g * 256 * 512;
            for (int r = 0; r < 32; ++r) { const int q = tid + 512 * r, n = q >> 6, k0 = (q & 63) * 8, s = k0 >> 4, h0 = k0 & 15; float v[8];
                if (n < 64) {
#pragma unroll
                    for (int e = 0; e < 8; ++e) v[e] = PWr[(31 - s) * 64 + n] * BBr[n * 16 + h0 + e] - PWi[(31 - s) * 64 + n] * BBi[n * 16 + h0 + e];
                } else if (n < 128) { const int p = n - 64;
#pragma unroll
                    for (int e = 0; e < 8; ++e) v[e] = PWr[(31 - s) * 64 + p] * BBi[p * 16 + h0 + e] + PWi[(31 - s) * 64 + p] * BBr[p * 16 + h0 + e];
                } else {
#pragma unroll
                    for (int e = 0; e < 8; ++e) v[e] = 0.f; }
                v4u o; o.x = pk2(v[0], v[1]); o.y = pk2(v[2], v[3]); o.z = pk2(v[4], v[5]); o.w = pk2(v[6], v[7]);
                *(GAS v4u*)(WST + (size_t)n * 512 + k0) = o; }
            __syncthreads();
        }
        for (int it = gw; it < 2 * 256; it += NGW) {
            const int li = it >> 8, r = it & 255, kb = r >> 4, gi = (r >> 2) & 3, db = r & 3, k = kb * 64 + lane;
            const float* wrow = args.in[2] + ((size_t)li * D + k) * 2048 + 1536 + gi * 128;
            const float* pw = args.in[4] + ((size_t)li * 4 + gi) * 128 * 128 + db * 32;
            float a[32];
#pragma unroll
            for (int d = 0; d < 32; ++d) a[d] = 0.f;
            for (int c4 = 0; c4 < 32; ++c4) { const f32x4 xv = *(const f32x4*)(wrow + c4 * 4);
#pragma unroll
                for (int cc = 0; cc < 4; ++cc) { const float xs = xv[cc]; const float* pr = pw + (size_t)(c4 * 4 + cc) * 128;
#pragma unroll
                    for (int d = 0; d < 32; ++d) a[d] += xs * pr[d]; } }
            const float gk = args.in[1][li * D + k];
            bf16* WT = (bf16*)(P_ws + WS_WEIN + li * EV_STRIDE + EV_EIN);
#pragma unroll
            for (int d = 0; d < 32; ++d) { const int n = gi * 128 + db * 32 + d; WT[(size_t)(1536 + n) * D + k] = (bf16)f2bf(a[d] * gk * args.in[5][li * 512 + n]); }
        }
        for (int q = bx * 512 + tid; q < 2 * 4 * 128 * 16; q += G * 512) {
            const int li = q >> 13, rem = q & 8191, hh = rem >> 11, i = (rem >> 4) & 127, j0 = (rem & 15) * 8;
            const float* src = args.in[24] + (((size_t)li * 4 + hh) * 128 + i) * 128 + j0;
            const f32x4 a = *(const f32x4*)src, b = *(const f32x4*)(src + 4);
            const bool keep = (j0 >> 6) <= (i >> 6);
            v4u o; o.x = keep ? pk2(a[0], a[1]) : 0u; o.y = keep ? pk2(a[2], a[3]) : 0u; o.z = keep ? pk2(b[0], b[1]) : 0u; o.w = keep ? pk2(b[2], b[3]) : 0u;
            *(GAS v4u*)((bf16*)(P_ws + WS_WODD + li * OD_STRIDE + OD_SGU) + ((size_t)hh * 128 + i) * 128 + j0) = o;
        }
        for (int m = gw; m < M; m += NGW) {
            const GAS f32x4* xr = (const GAS f32x4*)(args.in[0] + (size_t)m * D) + lane; f32x4 v[4]; float s = 0.f;
#pragma unroll
            for (int j = 0; j < 4; ++j) { v[j] = xr[64 * j]; s += (v[j].x * v[j].x + v[j].y * v[j].y) + (v[j].z * v[j].z + v[j].w * v[j].w); }
            s = wave_sum(s);
            GAS v2u* o8 = (GAS v2u*)(P_HB + (size_t)m * D) + lane;
#pragma unroll
            for (int j = 0; j < 4; ++j) { v2u w; w.x = pk2(v[j].x, v[j].y); w.y = pk2(v[j].z, v[j].w); o8[64 * j] = w; }
            if (lane < 16) P_SSQ[(size_t)m * 16 + lane] = lane == 0 ? s : 0.f;
        }
        {
            LAS float* tile = (LAS float*)(lds + RING_OFF); volatile LAS int* nxt = (volatile LAS int*)(lds + RING_OFF + 65536);
            unsigned* qctr = P_ctl + CW_QUEUE; int it = bx;
            const int lr = lane >> 5, nc4 = (lane & 31) * 4;
            const int cch = lane & 15, nro = lane >> 4;
#define TT_LOAD(RG, DD) do { _Pragma("unroll") for (int i = 0; i < 8; ++i) RG[i] = *(const f32x4*)((DD).src + (size_t)(wave * 16 + 2 * i + lr) * (DD).ldw + nc4); } while (0)
#define TT_STEP(RG, DD, ITC) do { \
                __syncthreads();                                                \
                _Pragma("unroll") for (int i = 0; i < 8; ++i) { const int k = wave * 16 + 2 * i + lr; *(LAS f32x4*)(tile + k * 128 + (nc4 ^ (((k >> 3) & 7) << 2))) = RG[i]; } \
                if (tid == 0) { nxt[0] = tk; tk = 2 * G + (int)__hip_atomic_fetch_add(qctr, 1u, RLX_AGENT); }     \
                __syncthreads(); \
                const int itn_ = nxt[0]; const TTile dc_ = DD; DD = decode_tile(args, P_ws, itn_ < TT_TOTAL ? itn_ : 0); \
                if (itn_ < TT_TOTAL) TT_LOAD(RG, DD); \
                f32x4 g0 = {1.f, 1.f, 1.f, 1.f}, g1 = {1.f, 1.f, 1.f, 1.f}; \
                if (dc_.gain) { g0 = *(const f32x4*)(dc_.gain + 8 * cch); g1 = *(const f32x4*)(dc_.gain + 8 * cch + 4); } \
                _Pragma("unroll") for (int i = 0; i < 4; ++i) { const int n = wave * 16 + i * 4 + nro; const int sw = n ^ ((cch & 7) << 2); const LAS float* s = tile + (8 * cch) * 128 + sw; \
                    const float e0 = s[0 * 128] * g0[0], e1 = s[1 * 128] * g0[1], e2 = s[2 * 128] * g0[2], e3 = s[3 * 128] * g0[3], e4 = s[4 * 128] * g1[0], e5 = s[5 * 128] * g1[1], e6 = s[6 * 128] * g1[2], e7 = s[7 * 128] * g1[3]; \
                    if (dc_.f8sc != 0.f) { const float q = dc_.f8sc; v2u o; o.x = pg8::pk4_fp8(e0 * q, e1 * q, e2 * q, e3 * q); o.y = pg8::pk4_fp8(e4 * q, e5 * q, e6 * q, e7 * q); \
                        *(GAS v2u*)(dc_.dst + (size_t)n * dc_.ldo_b + 8 * cch) = o; } \
                    else { v4u o; o.x = pk2(e0, e1); o.y = pk2(e2, e3); o.z = pk2(e4, e5); o.w = pk2(e6, e7); \
                        *(GAS v4u*)(dc_.dst + (size_t)n * dc_.ldo_b + 16 * cch) = o; } } \
                ITC = itn_; } while (0)
            int tk = 0; if (tid == 0) tk = 2 * G + (int)__hip_atomic_fetch_add(qctr, 1u, RLX_AGENT);
            f32x4 rgA[8], rgB[8]; int itA = bx, itB = bx + G;
            TTile dA = decode_tile(args, P_ws, itA < TT_TOTAL ? itA : 0), dB = decode_tile(args, P_ws, itB < TT_TOTAL ? itB : 0);
            if (itA < TT_TOTAL) TT_LOAD(rgA, dA);
            if (itB < TT_TOTAL) TT_LOAD(rgB, dB);
            for (;;) {
                if (itA < TT_TOTAL) TT_STEP(rgA, dA, itA);
                if (itB < TT_TOTAL) TT_STEP(rgB, dB, itB);
                if (itA >= TT_TOTAL && itB >= TT_TOTAL) break;
            }
#undef TT_LOAD
#undef TT_STEP
            __syncthreads();
        }
    }
    SEAM(0);

    for (int lp = 0; lp < 2; ++lp) {
        const int pb = 1 + lp * 15;
        if (IN(pb + 0)) {
            pg8::GDs g{P_HB, (const bf16*)(P_wev + EV_EIN), D, D, D, 30, 0}; pg8::Order S; S.init(M / 256, 2048 / 256, G_O, BX_O);
            RST_PREAMBLE(S);
            pg8::EpiScaleBf16 E{P_Z, 2048, (const LAS float*)(lds + RST_OFF)};
            pg8::gemm_phase<pg8::EpiScaleBf16, pg8::Order, pg8::GDs>(lds + RING_OFF, g, S, E, wave_s);
        }
        SEAM(pb + 0);
        for (int rep_ = 0; rep_ < REP_E2; ++rep_)
        if (IN(pb + 1)) {
            PHASE_IDS
            const float* cw = INP(3) + (size_t)lp * 3 * 512;
            const int cv = tid & 63, c0 = 8 * cv;
            f32x4 cwv[3][2];
#pragma unroll
            for (int k = 0; k < 3; ++k) { cwv[k][0] = *(const f32x4*)(cw + (2 - k) * 512 + c0); cwv[k][1] = *(const f32x4*)(cw + (2 - k) * 512 + c0 + 4); }
            const int gi = wave & 3;
            for (int vb = bx; vb < 256; vb += G) {
                for (int itx = 0; itx < 8; ++itx) {
                    const int tc = vb * 64 + itx * 8 + (tid >> 6), lc = tc & (SEQ - 1);
                    const bf16* zr = P_Z + (size_t)tc * 2048 + c0; const bool v1 = lc >= 1, v2 = lc >= 2;
                    const bf16* zr1 = v1 ? zr - 2048 : zr; const bf16* zr2 = v2 ? zr - 4096 : zr;
                    const v4u gb = *(const GAS v4u*)(zr), gc0 = *(const GAS v4u*)(zr + 512), xa0 = *(const GAS v4u*)(zr + 1024);
                    const v4u gc1 = *(const GAS v4u*)(zr1 + 512), xa1 = *(const GAS v4u*)(zr1 + 1024), gc2 = *(const GAS v4u*)(zr2 + 512), xa2 = *(const GAS v4u*)(zr2 + 1024);
                    const int t = vb * 64 + itx * 8 + 4 * (wave >> 2) + (lane >> 4), l = t & (SEQ - 1), pc0 = gi * 128 + 8 * (lane & 15);
                    const bf16* qr = P_Z + (size_t)t * 2048 + 1536 + pc0; float s[8];
#pragma unroll
                    for (int e = 0; e < 8; ++e) s[e] = 0.f;
                    v4u q0;
#define POOLW(WN) { v4u q[WN]; _Pragma("unroll") for (int k = 0; k < WN; ++k) q[k] = *(const GAS v4u*)(k <= l ? qr - (size_t)k * 2048 : qr); q0 = q[0]; \
                        _Pragma("unroll") for (int k = 0; k < WN; ++k) { const float mk = k <= l ? 1.f : 0.f; s[0] += mk * bflo(q[k].x); s[1] += mk * bfhi(q[k].x); s[2] += mk * bflo(q[k].y); s[3] += mk * bfhi(q[k].y); \
                            s[4] += mk * bflo(q[k].z); s[5] += mk * bfhi(q[k].z); s[6] += mk * bflo(q[k].w); s[7] += mk * bfhi(q[k].w); } }
                    if (gi == 0) POOLW(2) else if (gi == 1) POOLW(4) else if (gi == 2) POOLW(8) else POOLW(16)
#undef POOLW
                    {
                        const float m1 = v1 ? 1.f : 0.f, m2 = v2 ? 1.f : 0.f; float o[8];
#define CONV1(e, G0, X0, G1, X1, G2, X2, W) o[e] = cwv[0][(e) >> 2][(e) & 3] * W(G0) * W(X0) + m1 * cwv[1][(e) >> 2][(e) & 3] * W(G1) * W(X1) + m2 * cwv[2][(e) >> 2][(e) & 3] * W(G2) * W(X2)
                        CONV1(0, gc0.x, xa0.x, gc1.x, xa1.x, gc2.x, xa2.x, bflo); CONV1(1, gc0.x, xa0.x, gc1.x, xa1.x, gc2.x, xa2.x, bfhi);
                        CONV1(2, gc0.y, xa0.y, gc1.y, xa1.y, gc2.y, xa2.y, bflo); CONV1(3, gc0.y, xa0.y, gc1.y, xa1.y, gc2.y, xa2.y, bfhi);
                        CONV1(4, gc0.z, xa0.z, gc1.z, xa1.z, gc2.z, xa2.z, bflo); CONV1(5, gc0.z, xa0.z, gc1.z, xa1.z, gc2.z, xa2.z, bfhi);
                        CONV1(6, gc0.w, xa0.w, gc1.w, xa1.w, gc2.w, xa2.w, bflo); CONV1(7, gc0.w, xa0.w, gc1.w, xa1.w, gc2.w, xa2.w, bfhi);
#undef CONV1
                        v4u ov; ov.x = pk2(bflo(gb.x) * o[0], bfhi(gb.x) * o[1]); ov.y = pk2(bflo(gb.y) * o[2], bfhi(gb.y) * o[3]); ov.z = pk2(bflo(gb.z) * o[4], bfhi(gb.z) * o[5]); ov.w = pk2(bflo(gb.w) * o[6], bfhi(gb.w) * o[7]);
                        *(GAS v4u*)(P_MIX + (size_t)tc * 1024 + c0) = ov;
                    }
                    {
                        const int w = 2 << gi, cnt = (l + 1) < w ? (l + 1) : w; const float inv = 1.0f / (float)cnt;
                        v4u ov; ov.x = pk2(s[0] * inv - bflo(q0.x), s[1] * inv - bfhi(q0.x)); ov.y = pk2(s[2] * inv - bflo(q0.y), s[3] * inv - bfhi(q0.y));
                        ov.z = pk2(s[4] * inv - bflo(q0.z), s[5] * inv - bfhi(q0.z)); ov.w = pk2(s[6] * inv - bflo(q0.w), s[7] * inv - bfhi(q0.w));
                        *(GAS v4u*)(P_MIX + (size_t)t * 1024 + 512 + pc0) = ov;
                    }
                }
            }
        }
        SEAM(pb + 1);
        const bool ffn8 = F8_LAST && lp >= F8_FFN_FROM;
        if (IN(pb + 2)) {
            pg8::GDs g{P_MIX, (const bf16*)(P_wev + EV_EOUT), D, D, D, 30, 0}; pg8::Order S; S.init(M / 256, D / 256, G_O, BX_O);
            pg8::EpiResidB<false> E{P_HB, P_SSQ, 1.0f, ffn8 ? (unsigned char*)P_Z : nullptr};
            pg8::gemm_phase<pg8::EpiResidB<false>, pg8::Order, pg8::GDs>(lds + RING_OFF, g, S, E, wave_s);
        }
        SEAM(pb + 2);
        if (IN(pb + 3)) {
            pg8::Order S; S.init(M / 256, FFN / 128, G_O, BX_O);
            RST_PREAMBLE(S);
            if (ffn8) {
                pg8::GDs g{P_Z, (const bf16*)(P_wev + EV_E13), D / 2, D / 2, D / 2, 30, 0};
                pg8::EpiSwiGLUF8<true> E{(unsigned char*)P_UF, FFN, 1.0f / F8_W13_SC, F8_UM_SC, (const LAS float*)(lds + RST_OFF)};
                pg8::gemm_phase<pg8::EpiSwiGLUF8<true>, pg8::Order, pg8::GDs, 1>(lds + RING_OFF, g, S, E, wave_s);
            } else {
                pg8::GDs g{P_HB, (const bf16*)(P_wev + EV_E13), D, D, D, 30, 0};
                pg8::EpiSwiGLU<false> E{P_UF, FFN, (const LAS float*)(lds + RST_OFF)};
                pg8::gemm_phase<pg8::EpiSwiGLU<false>, pg8::Order, pg8::GDs>(lds + RING_OFF, g, S, E, wave_s);
            }
        }
        SEAM(pb + 3);
        if (IN(pb + 4)) {
            pg8::Order S; S.init(M / 256, D / 256, G_O, BX_O);
            if (ffn8) {
                pg8::GDs g{P_UF, (const bf16*)(P_wev + EV_E2), FFN / 2, FFN / 2, FFN / 2, 30, 0};
                pg8::EpiResidB<true> E{P_HB, P_SSQ, 1.0f / (F8_UM_SC * F8_W2_SC), nullptr};
                pg8::gemm_phase<pg8::EpiResidB<true>, pg8::Order, pg8::GDs, 1>(lds + RING_OFF, g, S, E, wave_s);
            } else {
                pg8::GDs g{P_UF, (const bf16*)(P_wev + EV_E2), FFN, FFN, FFN, 30, 0};
                pg8::EpiResidB<false> E{P_HB, P_SSQ, 1.0f, nullptr};
                pg8::gemm_phase<pg8::EpiResidB<false>, pg8::Order, pg8::GDs>(lds + RING_OFF, g, S, E, wave_s);
            }
        }
        SEAM(pb + 4);
        if (IN(pb + 5)) {
            pg8::GDs g{P_HB, (const bf16*)(P_wod + OD_OIN), D, D, D, 30, 0}; pg8::Order S; S.init(M / 256, 1536 / 256, G_O, BX_O);
            RST_PREAMBLE(S);
            pg8::EpiOddIn E{P_AG, P_ZUV, (const LAS float*)(lds + RST_OFF)};
            pg8::gemm_phase<pg8::EpiOddIn, pg8::Order, pg8::GDs>(lds + RING_OFF, g, S, E, wave_s);
        }
        SEAM(pb + 5);
        if (IN(pb + 6)) {
            const int NS5 = G >= 128 ? 64 : 0;
            if (NS5 == 0 || bx < NS5) {
                pg8::GDs g{P_AG + 128, (const bf16*)(P_wod + OD_WST), 640, 512, 512, 1, (size_t)256 * 512}; pg8::Order S; S.init(64, 1, NS5 ? NS5 : G_O, BX_O);
                pg8::EpiS5Scan E{P_AG, (const float*)(P_sm + SM_AT) + (size_t)lp * 32 * 64 * 2};
                pg8::gemm_phase<pg8::EpiS5Scan, pg8::Order, pg8::GDs>(lds + RING_OFF, g, S, E, wave_s);
            }
            for (int rep_ = 0; rep_ < REP_SGU; ++rep_)
            if (NS5 == 0 || bx >= NS5) {
                PHASE_IDS
                const int nwk = NS5 ? G - NS5 : G, wk = NS5 ? bx - NS5 : bx;
                LAS bf16* vT = (LAS bf16*)(lds + RING_OFF);
                const bf16* Wm = (const bf16*)(P_wod + OD_SGU);
                const float* lng = INP(23) + lp * 512; const float* sb = INP(25) + lp * 512;
                const int j_ln = tid >> 2, cq = tid & 3, fr = lane & 15, fq = lane >> 4, i_pos = wave * 16 + fr;
                for (int un = wk; un < 512; un += nwk) {
                    const int nb = un >> 2, hh = un & 3;
                    v4u vraw[4];
                    { const bf16* src = P_ZUV + (size_t)(nb * 128 + j_ln) * 1024 + 512 + hh * 128 + cq * 32;
#pragma unroll
                      for (int q4 = 0; q4 < 4; ++q4) vraw[q4] = *(const GAS v4u*)(src + q4 * 8); }
                    bf16x8 wf[4];
#pragma unroll
                    for (int ks = 0; ks < 4; ++ks) wf[ks] = *(const GAS bf16x8*)(Wm + ((size_t)hh * 128 + i_pos) * 128 + ks * 32 + fq * 8);
                    const float bias = sb[hh * 128 + i_pos]; const size_t tok = (size_t)(nb * 128 + i_pos);
                    v2u uu[8];
#pragma unroll
                    for (int ct = 0; ct < 8; ++ct) uu[ct] = *(const GAS v2u*)(P_ZUV + tok * 1024 + hh * 128 + ct * 16 + fq * 4);
                    __syncthreads();
                    {
                        float v[32]; float s = 0.f;
#pragma unroll
                        for (int q4 = 0; q4 < 4; ++q4) { const v4u w = vraw[q4];
                            v[q4 * 8 + 0] = bflo(w.x); v[q4 * 8 + 1] = bfhi(w.x); v[q4 * 8 + 2] = bflo(w.y); v[q4 * 8 + 3] = bfhi(w.y);
                            v[q4 * 8 + 4] = bflo(w.z); v[q4 * 8 + 5] = bfhi(w.z); v[q4 * 8 + 6] = bflo(w.w); v[q4 * 8 + 7] = bfhi(w.w); }
#pragma unroll
                        for (int e = 0; e < 32; ++e) s += v[e];
                        s += __shfl_xor(s, 1); s += __shfl_xor(s, 2);
                        const float mu = s * (1.0f / 128.0f); float q = 0.f;
#pragma unroll
                        for (int e = 0; e < 32; ++e) { v[e] -= mu; q += v[e] * v[e]; }
                        q += __shfl_xor(q, 1); q += __shfl_xor(q, 2);
                        const float rstd = 1.0f / sqrtf(q * (1.0f / 128.0f) + 1e-5f);
#pragma unroll
                        for (int e = 0; e < 32; ++e) { const int c = cq * 32 + e; vT[c * 136 + j_ln] = (bf16)f2bf(v[e] * rstd * lng[hh * 128 + c]); }
                    }
                    __syncthreads();
                    {
                        f32x4 acc[8];
#pragma unroll
                        for (int ct = 0; ct < 8; ++ct) acc[ct] = (f32x4){0.f, 0.f, 0.f, 0.f};
#pragma unroll
                        for (int ks = 0; ks < 4; ++ks) {
#pragma unroll
                            for (int ct = 0; ct < 8; ++ct) { const bf16x8 vf = *(const LAS bf16x8*)(vT + (ct * 16 + fr) * 136 + ks * 32 + fq * 8);
                                acc[ct] = __builtin_amdgcn_mfma_f32_16x16x32_bf16(vf, wf[ks], acc[ct], 0, 0, 0); }
                        }
#pragma unroll
                        for (int ct = 0; ct < 8; ++ct) { const int c = ct * 16 + fq * 4;
                            v2u o; o.x = pk2(bflo(uu[ct].x) * (acc[ct][0] + bias), bfhi(uu[ct].x) * (acc[ct][1] + bias)); o.y = pk2(bflo(uu[ct].y) * (acc[ct][2] + bias), bfhi(uu[ct].y) * (acc[ct][3] + bias));
                            *(GAS v2u*)(P_MIX + tok * 1024 + 512 + hh * 128 + c) = o; }
                    }
                }
                __syncthreads();
            }
        }
        SEAM(pb + 6);
        if (IN(pb + 7)) {
            pg8::GDh g{P_AG, (const bf16*)(P_wod + OD_MY), 640, 640, 640, 1, (size_t)512 * 640}; pg8::Order S; S.init(64, 4, G_O, BX_O);
            pg8::EpiS5Y E{P_AG, INP(20) + lp * 512, P_GY};
            pg8::gemm_phase<pg8::EpiS5Y, pg8::Order, pg8::GDh>(lds + RING_OFF, g, S, E, wave_s);
        }
        SEAM(pb + 7);
        if (IN(pb + 8)) {
            pg8::GDh g{P_GY, (const bf16*)(P_wod + OD_GLU), 512, 512, 512, 30, 0}; pg8::Order S; S.init(M / 256, 4, G_O, BX_O);
            pg8::EpiGLU E{P_GY, INP(22) + lp * 512, P_MIX};
            pg8::gemm_phase<pg8::EpiGLU, pg8::Order, pg8::GDh>(lds + RING_OFF, g, S, E, wave_s);
        }
        SEAM(pb + 8);
        if (IN(pb + 9)) {
            pg8::GDs g{P_MIX, (const bf16*)(P_wod + OD_OOUT), D, D, D, 30, 0}; pg8::Order S; S.init(M / 256, D / 256, G_O, BX_O);
            pg8::EpiResidB<false> E{P_HB, P_SSQ, 1.0f, nullptr};
            pg8::gemm_phase<pg8::EpiResidB<false>, pg8::Order, pg8::GDs>(lds + RING_OFF, g, S, E, wave_s);
        }
        SEAM(pb + 9);
        for (int rep_ = 0; rep_ < REP_ROUTE; ++rep_)
        if (IN(pb + 10)) {
            PHASE_IDS
            LAS int* tE = (LAS int*)(lds + RING_OFF);
            const float* Wr = INP(28) + (size_t)lp * D * 8; const float* g2 = INP(27) + lp * D;
            float gw[4][4][8];
#pragma unroll
            for (int j = 0; j < 4; ++j) { const f32x4 gv = *(const f32x4*)(g2 + 256 * j + 4 * lane);
#pragma unroll
                for (int i = 0; i < 4; ++i) { const float* wp = Wr + (size_t)(256 * j + 4 * lane + i) * 8; const f32x4 w0 = *(const f32x4*)wp, w1 = *(const f32x4*)(wp + 4);
#pragma unroll
                    for (int e = 0; e < 4; ++e) { gw[j][i][e] = w0[e] * gv[i]; gw[j][i][4 + e] = w1[e] * gv[i]; } } }
            const bool b0 = lane & 1, b1 = lane & 2, b2 = lane & 4;
            __syncthreads();
            for (int vb = bx; vb < 256; vb += G) {
                for (int tt = 0; tt < 8; tt += 2) {
                    const int tl = wave * 8 + tt, t = vb * 64 + tl;
                    const GAS v2u* hr = (const GAS v2u*)(P_HB + (size_t)t * D) + lane;
                    v2u hw2[2][4];
#pragma unroll
                    for (int q = 0; q < 2; ++q)
#pragma unroll
                        for (int j = 0; j < 4; ++j) hw2[q][j] = hr[q * 256 + 64 * j];
                    f32x4 hv2[2][4];
#pragma unroll
                    for (int q = 0; q < 2; ++q)
#pragma unroll
                        for (int j = 0; j < 4; ++j) { hv2[q][j].x = bflo(hw2[q][j].x); hv2[q][j].y = bfhi(hw2[q][j].x); hv2[q][j].z = bflo(hw2[q][j].y); hv2[q][j].w = bfhi(hw2[q][j].y); }
#pragma unroll
                    for (int q = 0; q < 2; ++q) {
                        float lg[8]; float ss = 0.f;
#pragma unroll
                        for (int e = 0; e < 8; ++e) lg[e] = 0.f;
#pragma unroll
                        for (int j = 0; j < 4; ++j) { const f32x4 hv = hv2[q][j]; ss += (hv.x * hv.x + hv.y * hv.y) + (hv.z * hv.z + hv.w * hv.w);
#pragma unroll
                            for (int i = 0; i < 4; ++i) { const float hvi = hv[i];
#pragma unroll
                                for (int e = 0; e < 8; ++e) lg[e] += hvi * gw[j][i][e]; } }
                        ss = wave_sum(ss);
                        float ra[4], rb[2], rc;
#pragma unroll
                        for (int qq = 0; qq < 4; ++qq) { const float mine = b0 ? lg[4 + qq] : lg[qq], oth = b0 ? lg[qq] : lg[4 + qq]; ra[qq] = mine + __shfl_xor(oth, 1); }
#pragma unroll
                        for (int r = 0; r < 2; ++r) { const float mine = b1 ? ra[2 + r] : ra[r], oth = b1 ? ra[r] : ra[2 + r]; rb[r] = mine + __shfl_xor(oth, 2); }
                        { const float mine = b2 ? rb[1] : rb[0], oth = b2 ? rb[0] : rb[1]; rc = mine + __shfl_xor(oth, 4); }
                        rc += __shfl_xor(rc, 8); rc += __shfl_xor(rc, 16); rc += __shfl_xor(rc, 32);
                        const float rstd = 1.0f / sqrtf(ss * (1.0f / 1024.0f) + 1e-5f);
                        float lv[8];
#pragma unroll
                        for (int e = 0; e < 8; ++e) lv[e] = __shfl(rc, (e >> 2) + 2 * ((e >> 1) & 1) + 4 * (e & 1)) * rstd;
                        int e0 = 0; float v0 = lv[0];
#pragma unroll
                        for (int e = 1; e < 8; ++e) { if (lv[e] > v0) { v0 = lv[e]; e0 = e; } }
                        int e1 = -1; float v1 = 0.f;
#pragma unroll
                        for (int e = 0; e < 8; ++e) { if (e != e0 && (e1 < 0 || lv[e] > v1)) { v1 = lv[e]; e1 = e; } }
                        const float ex = __expf(v1 - v0), w0 = 1.0f / (1.0f + ex), w1 = ex * w0;
                        if (lane == 0) { tE[(tl + q) * 2] = e0; tE[(tl + q) * 2 + 1] = e1; P_TOKE[(t + q) * 2] = e0; P_TOKE[(t + q) * 2 + 1] = e1; P_TOKW[(t + q) * 2] = w0; P_TOKW[(t + q) * 2 + 1] = w1; P_RSTD[t + q] = rstd; }
                    }
                }
                __syncthreads();
                if (wave == 0) { const int e0 = tE[lane * 2], e1 = tE[lane * 2 + 1], t = vb * 64 + lane; int r0 = 0, r1 = 0;
#pragma unroll
                    for (int e = 0; e < 8; ++e) { const unsigned long long mk = __ballot(e0 == e || e1 == e); const int rk = __popcll(mk & ((1ull << lane) - 1ull));
                        if (e0 == e) r0 = rk; if (e1 == e) r1 = rk; if (lane == 0) P_WGCNT[vb * 8 + e] = __popcll(mk); }
                    P_TOKR[t * 2] = r0; P_TOKR[t * 2 + 1] = r1; }
                __syncthreads();
            }
        }
        SEAM(pb + 10);
        for (int rep_ = 0; rep_ < REP_ROUTE; ++rep_)
        if (IN(pb + 11)) {
            PHASE_IDS
            const bool f8 = F8_LAST && lp >= F8_FROM;
            LAS int* cntT = (LAS int*)(lds + RING_OFF);
            LAS int* pre = cntT + 32;
            __syncthreads();
            {
                const int e = wave; int s = 0;
#pragma unroll
                for (int i = 0; i < 4; ++i) s += P_WGCNT[(lane * 4 + i) * 8 + e];
#pragma unroll
                for (int o = 1; o < 64; o <<= 1) s += __shfl_xor(s, o);
                if (lane == 0) { cntT[e] = s; cntT[16 + e] = (s + 255) & ~255; }
            }
            __syncthreads();
            if (tid == 0) { int b = 0; for (int e = 0; e < 8; ++e) { cntT[8 + e] = b; b += cntT[16 + e]; } cntT[24] = b >> 8; }
            __syncthreads();
            if (bx == 0) { const int np = cntT[24];
                if (tid < MAXPAN) { int ex = 0; for (int e = 0; e < 8; ++e) if (tid * 256 >= cntT[8 + e]) ex = e; P_PANEL[tid] = tid < np ? ex : 0; }
                if (tid == 0) P_PANEL[MAXPAN] = np; }
            for (int e = bx; e < 8; e += G) {
                const int r0 = cntT[8 + e] + cntT[e], r1 = cntT[8 + e] + cntT[16 + e];
                if (tid < r1 - r0 && r0 + tid >= 128 * 256) P_ROWT[r0 + tid] = -1;
                if (f8) { for (int q = tid; q < (r1 - r0) * 64; q += 512) { const int r = r0 + (q >> 6); *(GAS v4u*)((unsigned char*)P_XS + (size_t)r * D + (q & 63) * 16) = (v4u){0u, 0u, 0u, 0u}; } }
                else { for (int q = tid; q < (r1 - r0) * 128; q += 512) { const int r = r0 + (q >> 7); *(GAS v4u*)(P_XS + (size_t)r * D + (q & 127) * 8) = (v4u){0u, 0u, 0u, 0u}; } }
            }
            for (int vb = bx; vb < 256; vb += G) {
                __syncthreads();
                {   const int e = wave; int s = 0;
#pragma unroll
                    for (int i = 0; i < 4; ++i) { const int b2 = lane * 4 + i; s += b2 < vb ? P_WGCNT[b2 * 8 + e] : 0; }
#pragma unroll
                    for (int o = 1; o < 64; o <<= 1) s += __shfl_xor(s, o);
                    if (lane == 0) pre[e] = s; }
                __syncthreads();
                int mp0 = 0, mp1 = 0; float mrs = 0.f;
                if (lane < 8) { const int t = vb * 64 + wave * 8 + lane; const int e0 = P_TOKE[t * 2], e1 = P_TOKE[t * 2 + 1];
                    mp0 = cntT[8 + e0] + pre[e0] + P_TOKR[t * 2]; mp1 = cntT[8 + e1] + pre[e1] + P_TOKR[t * 2 + 1]; mrs = P_RSTD[t];
                    P_TOKP[t * 2] = mp0; P_TOKP[t * 2 + 1] = mp1; if (mp0 >= 128 * 256) P_ROWT[mp0] = t; if (mp1 >= 128 * 256) P_ROWT[mp1] = t; }
                for (int tt = 0; tt < 8; tt += 2) {
                    const int t = vb * 64 + wave * 8 + tt;
                    const GAS v2u* hr = (const GAS v2u*)(P_HB + (size_t)t * D) + lane;
                    v2u hw2[2][4];
#pragma unroll
                    for (int q = 0; q < 2; ++q)
#pragma unroll
                        for (int j = 0; j < 4; ++j) hw2[q][j] = hr[q * 256 + 64 * j];
                    f32x4 hv2[2][4];
#pragma unroll
                    for (int q = 0; q < 2; ++q)
#pragma unroll
                        for (int j = 0; j < 4; ++j) { hv2[q][j].x = bflo(hw2[q][j].x); hv2[q][j].y = bfhi(hw2[q][j].x); hv2[q][j].z = bflo(hw2[q][j].y); hv2[q][j].w = bfhi(hw2[q][j].y); }
#pragma unroll
                    for (int q = 0; q < 2; ++q) {
                        const int p0 = __shfl(mp0, tt + q), p1 = __shfl(mp1, tt + q); const float rstd = __shfl(mrs, tt + q);
                        if (f8) { GAS unsigned* o0 = (GAS unsigned*)((unsigned char*)P_XS + (size_t)p0 * D) + lane; GAS unsigned* o1 = (GAS unsigned*)((unsigned char*)P_XS + (size_t)p1 * D) + lane;
#pragma unroll
                            for (int j = 0; j < 4; ++j) { const f32x4 hv = hv2[q][j]; const unsigned w = pg8::pk4_fp8(hv.x * rstd, hv.y * rstd, hv.z * rstd, hv.w * rstd); o0[64 * j] = w; o1[64 * j] = w; }
                        } else { GAS v2u* o0 = (GAS v2u*)(P_XS + (size_t)p0 * D) + lane; GAS v2u* o1 = (GAS v2u*)(P_XS + (size_t)p1 * D) + lane;
#pragma unroll
                            for (int j = 0; j < 4; ++j) { const f32x4 hv = hv2[q][j]; v2u w; w.x = pk2(hv.x * rstd, hv.y * rstd); w.y = pk2(hv.z * rstd, hv.w * rstd); o0[64 * j] = w; o1[64 * j] = w; } }
                    }
                }
            }
        }
        SEAM(pb + 11);
        LAS int* ptab = (LAS int*)(lds + PTAB_OFF);
        if (IN(pb + 12) || IN(pb + 13)) {
            PHASE_IDS
            __syncthreads();
            if (tid <= MAXPAN) ptab[tid] = (int)__hip_atomic_load((unsigned*)P_PANEL + tid, RLX_AGENT);
            __syncthreads();
        }
        if (IN(pb + 12)) {
            const int np = __builtin_amdgcn_readfirstlane(ptab[MAXPAN]);
            pg8::Order S; S.init(np, EXD / 128, G_O, BX_O);
            if (F8_LAST && lp >= F8_FROM) {
                pg8::GDt g{P_XS, (const bf16*)(P_wod + OD_M13), D / 2, D / 2, D / 2, (size_t)EXD * D, ptab};
                pg8::EpiSwiGLUF8<false> E{(unsigned char*)P_UM, EXD, 1.0f / F8_W13_SC, F8_UM_SC, nullptr};
                pg8::gemm_phase<pg8::EpiSwiGLUF8<false>, pg8::Order, pg8::GDt, 1>(lds + RING_OFF, g, S, E, wave_s);
            } else {
                pg8::GDt g{P_XS, (const bf16*)(P_wod + OD_M13), D, D, D, (size_t)2 * EXD * D, ptab};
                pg8::EpiSwiGLU<true> E{P_UM, EXD, nullptr};
                pg8::gemm_phase<pg8::EpiSwiGLU<true>, pg8::Order, pg8::GDt>(lds + RING_OFF, g, S, E, wave_s);
            }
        }
        SEAM(pb + 12);
        if (IN(pb + 13)) {
            const int np = __builtin_amdgcn_readfirstlane(ptab[MAXPAN]);
            if (F8_LAST && lp >= F8_FROM) {
                const float osc = 1.0f / (F8_UM_SC * F8_W2_SC);
                {   pg8::GDt g{P_UM, (const bf16*)(P_wod + OD_M2), EXD / 2, EXD / 2, EXD / 2, (size_t)D * EXD / 2, ptab}; pg8::Order S; S.init(np < 128 ? np : 128, D / 256, G_O, BX_O);
                    pg8::EpiBf16 E{P_XS, D, osc};
                    pg8::gemm_phase<pg8::EpiBf16, pg8::Order, pg8::GDt, 1>(lds + RING_OFF, g, S, E, wave_s); }
                if (np > 128) {
                    pg8::GDk g{P_UM, (const bf16*)(P_wod + OD_M2), EXD / 2, EXD / 2, 256, (size_t)D * EXD / 2, ptab, 128, 256}; pg8::Order S; S.init(np - 128, 28, G_O, BX_O);
                    pg8::EpiPartF32 E{(float*)(P_ws + WS_PART), osc};
                    pg8::gemm_phase<pg8::EpiPartF32, pg8::Order, pg8::GDk, 1>(lds + RING_OFF, g, S, E, wave_s); }
            } else {
                {
                    pg8::GDt g{P_UM, (const bf16*)(P_wod + OD_M2), EXD, EXD, EXD, (size_t)D * EXD, ptab}; pg8::Order S; S.init(np < 128 ? np : 128, D / 256, G_O, BX_O);
                    pg8::EpiBf16 E{P_XS, D, 1.0f};
                    pg8::gemm_phase<pg8::EpiBf16, pg8::Order, pg8::GDt>(lds + RING_OFF, g, S, E, wave_s); }
                if (np > 128) {
                    pg8::GDk g{P_UM, (const bf16*)(P_wod + OD_M2), EXD, EXD, 512, (size_t)D * EXD, ptab, 128, 512}; pg8::Order S; S.init(np - 128, 28, G_O, BX_O);
                    pg8::EpiPartF32 E{(float*)(P_ws + WS_PART), 1.0f};
                    pg8::gemm_phase<pg8::EpiPartF32, pg8::Order, pg8::GDk>(lds + RING_OFF, g, S, E, wave_s); }
            }
        }
        SEAM(pb + 13);
        if (IN(pb + 14)) {
            PHASE_IDS
            const int gw = bx * NWAVES + wave, NGW = G * NWAVES; const bf16* YC = P_XS; const float* fg = INP(32); const float* PART = (const float*)(P_ws + WS_PART);
            int mp0 = 0, mp1 = 0; float mw0 = 0.f, mw1 = 0.f;
            if (lane < 8 && gw + lane * NGW < M) { const int t = gw + lane * NGW; mp0 = P_TOKP[t * 2]; mp1 = P_TOKP[t * 2 + 1]; mw0 = P_TOKW[t * 2]; mw1 = P_TOKW[t * 2 + 1]; }
#define COMBINE_FIN(T, V, AV, BV, FAST, PP0, PP1, GW0, GW1) do { GAS f32x4* hr_ = (GAS f32x4*)(P_H + (size_t)(T) * D) + lane; float s_ = 0.f;   \
                if (FAST) { _Pragma("unroll") for (int j = 0; j < 4; ++j) { V[j].x += GW0 * bflo(AV[j].x) + GW1 * bflo(BV[j].x); V[j].y += GW0 * bfhi(AV[j].x) + GW1 * bfhi(BV[j].x); V[j].z += GW0 * bflo(AV[j].y) + GW1 * bflo(BV[j].y); V[j].w += GW0 * bfhi(AV[j].y) + GW1 * bfhi(BV[j].y); } } \
                else { _Pragma("unroll") for (int sl = 0; sl < 2; ++sl) { const int p_ = sl ? PP1 : PP0; const float gwt_ = sl ? GW1 : GW0; \
                        if (p_ < 128 * 256) { const GAS v2u* y_ = (const GAS v2u*)(YC + (size_t)p_ * D) + lane; \
                            _Pragma("unroll") for (int j = 0; j < 4; ++j) { const v2u a_ = y_[64 * j]; V[j].x += gwt_ * bflo(a_.x); V[j].y += gwt_ * bfhi(a_.x); V[j].z += gwt_ * bflo(a_.y); V[j].w += gwt_ * bfhi(a_.y); } } \
                        else { const int q_ = (p_ - 128 * 256) >> 8, r_ = p_ & 255; \
                            for (int ks = 0; ks < 7; ++ks) { const GAS f32x4* y_ = (const GAS f32x4*)(PART + ((size_t)(q_ * 7 + ks) * 256 + r_) * D) + lane; \
                                _Pragma("unroll") for (int j = 0; j < 4; ++j) V[j] += gwt_ * y_[64 * j]; } } } } \
                _Pragma("unroll") for (int j = 0; j < 4; ++j) s_ += (V[j].x * V[j].x + V[j].y * V[j].y) + (V[j].z * V[j].z + V[j].w * V[j].w); \
                s_ = wave_sum(s_); \
                if (lp == 1) { const float rstd_ = 1.0f / sqrtf(s_ * (1.0f / 1024.0f) + 1e-5f); \
                    _Pragma("unroll") for (int j = 0; j < 4; ++j) { const f32x4 gv_ = *((const GAS f32x4*)fg + lane + 64 * j); f32x4 o_; o_.x = V[j].x * rstd_ * gv_.x; o_.y = V[j].y * rstd_ * gv_.y; o_.z = V[j].z * rstd_ * gv_.z; o_.w = V[j].w * rstd_ * gv_.w; hr_[64 * j] = o_; } } \
                else { GAS v2u* o8_ = (GAS v2u*)(P_HB + (size_t)(T) * D) + lane; \
                    _Pragma("unroll") for (int j = 0; j < 4; ++j) { v2u w_; w_.x = pk2(V[j].x, V[j].y); w_.y = pk2(V[j].z, V[j].w); o8_[64 * j] = w_; } \
                    if (lane < 16) P_SSQ[(size_t)(T) * 16 + lane] = lane == 0 ? s_ : 0.f; } } while (0)
            for (int it = 0; it < 8; it += 2) {
                const int t0 = gw + it * NGW, t1 = t0 + NGW; if (t0 >= M) break;
                const bool ok1 = t1 < M;
                const int p00 = __shfl(mp0, it), p01 = __shfl(mp1, it), p10 = __shfl(mp0, it + 1), p11 = __shfl(mp1, it + 1);
                const float g00 = __shfl(mw0, it), g01 = __shfl(mw1, it), g10 = __shfl(mw0, it + 1), g11 = __shfl(mw1, it + 1);
                const bool fast0 = p00 < 128 * 256 && p01 < 128 * 256, fast1 = ok1 && p10 < 128 * 256 && p11 < 128 * 256;
                f32x4 v0[4], v1[4]; v2u a0[4], b0[4], a1[4], b1[4], h0w[4], h1w[4];
                const int t1c = ok1 ? t1 : t0;
                const GAS v2u* hr0 = (const GAS v2u*)(P_HB + (size_t)t0 * D) + lane; const GAS v2u* hr1 = (const GAS v2u*)(P_HB + (size_t)t1c * D) + lane;
                const GAS v2u* y00 = (const GAS v2u*)(YC + (size_t)(fast0 ? p00 : 0) * D) + lane; const GAS v2u* y01 = (const GAS v2u*)(YC + (size_t)(fast0 ? p01 : 0) * D) + lane;
                const GAS v2u* y10 = (const GAS v2u*)(YC + (size_t)(fast1 ? p10 : 0) * D) + lane; const GAS v2u* y11 = (const GAS v2u*)(YC + (size_t)(fast1 ? p11 : 0) * D) + lane;
#pragma unroll
                for (int j = 0; j < 4; ++j) { h0w[j] = hr0[64 * j]; a0[j] = y00[64 * j]; b0[j] = y01[64 * j]; }
#pragma unroll
                for (int j = 0; j < 4; ++j) { h1w[j] = hr1[64 * j]; a1[j] = y10[64 * j]; b1[j] = y11[64 * j]; }
#pragma unroll
                for (int j = 0; j < 4; ++j) { v0[j].x = bflo(h0w[j].x); v0[j].y = bfhi(h0w[j].x); v0[j].z = bflo(h0w[j].y); v0[j].w = bfhi(h0w[j].y); v1[j].x = bflo(h1w[j].x); v1[j].y = bfhi(h1w[j].x); v1[j].z = bflo(h1w[j].y); v1[j].w = bfhi(h1w[j].y); }
                if (fast0) COMBINE_FIN(t0, v0, a0, b0, true, p00, p01, g00, g01);
                if (fast1) COMBINE_FIN(t1, v1, a1, b1, true, p10, p11, g10, g11);
            }
            {
                const int nrow = (int)__hip_atomic_load((unsigned*)P_PANEL + MAXPAN, RLX_AGENT) * 256;
                for (int r = 128 * 256 + gw; r < nrow; r += NGW) {
                    const int t = __builtin_amdgcn_readfirstlane(P_ROWT[r]); if (t < 0) continue;
                    const int q0 = __builtin_amdgcn_readfirstlane(P_TOKP[t * 2]), q1 = __builtin_amdgcn_readfirstlane(P_TOKP[t * 2 + 1]);
                    if ((q0 >= 128 * 256 ? q0 : q1) != r) continue;
                    const float h0 = P_TOKW[t * 2], h1 = P_TOKW[t * 2 + 1];
                    f32x4 v[4]; v2u ax[4], bx_[4]; const GAS v2u* hrr = (const GAS v2u*)(P_HB + (size_t)t * D) + lane;
#pragma unroll
                    for (int j = 0; j < 4; ++j) { const v2u hw = hrr[64 * j]; v[j].x = bflo(hw.x); v[j].y = bfhi(hw.x); v[j].z = bflo(hw.y); v[j].w = bfhi(hw.y); ax[j] = (v2u){0u, 0u}; bx_[j] = (v2u){0u, 0u}; }
                    COMBINE_FIN(t, v, ax, bx_, false, q0, q1, h0, h1);
                }
            }
#undef COMBINE_FIN
        }
        if (lp == 0) SEAM(pb + 14);
    }
#undef IN
#undef SEAM
}

#ifndef MK_PER_PHASE
#define MK_PER_PHASE 0
#endif
extern "C" void kernel_launch(void* const* d_in, const int* in_sizes, int n_in, void* d_out, int out_size, void* d_ws, size_t ws_size, hipStream_t stream) {
    static int grid = 0;
    if (grid == 0) {
        if (n_in != 33 || out_size != M * D || ws_size < WS_END) { fprintf(stderr, "kernel_launch: unexpected shapes (n_in %d, out %d, ws %zu, need %zu)\n", n_in, out_size, ws_size, (size_t)WS_END); grid = -1; return; }
        int dev = 0, cus = 0, per_cu = 0;
        if (hipGetDevice(&dev) != hipSuccess || hipDeviceGetAttribute(&cus, hipDeviceAttributeMultiprocessorCount, dev) != hipSuccess) { grid = -1; return; }
        if (hipFuncSetAttribute((const void*)trunk_fwd, hipFuncAttributeMaxDynamicSharedMemorySize, LDS_BYTES) != hipSuccess) { fprintf(stderr, "kernel_launch: hipFuncSetAttribute failed\n"); grid = -1; return; }
        if (hipOccupancyMaxActiveBlocksPerMultiprocessor(&per_cu, (const void*)trunk_fwd, NWAVES * 64, LDS_BYTES) != hipSuccess || per_cu < 1) fprintf(stderr, "kernel_launch: occupancy query reports %d\n", per_cu);
        (void)hipGetLastError();
        grid = cus;
    }
    if (grid < 0) return;
    if (hipMemsetAsync((char*)d_ws + WS_CTL, 0, CTL_ZERO_BYTES, stream) != hipSuccess) return;
    Args a{};
    for (int i = 0; i < 33; ++i) a.in[i] = (const float*)d_in[i];
    a.out = (float*)d_out; a.ws = (unsigned char*)d_ws;
#if MK_PER_PHASE
    for (int p = 0; p < NPH; ++p) { a.ph_lo = p; a.ph_hi = p + 1; hipLaunchKernelGGL(trunk_fwd, dim3(grid), dim3(NWAVES * 64), LDS_BYTES, stream, a); }
#elif defined(PROBE_PRE_LO)
    for (int rp = 0; rp < PROBE_PRE_N; ++rp) { a.ph_lo = PROBE_PRE_LO; a.ph_hi = PROBE_PRE_HI; hipLaunchKernelGGL(trunk_fwd, dim3(grid), dim3(NWAVES * 64), LDS_BYTES, stream, a);
        (void)hipMemsetAsync((char*)d_ws + WS_CTL, 0, CTL_ZERO_BYTES, stream); }
    a.ph_lo = 0; a.ph_hi = NPH;
    hipLaunchKernelGGL(trunk_fwd, dim3(grid), dim3(NWAVES * 64), LDS_BYTES, stream, a);
#elif defined(PROBE_POST_LO)
    a.ph_lo = 0; a.ph_hi = NPH;
    hipLaunchKernelGGL(trunk_fwd, dim3(grid), dim3(NWAVES * 64), LDS_BYTES, stream, a);
    for (int rp = 0; rp < PROBE_POST_N; ++rp) { (void)hipMemsetAsync((char*)d_ws + WS_CTL, 0, CTL_ZERO_BYTES, stream);
        a.ph_lo = PROBE_POST_LO; a.ph_hi = PROBE_POST_HI; hipLaunchKernelGGL(trunk_fwd, dim3(grid), dim3(NWAVES * 64), LDS_BYTES, stream, a); }
#else
    a.ph_lo = 0; a.ph_hi = NPH;
    hipLaunchKernelGGL(trunk_fwd, dim3(grid), dim3(NWAVES * 64), LDS_BYTES, stream, a);
#endif
}
```

```cpp
#include <hip/hip_runtime.h>
#include <cstdio>
#include <cstdint>

namespace pg8 {
#define PG8_LAS __attribute__((address_space(3)))
typedef unsigned short bf16_t;
typedef short bf16x8 __attribute__((ext_vector_type(8)));
typedef float f32x4 __attribute__((ext_vector_type(4)));
typedef float f32x2 __attribute__((ext_vector_type(2)));
typedef unsigned u32x4 __attribute__((ext_vector_type(4)));
typedef unsigned u32x2 __attribute__((ext_vector_type(2)));
constexpr int BM = 256, BK = 64, HALF = 128, HTB = HALF * BK * 2  , STAGE_BYTES = 8 * HTB, NXCD = 8, WGM = 8;

__host__ __device__ __forceinline__ int lds_byte(int r, int c) { const int st = (r >> 4) * 2 + (c >> 5), rr = r & 15, cc = c & 31, ob = rr * 64 + cc * 2; return st * 1024 + (ob ^ (((ob >> 9) & 1) << 5)); }
__host__ __device__ __forceinline__ void stage_rc(int b, int& R, int& C) { const int st = b / 1024, sb = b % 1024, swz = sb ^ (((sb >> 9) & 1) << 5); R = (st >> 1) * 16 + swz / 64; C = (st & 1) * 32 + (swz % 64) / 2; }
__host__ __device__ __forceinline__ int perm32(int rho) { const int n = rho >> 4, i = rho & 15; return 8 * (i >> 2) + 4 * n + (i & 3); }

typedef int i32x4 __attribute__((ext_vector_type(4)));
typedef int i32x8 __attribute__((ext_vector_type(8)));
__device__ __forceinline__ i32x8 cat8(const bf16x8 a, const bf16x8 b) { return __builtin_shufflevector(__builtin_bit_cast(i32x4, a), __builtin_bit_cast(i32x4, b), 0, 1, 2, 3, 4, 5, 6, 7); }
__device__ __forceinline__ unsigned pk4_fp8(float a, float b, float c, float d) {
    a = __builtin_fminf(__builtin_fmaxf(a, -448.f), 448.f); b = __builtin_fminf(__builtin_fmaxf(b, -448.f), 448.f); c = __builtin_fminf(__builtin_fmaxf(c, -448.f), 448.f); d = __builtin_fminf(__builtin_fmaxf(d, -448.f), 448.f);
    int p = __builtin_amdgcn_cvt_pk_fp8_f32(a, b, 0, false); p = __builtin_amdgcn_cvt_pk_fp8_f32(c, d, p, true); return (unsigned)p;
}
struct Unit { int pm, pn, idx; };

struct Order {
    int nM, nN, nwg, G, c;
    __device__ __forceinline__ void init(int nM_, int nN_, int G_, int c_) { nM = nM_; nN = nN_; nwg = nM * nN; G = G_; c = c_; }
    __device__ __forceinline__ bool next(int i, Unit& u) const {
        const long L = (long)i * G + c; if (L >= nwg) return false;
        int wgid = (int)L; { const int q = nwg / NXCD, r = nwg % NXCD, xcd = wgid % NXCD, off = wgid / NXCD; wgid = (xcd < r ? xcd * (q + 1) : r * (q + 1) + (xcd - r) * q) + off; }
        const int nig = WGM * nN, gid = wgid / nig, fm = gid * WGM, gsz = (nM - fm) < WGM ? (nM - fm) : WGM;
        u.pm = fm + ((wgid % nig) % gsz); u.pn = (wgid % nig) / gsz; u.idx = i; return true;
    }
    __device__ __forceinline__ void a_ready(const Unit&) const {}
    __device__ __forceinline__ void done(const Unit&) const {}
};

struct GDs {
    const bf16_t* A; const bf16_t* Bt; int lda, ldb, K, gshift; size_t gstride;
    __device__ __forceinline__ const char* a_ptr(const Unit& u) const { return (const char*)(A + (size_t)u.pm * BM * lda); }
    __device__ __forceinline__ const char* b_ptr(const Unit& u) const { return (const char*)(Bt + (size_t)(u.pm >> gshift) * gstride + (size_t)u.pn * BM * ldb); }
};
struct GDh {
    const bf16_t* A; const bf16_t* Bt; int lda, ldb, K, gshift; size_t gstride;
    __device__ __forceinline__ const char* a_ptr(const Unit& u) const { return (const char*)(A + (size_t)u.pm * BM * lda); }
    __device__ __forceinline__ const char* b_ptr(const Unit& u) const { return (const char*)(Bt + (size_t)(u.pm >> gshift) * gstride + (size_t)u.pn * HALF * ldb); }
};
struct GDt {
    const bf16_t* A; const bf16_t* Bt; int lda, ldb, K; size_t gstride; const PG8_LAS int* tab;
    __device__ __forceinline__ const char* a_ptr(const Unit& u) const { return (const char*)(A + (size_t)u.pm * BM * lda); }
    __device__ __forceinline__ const char* b_ptr(const Unit& u) const { const int grp = __builtin_amdgcn_readfirstlane(tab[u.pm]); return (const char*)(Bt + (size_t)grp * gstride + (size_t)u.pn * BM * ldb); }
};

struct GDk {
    const bf16_t* A; const bf16_t* Bt; int lda, ldb, K; size_t gstride; const PG8_LAS int* tab; int pm0, ksl;
    __device__ __forceinline__ const char* a_ptr(const Unit& u) const { return (const char*)(A + (size_t)(pm0 + u.pm) * BM * lda + (size_t)(u.pn >> 2) * ksl); }
    __device__ __forceinline__ const char* b_ptr(const Unit& u) const { const int grp = __builtin_amdgcn_readfirstlane(tab[pm0 + u.pm]); return (const char*)(Bt + (size_t)grp * gstride + (size_t)(u.pn & 3) * BM * ldb + (size_t)(u.pn >> 2) * ksl); }
};

__device__ __forceinline__ unsigned cvt_pk_bf16(float lo, float hi) { unsigned r; asm volatile("v_cvt_pk_bf16_f32 %0, %1, %2" : "=v"(r) : "v"(lo), "v"(hi)); return r; }
__device__ __forceinline__ float bf_lo(unsigned w) { return __uint_as_float(w << 16); }
__device__ __forceinline__ float bf_hi(unsigned w) { return __uint_as_float(w & 0xffff0000u); }
__device__ __forceinline__ float sigmoid_f(float x) { return __builtin_amdgcn_rcpf(1.0f + __expf(-x)); }
__device__ __forceinline__ float silu_f(float x) { return x * sigmoid_f(x); }
__device__ __forceinline__ float gelu_f(float x) { const float z2 = 1.5957691216057308f * (x + 0.044715f * x * x * x); return x * sigmoid_f(z2); }

constexpr float RMS_EPS_F = 1e-5f;
__device__ __forceinline__ float row_rstd(const float* ssq, int row, int fq) {
    const f32x4 p = *(const f32x4*)(ssq + (size_t)row * 16 + 4 * fq);
    float s = (p[0] + p[1]) + (p[2] + p[3]);
    s += __shfl_xor(s, 16); s += __shfl_xor(s, 32);
    return 1.0f / sqrtf(s * (1.0f / 1024.0f) + RMS_EPS_F);
}
__device__ __forceinline__ void rows_rstd(const float* ssq, int row0, int fq, float (&rs)[2][4]) {
    f32x4 p[2][4];
#pragma unroll
    for (int ai = 0; ai < 2; ++ai)
#pragma unroll
        for (int m = 0; m < 4; ++m) p[ai][m] = *(const f32x4*)(ssq + (size_t)(row0 + ai * HALF + m * 16) * 16 + 4 * fq);
#pragma unroll
    for (int ai = 0; ai < 2; ++ai)
#pragma unroll
        for (int m = 0; m < 4; ++m) { float s = (p[ai][m][0] + p[ai][m][1]) + (p[ai][m][2] + p[ai][m][3]); s += __shfl_xor(s, 16); s += __shfl_xor(s, 32); rs[ai][m] = 1.0f / sqrtf(s * (1.0f / 1024.0f) + RMS_EPS_F); }
}
__device__ __forceinline__ void rows_rstd_lds(const PG8_LAS float* t, float (&rs)[2][4]) {
#pragma unroll
    for (int ai = 0; ai < 2; ++ai)
#pragma unroll
        for (int m = 0; m < 4; ++m) rs[ai][m] = t[ai * HALF + m * 16];
}
__device__ __forceinline__ u32x4 pack8(const f32x4& a, const f32x4& b) { u32x4 w; w.x = cvt_pk_bf16(a[0], a[1]); w.y = cvt_pk_bf16(a[2], a[3]); w.z = cvt_pk_bf16(b[0], b[1]); w.w = cvt_pk_bf16(b[2], b[3]); return w; }

struct EpiScaleBf16 {
    static constexpr bool PERM = true, AFTER_DRAIN = false;
    bf16_t* O; int ldc; const PG8_LAS float* rst;
    __device__ __forceinline__ void operator()(const f32x4 (&acc)[2][2][4][2], const Unit& u, int wr, int wc, int fr, int fq) const {
        const int row0 = u.pm * BM + wr * 64 + fr, col0 = u.pn * BM + wc * 32 + 8 * fq;
        float rsv[2][4]; rows_rstd_lds(rst + u.idx * 256 + wr * 64 + fr, rsv);
#pragma unroll
        for (int ai = 0; ai < 2; ++ai)
#pragma unroll
            for (int m = 0; m < 4; ++m) { const int row = row0 + ai * HALF + m * 16; const float rs = rsv[ai][m]; bf16_t* rowp = O + (size_t)row * ldc + col0;
#pragma unroll
                for (int bj = 0; bj < 2; ++bj) *(u32x4*)(rowp + bj * HALF) = pack8(acc[ai][bj][m][0] * rs, acc[ai][bj][m][1] * rs); }
    }
};
template <bool SCALED> struct EpiResid {
    static constexpr bool PERM = false, AFTER_DRAIN = false;
    const float* resid; float* H; bf16_t* HB; float* ssq; float sc; unsigned char* H8;
    __device__ __forceinline__ void operator()(const f32x4 (&acc)[2][2][4][2], const Unit& u, int wr, int wc, int fr, int fq) const {
        const int row0 = u.pm * BM + wr * 64 + fr, col0 = u.pn * BM + wc * 32 + 4 * fq;
#pragma unroll
        for (int ai = 0; ai < 2; ++ai)
#pragma unroll
            for (int m = 0; m < 4; ++m) { const int row = row0 + ai * HALF + m * 16; const size_t off = (size_t)row * 1024 + col0; float q = 0.f;
#pragma unroll
                for (int bj = 0; bj < 2; ++bj)
#pragma unroll
                    for (int n = 0; n < 2; ++n) { const f32x4 bs = *(const f32x4*)(resid + off + bj * HALF + n * 16); f32x4 o; if (SCALED) { const f32x4 a4 = acc[ai][bj][m][n]; o[0] = __builtin_fmaf(a4[0], sc, bs[0]); o[1] = __builtin_fmaf(a4[1], sc, bs[1]); o[2] = __builtin_fmaf(a4[2], sc, bs[2]); o[3] = __builtin_fmaf(a4[3], sc, bs[3]); } else o = bs + acc[ai][bj][m][n];
                        *(f32x4*)(H + off + bj * HALF + n * 16) = o;
                        if (HB) { u32x2 w; w.x = cvt_pk_bf16(o[0], o[1]); w.y = cvt_pk_bf16(o[2], o[3]); *(u32x2*)(HB + off + bj * HALF + n * 16) = w; q += (o[0] * o[0] + o[1] * o[1]) + (o[2] * o[2] + o[3] * o[3]); }
                        if (H8) *(unsigned*)(H8 + off + bj * HALF + n * 16) = pk4_fp8(o[0], o[1], o[2], o[3]); }
                if (HB) { q += __shfl_xor(q, 16); q += __shfl_xor(q, 32); if (fq == 0) ssq[(size_t)row * 16 + u.pn * 4 + wc] = q; }
                asm volatile("" ::: "memory"); }
    }
};
template <bool SCALED> struct EpiResidB {
    static constexpr bool PERM = true, AFTER_DRAIN = false;
    bf16_t* HB; float* ssq; float sc; unsigned char* H8;
    __device__ __forceinline__ void operator()(const f32x4 (&acc)[2][2][4][2], const Unit& u, int wr, int wc, int fr, int fq) const {
        const int row0 = u.pm * BM + wr * 64 + fr, col0 = u.pn * BM + wc * 32 + 8 * fq;
        u32x4 rs[2][2][2];
#define PG8_RLOAD(P, B) do { _Pragma("unroll") for (int g_ = 0; g_ < 2; ++g_) { const int gi_ = 2 * (P) + g_; \
            _Pragma("unroll") for (int bj = 0; bj < 2; ++bj) rs[B][g_][bj] = *(const u32x4*)(HB + (size_t)(row0 + (gi_ >> 2) * HALF + (gi_ & 3) * 16) * 1024 + col0 + bj * HALF); } } while (0)
        PG8_RLOAD(0, 0);
#pragma unroll
        for (int p = 0; p < 4; ++p) {
            if (p < 3) PG8_RLOAD(p + 1, (p + 1) & 1);
            asm volatile("" ::: "memory");
#pragma unroll
            for (int g = 0; g < 2; ++g) { const int gi = 2 * p + g, ai = gi >> 2, m = gi & 3; const int row = row0 + ai * HALF + m * 16; const size_t off = (size_t)row * 1024 + col0; float q = 0.f;
#pragma unroll
                for (int bj = 0; bj < 2; ++bj) { const u32x4 r = rs[p & 1][g][bj]; const f32x4 a0 = acc[ai][bj][m][0], a1 = acc[ai][bj][m][1]; f32x4 o0, o1;
                    if (SCALED) { o0[0] = __builtin_fmaf(a0[0], sc, bf_lo(r.x)); o0[1] = __builtin_fmaf(a0[1], sc, bf_hi(r.x)); o0[2] = __builtin_fmaf(a0[2], sc, bf_lo(r.y)); o0[3] = __builtin_fmaf(a0[3], sc, bf_hi(r.y));
                        o1[0] = __builtin_fmaf(a1[0], sc, bf_lo(r.z)); o1[1] = __builtin_fmaf(a1[1], sc, bf_hi(r.z)); o1[2] = __builtin_fmaf(a1[2], sc, bf_lo(r.w)); o1[3] = __builtin_fmaf(a1[3], sc, bf_hi(r.w)); }
                    else { o0[0] = a0[0] + bf_lo(r.x); o0[1] = a0[1] + bf_hi(r.x); o0[2] = a0[2] + bf_lo(r.y); o0[3] = a0[3] + bf_hi(r.y); o1[0] = a1[0] + bf_lo(r.z); o1[1] = a1[1] + bf_hi(r.z); o1[2] = a1[2] + bf_lo(r.w); o1[3] = a1[3] + bf_hi(r.w); }
                    *(u32x4*)(HB + off + bj * HALF) = pack8(o0, o1);
                    q += ((o0[0] * o0[0] + o0[1] * o0[1]) + (o0[2] * o0[2] + o0[3] * o0[3])) + ((o1[0] * o1[0] + o1[1] * o1[1]) + (o1[2] * o1[2] + o1[3] * o1[3]));
                    if (H8) { u32x2 w; w.x = pk4_fp8(o0[0], o0[1], o0[2], o0[3]); w.y = pk4_fp8(o1[0], o1[1], o1[2], o1[3]); *(u32x2*)(H8 + off + bj * HALF) = w; } }
                q += __shfl_xor(q, 16); q += __shfl_xor(q, 32); if (fq == 0) ssq[(size_t)row * 16 + u.pn * 4 + wc] = q; }
            asm volatile("" ::: "memory");
        }
#undef PG8_RLOAD
    }
};
__device__ __forceinline__ f32x2 swiglu2(const f32x2 g, const f32x2 u, const float c1, const float c2) {
    const f32x2 t = g * c1; f32x2 e; e.x = __builtin_amdgcn_exp2f(t.x); e.y = __builtin_amdgcn_exp2f(t.y);
    const f32x2 d = e + 1.0f; f32x2 r; r.x = __builtin_amdgcn_rcpf(d.x); r.y = __builtin_amdgcn_rcpf(d.y);
    return ((g * u) * r) * c2;
}
template <bool MOE> struct EpiSwiGLU {
    static constexpr bool PERM = true, AFTER_DRAIN = false;
    bf16_t* U; int ldc; const PG8_LAS float* rst;
    __device__ __forceinline__ void operator()(const f32x4 (&acc)[2][2][4][2], const Unit& u, int wr, int wc, int fr, int fq) const {
        const int row0 = u.pm * BM + wr * 64 + fr, col0 = u.pn * HALF + wc * 32 + 8 * fq;
        float rsv[2][4];
        if (!MOE) rows_rstd_lds(rst + u.idx * 256 + wr * 64 + fr, rsv);
#pragma unroll
        for (int ai = 0; ai < 2; ++ai)
#pragma unroll
            for (int m = 0; m < 4; ++m) { const int row = row0 + ai * HALF + m * 16;
                const float rs = MOE ? 1.0f : rsv[ai][m], c1 = rs * -1.4426950408889634f, c2 = rs * rs;
                const f32x4 g0 = acc[ai][0][m][0], g1 = acc[ai][0][m][1], u0 = acc[ai][1][m][0], u1 = acc[ai][1][m][1];
                const f32x2 a = swiglu2((f32x2){g0[0], g0[1]}, (f32x2){u0[0], u0[1]}, c1, c2), b = swiglu2((f32x2){g0[2], g0[3]}, (f32x2){u0[2], u0[3]}, c1, c2);
                const f32x2 c = swiglu2((f32x2){g1[0], g1[1]}, (f32x2){u1[0], u1[1]}, c1, c2), d = swiglu2((f32x2){g1[2], g1[3]}, (f32x2){u1[2], u1[3]}, c1, c2);
                u32x4 w; w.x = cvt_pk_bf16(a.x, a.y); w.y = cvt_pk_bf16(b.x, b.y); w.z = cvt_pk_bf16(c.x, c.y); w.w = cvt_pk_bf16(d.x, d.y);
                *(u32x4*)(U + (size_t)row * ldc + col0) = w; }
    }
};
__device__ __forceinline__ unsigned pk4_fp8v(const f32x2 a, const f32x2 b) {
    const float a0 = __builtin_amdgcn_fmed3f(a.x, -448.f, 448.f), a1 = __builtin_amdgcn_fmed3f(a.y, -448.f, 448.f), b0 = __builtin_amdgcn_fmed3f(b.x, -448.f, 448.f), b1 = __builtin_amdgcn_fmed3f(b.y, -448.f, 448.f);
    int p = __builtin_amdgcn_cvt_pk_fp8_f32(a0, a1, 0, false); p = __builtin_amdgcn_cvt_pk_fp8_f32(b0, b1, p, true); return (unsigned)p;
}
template <bool RS> struct EpiSwiGLUF8 {
    static constexpr bool PERM = true, AFTER_DRAIN = false;
    unsigned char* U; int ldc; float isc, osc; const PG8_LAS float* rst;
    __device__ __forceinline__ void operator()(const f32x4 (&acc)[2][2][4][2], const Unit& u, int wr, int wc, int fr, int fq) const {
        const int row0 = u.pm * BM + wr * 64 + fr, col0 = u.pn * HALF + wc * 32 + 8 * fq;
        float rsv[2][4];
        if (RS) rows_rstd_lds(rst + u.idx * 256 + wr * 64 + fr, rsv);
#pragma unroll
        for (int ai = 0; ai < 2; ++ai)
#pragma unroll
            for (int m = 0; m < 4; ++m) { const int row = row0 + ai * HALF + m * 16; const float is = RS ? isc * rsv[ai][m] : isc, c1 = is * -1.4426950408889634f, c2 = is * is * osc;
                const f32x4 g0 = acc[ai][0][m][0], g1 = acc[ai][0][m][1], u0 = acc[ai][1][m][0], u1 = acc[ai][1][m][1];
                const f32x2 a = swiglu2((f32x2){g0[0], g0[1]}, (f32x2){u0[0], u0[1]}, c1, c2), b = swiglu2((f32x2){g0[2], g0[3]}, (f32x2){u0[2], u0[3]}, c1, c2);
                const f32x2 c = swiglu2((f32x2){g1[0], g1[1]}, (f32x2){u1[0], u1[1]}, c1, c2), d = swiglu2((f32x2){g1[2], g1[3]}, (f32x2){u1[2], u1[3]}, c1, c2);
                u32x2 w; w.x = pk4_fp8v(a, b); w.y = pk4_fp8v(c, d);
                *(u32x2*)(U + (size_t)row * ldc + col0) = w; }
    }
};
struct EpiOddIn {
    static constexpr bool PERM = true, AFTER_DRAIN = false;
    bf16_t* AG; bf16_t* ZUV; const PG8_LAS float* rst;
    __device__ __forceinline__ void operator()(const f32x4 (&acc)[2][2][4][2], const Unit& u, int wr, int wc, int fr, int fq) const {
        const int row0 = u.pm * BM + wr * 64 + fr;
        float rsv[2][4]; rows_rstd_lds(rst + u.idx * 256 + wr * 64 + fr, rsv);
#pragma unroll
        for (int ai = 0; ai < 2; ++ai)
#pragma unroll
            for (int m = 0; m < 4; ++m) { const int row = row0 + ai * HALF + m * 16; const float rs = rsv[ai][m];
#pragma unroll
                for (int bj = 0; bj < 2; ++bj) { f32x4 v0 = acc[ai][bj][m][0] * rs, v1 = acc[ai][bj][m][1] * rs;
                    if (u.pn < 2) { const int cc = u.pn * BM + bj * HALF + wc * 32 + 8 * fq, g = cc >> 4, h0 = cc & 15;
                        *(u32x4*)(AG + ((size_t)g * 512 + (row >> 5)) * 640 + 128 + (row & 31) * 16 + h0) = pack8(v0, v1); }
                    else { const int cc = (u.pn - 2) * BM + bj * HALF + wc * 32 + 8 * fq;
#pragma unroll
                        for (int j = 0; j < 4; ++j) { v0[j] = gelu_f(v0[j]); v1[j] = gelu_f(v1[j]); }
                        *(u32x4*)(ZUV + (size_t)row * 1024 + cc) = pack8(v0, v1); } } }
    }
};
struct EpiS5Scan {
    static constexpr bool PERM = false, AFTER_DRAIN = true;
    bf16_t* AG; const float* AT;
    __device__ __forceinline__ void operator()(const f32x4 (&)[2][2][4][2], const Unit&, int, int, int, int) const {}
    __device__ __forceinline__ void fused(const f32x4 (&acc)[2][2][4][2], const Unit& u, int wr, int wc, int fr, int fq, PG8_LAS unsigned char* lds, int wid, int lane) const {
#pragma unroll
        for (int ai = 0; ai < 2; ++ai)
#pragma unroll
            for (int m = 0; m < 4; ++m) { const int r = ai * HALF + wr * 64 + m * 16 + fr;
#pragma unroll
                for (int n = 0; n < 2; ++n) { const int gq = (wc * 32 + n * 16 + 4 * fq) >> 2; *(PG8_LAS f32x4*)(lds + r * 512 + ((gq ^ (r & 15)) << 4)) = acc[ai][0][m][n]; } }
        asm volatile("s_waitcnt lgkmcnt(0)" ::: "memory"); __builtin_amdgcn_s_barrier(); asm volatile("" ::: "memory");
        if (wid == 0) { const int g = u.pm >> 1, p = lane;
            const float ar = AT[(g * 64 + p) * 2], ai_ = AT[(g * 64 + p) * 2 + 1]; float hr = 0.f, hi = 0.f;
            bf16_t* ap = AG + (size_t)u.pm * BM * 640 + p;
            const int g0 = p >> 2, g1 = (64 + p) >> 2, sub = (p & 3) << 2;
            for (int c0 = 0; c0 < 256; c0 += 8) { float sr[8], si[8];
#pragma unroll
                for (int e = 0; e < 8; ++e) { const int c = c0 + e; sr[e] = *(const PG8_LAS float*)(lds + c * 512 + ((g0 ^ (c & 15)) << 4) + sub); si[e] = *(const PG8_LAS float*)(lds + c * 512 + ((g1 ^ (c & 15)) << 4) + sub); }
#pragma unroll
                for (int e = 0; e < 8; ++e) { const unsigned w = cvt_pk_bf16(hr, hi); ap[(size_t)(c0 + e) * 640] = (bf16_t)(w & 0xffffu); ap[(size_t)(c0 + e) * 640 + 64] = (bf16_t)(w >> 16);
                    const float nr = ar * hr - ai_ * hi + sr[e], ni = ar * hi + ai_ * hr + si[e]; hr = nr; hi = ni; } }
        }
    }
};
struct EpiS5Y {
    static constexpr bool PERM = true, AFTER_DRAIN = false;
    const bf16_t* AG; const float* dskip; bf16_t* GY;
    __device__ __forceinline__ void operator()(const f32x4 (&acc)[2][2][4][2], const Unit& u, int wr, int wc, int fr, int fq) const {
        const int row0 = u.pm * BM + wr * 64 + fr, g = u.pm >> 1;
        const int n0 = u.pn * HALF + wc * 32 + 8 * fq, jl = n0 >> 4, h0 = n0 & 15;
        const f32x4 d0 = *(const f32x4*)(dskip + g * 16 + h0), d1 = *(const f32x4*)(dskip + g * 16 + h0 + 4);
#pragma unroll
        for (int ai = 0; ai < 2; ++ai)
#pragma unroll
            for (int m = 0; m < 4; ++m) { const int row = row0 + ai * HALF + m * 16;
                const u32x4 uu = *(const u32x4*)(AG + (size_t)row * 640 + 128 + n0);
                f32x4 y0 = acc[ai][0][m][0], y1 = acc[ai][0][m][1];
                y0[0] += d0[0] * bf_lo(uu.x); y0[1] += d0[1] * bf_hi(uu.x); y0[2] += d0[2] * bf_lo(uu.y); y0[3] += d0[3] * bf_hi(uu.y);
                y1[0] += d1[0] * bf_lo(uu.z); y1[1] += d1[1] * bf_hi(uu.z); y1[2] += d1[2] * bf_lo(uu.w); y1[3] += d1[3] * bf_hi(uu.w);
#pragma unroll
                for (int j = 0; j < 4; ++j) { y0[j] = gelu_f(y0[j]); y1[j] = gelu_f(y1[j]); }
                const int chunk = row & 511, token = chunk * 32 + jl;
                *(u32x4*)(GY + (size_t)token * 512 + g * 16 + h0) = pack8(y0, y1); }
    }
};
struct EpiGLU {
    static constexpr bool PERM = true, AFTER_DRAIN = false;
    const bf16_t* GY; const float* bias; bf16_t* MIX;
    __device__ __forceinline__ void operator()(const f32x4 (&acc)[2][2][4][2], const Unit& u, int wr, int wc, int fr, int fq) const {
        const int row0 = u.pm * BM + wr * 64 + fr, c0 = u.pn * HALF + wc * 32 + 8 * fq;
        const f32x4 b0 = *(const f32x4*)(bias + c0), b1 = *(const f32x4*)(bias + c0 + 4);
#pragma unroll
        for (int ai = 0; ai < 2; ++ai)
#pragma unroll
            for (int m = 0; m < 4; ++m) { const int row = row0 + ai * HALF + m * 16;
                const u32x4 gg = *(const u32x4*)(GY + (size_t)row * 512 + c0);
                const f32x4 a0 = acc[ai][0][m][0] + b0, a1 = acc[ai][0][m][1] + b1; f32x4 o0, o1;
                o0[0] = bf_lo(gg.x) * sigmoid_f(a0[0]); o0[1] = bf_hi(gg.x) * sigmoid_f(a0[1]); o0[2] = bf_lo(gg.y) * sigmoid_f(a0[2]); o0[3] = bf_hi(gg.y) * sigmoid_f(a0[3]);
                o1[0] = bf_lo(gg.z) * sigmoid_f(a1[0]); o1[1] = bf_hi(gg.z) * sigmoid_f(a1[1]); o1[2] = bf_lo(gg.w) * sigmoid_f(a1[2]); o1[3] = bf_hi(gg.w) * sigmoid_f(a1[3]);
                *(u32x4*)(MIX + (size_t)row * 1024 + c0) = pack8(o0, o1); }
    }
};
struct EpiBf16 {
    static constexpr bool PERM = true, AFTER_DRAIN = false;
    bf16_t* O; int ldc; float sc;
    __device__ __forceinline__ void operator()(const f32x4 (&acc)[2][2][4][2], const Unit& u, int wr, int wc, int fr, int fq) const {
        const int row0 = u.pm * BM + wr * 64 + fr, col0 = u.pn * BM + wc * 32 + 8 * fq;
#pragma unroll
        for (int ai = 0; ai < 2; ++ai)
#pragma unroll
            for (int m = 0; m < 4; ++m) { bf16_t* rowp = O + (size_t)(row0 + ai * HALF + m * 16) * ldc + col0;
#pragma unroll
                for (int bj = 0; bj < 2; ++bj) *(u32x4*)(rowp + bj * HALF) = pack8(acc[ai][bj][m][0] * sc, acc[ai][bj][m][1] * sc); }
    }
};

struct EpiPartF32 {
    static constexpr bool PERM = false, AFTER_DRAIN = false;
    float* P; float sc;
    __device__ __forceinline__ void operator()(const f32x4 (&acc)[2][2][4][2], const Unit& u, int wr, int wc, int fr, int fq) const {
        float* base = P + ((size_t)(u.pm * 7 + (u.pn >> 2)) * 256 + wr * 64 + fr) * 1024 + (u.pn & 3) * BM + wc * 32 + 4 * fq;
#pragma unroll
        for (int ai = 0; ai < 2; ++ai)
#pragma unroll
            for (int m = 0; m < 4; ++m) { float* rowp = base + (size_t)(ai * HALF + m * 16) * 1024;
#pragma unroll
                for (int bj = 0; bj < 2; ++bj)
#pragma unroll
                    for (int n = 0; n < 2; ++n) *(f32x4*)(rowp + bj * HALF + n * 16) = acc[ai][bj][m][n] * sc; }
    }
};

template <class Epi, class Sched, class GD, int MMODE = 0, bool ALIGN_EPI = true, bool SP2 = true>
__device__ __forceinline__ void gemm_phase(PG8_LAS unsigned char* lds, const GD& g, const Sched& S, const Epi& E, const int wid) {
    int lane_o; asm volatile("v_mbcnt_lo_u32_b32 %0, -1, 0\n\tv_mbcnt_hi_u32_b32 %0, -1, %0" : "=v"(lane_o));
    const int lane = lane_o, tid = wid * 64 + lane, wr = wid >> 2, wc = wid & 3, fr = lane & 15, fq = lane >> 4;
    const int K = g.K, nt = K / BK, lda = g.lda, ldb = g.ldb;
    unsigned voffA[2], voffB[2];
#pragma unroll
    for (int i = 0; i < 2; ++i) { int R, C; stage_rc(tid * 16 + i * 8192, R, C); const int Rb = Epi::PERM ? ((R & ~31) + perm32(R & 31)) : R;
        voffA[i] = (unsigned)(R * lda + C) * 2u; voffB[i] = (unsigned)(Rb * ldb + C) * 2u; }
    const size_t kstep = (size_t)(BK * 2);
    const size_t hstepA = (size_t)HALF * lda * 2, hstepB = (size_t)HALF * ldb * 2;
    const unsigned ldsw = (unsigned)wid * 1024u;
    const int aoff = lds_byte(wr * 64 + fr, fq * 8), boff = lds_byte(wc * 32 + fr, fq * 8);
#define PG8_SA(b, h) (((b) * 2 + (h)) * HTB)
#define PG8_SB(b, h) ((4 + (b) * 2 + (h)) * HTB)
#define PG8_STAGE(bufoff, gbase, voff) do { _Pragma("unroll") for (int _i = 0; _i < 2; ++_i) \
        __builtin_amdgcn_global_load_lds((const unsigned*)((const char*)(gbase) + (voff)[_i]), (PG8_LAS unsigned*)(lds + (bufoff) + ldsw + _i * 8192), 16, 0, 0); } while (0)
#define PG8_LDA(dst, b, h) do { if constexpr (MMODE == 0) { _Pragma("unroll") for (int m = 0; m < 4; ++m) _Pragma("unroll") for (int k = 0; k < 2; ++k) dst[m][k] = *(const PG8_LAS bf16x8*)(lds + PG8_SA(b, h) + aoff + m * 2048 + k * 1024); } \
        else { _Pragma("unroll") for (int m = 0; m < 4; ++m) dst##8[m] = cat8(*(const PG8_LAS bf16x8*)(lds + PG8_SA(b, h) + aoff + m * 2048), *(const PG8_LAS bf16x8*)(lds + PG8_SA(b, h) + aoff + m * 2048 + 1024)); } } while (0)
#define PG8_LDB(dst, b, h) do { if constexpr (MMODE == 0) { _Pragma("unroll") for (int n = 0; n < 2; ++n) _Pragma("unroll") for (int k = 0; k < 2; ++k) dst[n][k] = *(const PG8_LAS bf16x8*)(lds + PG8_SB(b, h) + boff + n * 2048 + k * 1024); } \
        else { _Pragma("unroll") for (int n = 0; n < 2; ++n) dst##8[n] = cat8(*(const PG8_LAS bf16x8*)(lds + PG8_SB(b, h) + boff + n * 2048), *(const PG8_LAS bf16x8*)(lds + PG8_SB(b, h) + boff + n * 2048 + 1024)); } } while (0)
#define PG8_MMA(ai, bj, At, Bt) do { __builtin_amdgcn_s_setprio(1); \
        if constexpr (MMODE == 0) { _Pragma("unroll") for (int m = 0; m < 4; ++m) _Pragma("unroll") for (int n = 0; n < 2; ++n) _Pragma("unroll") for (int k = 0; k < 2; ++k) \
            acc[ai][bj][m][n] = __builtin_amdgcn_mfma_f32_16x16x32_bf16(Bt[n][k], At[m][k], acc[ai][bj][m][n], 0, 0, 0); } \
        else { asm volatile("s_nop 1"); _Pragma("unroll") for (int m = 0; m < 4; ++m) _Pragma("unroll") for (int n = 0; n < 2; ++n) \
            asm volatile("v_mfma_scale_f32_16x16x128_f8f6f4 %0, %1, %2, %0, %3, %3 op_sel_hi:[0,0,0]" : "+v"(acc[ai][bj][m][n]) : "v"(Bt##8[n]), "v"(At##8[m]), "v"(f8one)); } \
        __builtin_amdgcn_s_setprio(0); } while (0)
#define PG8_WAIT_V(n) asm volatile("s_waitcnt vmcnt(" #n ")" ::: "memory")
#define PG8_WAIT_L(n) asm volatile("s_waitcnt lgkmcnt(" #n ")" ::: "memory")
#define PG8_BAR __builtin_amdgcn_s_barrier()
#define PG8_SCHED __builtin_amdgcn_sched_barrier(0)
    Unit cur, nxt; int ui = 0;
    if (!S.next(0, cur)) return;
    f32x4 acc[2][2][4][2];
#pragma unroll
    for (int a = 0; a < 2; ++a)
#pragma unroll
        for (int b = 0; b < 2; ++b)
#pragma unroll
            for (int m = 0; m < 4; ++m)
#pragma unroll
                for (int n = 0; n < 2; ++n) acc[a][b][m][n] = (f32x4){0.f, 0.f, 0.f, 0.f};
    const int f8one = 0x7f7f7f7f;
    bf16x8 At[4][2], B0[2][2], B1[2][2]; i32x8 At8[4], B08[2], B18[2];
    const char* cA = g.a_ptr(cur); const char* cB = g.b_ptr(cur);
    S.a_ready(cur);
    if constexpr (SP2) {
        PG8_STAGE(PG8_SB(0, 0), cB, voffB); PG8_STAGE(PG8_SB(0, 1), cB + hstepB, voffB); PG8_STAGE(PG8_SA(0, 0), cA, voffA); PG8_STAGE(PG8_SA(0, 1), cA + hstepA, voffA);
        if (wr == 1) PG8_BAR;
        PG8_WAIT_V(2); PG8_BAR;
        PG8_STAGE(PG8_SB(1, 0), cB + kstep, voffB); PG8_STAGE(PG8_SA(1, 0), cA + kstep, voffA); PG8_STAGE(PG8_SB(1, 1), cB + hstepB + kstep, voffB);
        PG8_WAIT_V(6); PG8_BAR;
    } else {
        PG8_STAGE(PG8_SB(0, 0), cB, voffB); PG8_STAGE(PG8_SA(0, 0), cA, voffA); PG8_STAGE(PG8_SB(0, 1), cB + hstepB, voffB); PG8_STAGE(PG8_SA(0, 1), cA + hstepA, voffA);
        if (wr == 1) PG8_BAR;
        PG8_WAIT_V(4); PG8_BAR;
        PG8_STAGE(PG8_SB(1, 0), cB + kstep, voffB); PG8_STAGE(PG8_SA(1, 0), cA + kstep, voffA); PG8_STAGE(PG8_SB(1, 1), cB + hstepB + kstep, voffB);
        PG8_WAIT_V(6); PG8_BAR;
    }
    for (;;) {
        const bool has_next = S.next(ui + 1, nxt);
        const char* nA = has_next ? g.a_ptr(nxt) : cA; const char* nB = has_next ? g.b_ptr(nxt) : cB;
        for (int t = 0; t < nt; t += 2) {
            const bool last = (t == nt - 2);
            const char* a1 = cA + (size_t)(t + 1) * kstep;
            const char* a2 = last ? nA : cA + (size_t)(t + 2) * kstep; const char* b2 = last ? nB : cB + (size_t)(t + 2) * kstep;
            const char* a3 = a2 + kstep; const char* b3 = b2 + kstep;
            if (last && has_next) S.a_ready(nxt);
            if constexpr (SP2) {
            PG8_LDB(B0, 0, 0); PG8_LDB(B1, 0, 1); PG8_SCHED; PG8_LDA(At, 0, 0); PG8_STAGE(PG8_SA(1, 1), a1 + hstepA, voffA);
            PG8_WAIT_V(8); PG8_WAIT_L(0); PG8_BAR; PG8_MMA(0, 0, At, B0); PG8_MMA(0, 1, At, B1); PG8_BAR; PG8_SCHED;
            PG8_LDA(At, 0, 1); PG8_STAGE(PG8_SB(0, 0), b2, voffB); PG8_STAGE(PG8_SB(0, 1), b2 + hstepB, voffB); PG8_STAGE(PG8_SA(0, 0), a2, voffA);
            PG8_WAIT_V(8); PG8_WAIT_L(0); PG8_BAR; PG8_MMA(1, 0, At, B0); PG8_MMA(1, 1, At, B1); PG8_BAR; PG8_SCHED;
            PG8_LDB(B0, 1, 0); PG8_LDB(B1, 1, 1); PG8_SCHED; PG8_LDA(At, 1, 0); PG8_STAGE(PG8_SA(0, 1), a2 + hstepA, voffA);
            PG8_WAIT_V(8); PG8_WAIT_L(0); PG8_BAR; PG8_MMA(0, 0, At, B0); PG8_MMA(0, 1, At, B1); PG8_BAR; PG8_SCHED;
            PG8_LDA(At, 1, 1); PG8_STAGE(PG8_SB(1, 0), b3, voffB); PG8_STAGE(PG8_SB(1, 1), b3 + hstepB, voffB); PG8_STAGE(PG8_SA(1, 0), a3, voffA);
            PG8_WAIT_V(8); PG8_WAIT_L(0); PG8_BAR; PG8_MMA(1, 0, At, B0); PG8_MMA(1, 1, At, B1); PG8_BAR; PG8_SCHED;
            } else {
            PG8_LDB(B0, 0, 0); PG8_SCHED; PG8_LDA(At, 0, 0); PG8_STAGE(PG8_SA(1, 1), a1 + hstepA, voffA);
            PG8_WAIT_L(8); PG8_BAR; PG8_WAIT_L(0); PG8_MMA(0, 0, At, B0); PG8_BAR; PG8_SCHED;
            PG8_LDB(B1, 0, 1); PG8_STAGE(PG8_SB(0, 0), b2, voffB);
            PG8_BAR; PG8_WAIT_L(0); PG8_MMA(0, 1, At, B1); PG8_BAR;
            PG8_LDA(At, 0, 1); PG8_STAGE(PG8_SA(0, 0), a2, voffA);
            PG8_BAR; PG8_WAIT_L(0); PG8_MMA(1, 0, At, B0); PG8_BAR; PG8_SCHED;
            PG8_STAGE(PG8_SB(0, 1), b2 + hstepB, voffB);
            PG8_WAIT_V(6); PG8_BAR; PG8_MMA(1, 1, At, B1); PG8_BAR;
            PG8_LDB(B0, 1, 0); PG8_SCHED; PG8_LDA(At, 1, 0); PG8_STAGE(PG8_SA(0, 1), a2 + hstepA, voffA);
            PG8_WAIT_L(8); PG8_BAR; PG8_WAIT_L(0); PG8_MMA(0, 0, At, B0); PG8_BAR; PG8_SCHED;
            PG8_LDB(B1, 1, 1); PG8_STAGE(PG8_SB(1, 0), b3, voffB);
            PG8_BAR; PG8_WAIT_L(0); PG8_MMA(0, 1, At, B1); PG8_BAR;
            PG8_LDA(At, 1, 1); PG8_STAGE(PG8_SA(1, 0), a3, voffA);
            PG8_BAR; PG8_WAIT_L(0); PG8_MMA(1, 0, At, B0); PG8_BAR; PG8_SCHED;
            PG8_STAGE(PG8_SB(1, 1), b3 + hstepB, voffB);
            PG8_WAIT_V(6); PG8_BAR; PG8_MMA(1, 1, At, B1); PG8_BAR;
            }
        }
        if constexpr (MMODE == 1) asm volatile("s_nop 15\n\ts_nop 15" ::: "memory");
        if constexpr (ALIGN_EPI) { if (wr == 0) PG8_BAR; }
        if constexpr (!Epi::AFTER_DRAIN) { E(acc, cur, wr, wc, fr, fq); S.done(cur); }
        if (!has_next) break;
#pragma unroll
        for (int a = 0; a < 2; ++a)
#pragma unroll
            for (int b = 0; b < 2; ++b)
#pragma unroll
                for (int m = 0; m < 4; ++m)
#pragma unroll
                    for (int n = 0; n < 2; ++n) acc[a][b][m][n] = (f32x4){0.f, 0.f, 0.f, 0.f};
        cur = nxt; cA = nA; cB = nB; ++ui;
        if constexpr (ALIGN_EPI) { if (wr == 1) PG8_BAR; }
    }
    PG8_WAIT_V(0);
    if constexpr (!ALIGN_EPI) { if (wr == 0) PG8_BAR; }
    PG8_BAR;
    if constexpr (Epi::AFTER_DRAIN) { E.fused(acc, cur, wr, wc, fr, fq, lds, wid, lane); S.done(cur); }
#undef PG8_SA
#undef PG8_SB
#undef PG8_STAGE
#undef PG8_LDA
#undef PG8_LDB
#undef PG8_MMA
#undef PG8_WAIT_V
#undef PG8_WAIT_L
#undef PG8_BAR
#undef PG8_SCHED
}
}

constexpr int NWAVES = 8;
constexpr int D = 1024, SEQ = 8192, M = 16384;
constexpr int FFN = 2816, EXD = 3584, NEXP = 8;
constexpr int XS_ROWS = 2 * M + NEXP * 256;
constexpr int MAXPAN = XS_ROWS / 256;
constexpr int NPH = 31;

constexpr size_t MiB = 1u << 20;
constexpr size_t WS_CTL = 0, CTL_ZERO_BYTES = 1 * MiB;
constexpr size_t WS_SMALL = 1 * MiB;
constexpr size_t SM_AT = 0;
constexpr size_t SM_TOKE = 64 * 1024;
constexpr size_t SM_TOKW = SM_TOKE + 128 * 1024;
constexpr size_t SM_TOKR = SM_TOKW + 128 * 1024;
constexpr size_t SM_TOKP = SM_TOKR + 128 * 1024;
constexpr size_t SM_RSTD = SM_TOKP + 128 * 1024;
constexpr size_t SM_WGCNT = SM_RSTD + 64 * 1024;
constexpr size_t SM_ROWG = SM_WGCNT + 8 * 1024;
constexpr size_t SM_PANEL = SM_ROWG + 192 * 1024;
constexpr size_t SM_SSQ = 1 * MiB;
constexpr size_t WS_WEIN = 9 * MiB;
constexpr size_t EV_EIN = 0, EV_EOUT = 4 * MiB, EV_E13 = 6 * MiB, EV_E2 = 17 * MiB, EV_STRIDE = 23 * MiB;
constexpr size_t WS_WODD = WS_WEIN + 2 * EV_STRIDE;
constexpr size_t OD_OIN = 0, OD_GLU = 3 * MiB, OD_OOUT = 4 * MiB, OD_SGU = 6 * MiB, OD_WST = 7 * MiB, OD_MY = 15 * MiB, OD_M13 = 35 * MiB, OD_M2 = 147 * MiB, OD_STRIDE = 203 * MiB;
constexpr size_t WS_HB = WS_WODD + 2 * OD_STRIDE;
constexpr size_t WS_ARENA = WS_HB + 32 * MiB;
constexpr size_t AR_UM = 0;
constexpr size_t AR_Z = 0, AR_MIX = 64 * MiB, AR_UF = 96 * MiB;
constexpr size_t AR_AG = 0, AR_SST = 20 * MiB, AR_ZUV = 32 * MiB, AR_GY = 96 * MiB;
constexpr size_t AR_XS = 238 * MiB;
constexpr size_t WS_PART = WS_ARENA + 306 * MiB;
constexpr size_t WS_END = WS_PART + 56 * MiB;
static_assert((size_t)XS_ROWS * EXD * 2 <= 238 * MiB && (size_t)XS_ROWS * D * 2 <= 68 * MiB, "arena");
static_assert(SM_PANEL + 1024 <= SM_SSQ && SM_SSQ + (size_t)M * 16 * 4 <= 8 * MiB, "small tables");
constexpr int CW_TMO = 0;
constexpr int CW_BAR = 4096;
constexpr int CW_QUEUE = 64;

constexpr int RING_OFF = 0, RING_BYTES = 131072;
constexpr int LDSCTL_OFF = RING_BYTES, MISC_OFF = LDSCTL_OFF + 320;
constexpr int PTAB_OFF = LDSCTL_OFF + 1024;
constexpr int RST_OFF = LDSCTL_OFF + 2048;
constexpr int RST_UNITS = 6;
constexpr int LDS_BYTES = 147456;

#define GAS __attribute__((address_space(1)))
#define LAS __attribute__((address_space(3)))
typedef unsigned short bf16;
typedef unsigned v4u __attribute__((ext_vector_type(4)));
typedef unsigned v2u __attribute__((ext_vector_type(2)));
typedef float f32x4 __attribute__((ext_vector_type(4)));
typedef short bf16x8 __attribute__((ext_vector_type(8)));
#define RLX_AGENT __ATOMIC_RELAXED, __HIP_MEMORY_SCOPE_AGENT
#define LDS_WAIT() asm volatile("s_waitcnt lgkmcnt(0)" ::: "memory")
#define VM_WAIT() asm volatile("s_waitcnt vmcnt(0)" ::: "memory")
__device__ __forceinline__ unsigned f2bf(float f) { unsigned u = __builtin_bit_cast(unsigned, f); return (u + 0x7fffu + ((u >> 16) & 1u)) >> 16; }
__device__ __forceinline__ unsigned pk2(float lo, float hi) { return f2bf(lo) | (f2bf(hi) << 16); }
__device__ __forceinline__ float bflo(unsigned w) { return __uint_as_float(w << 16); }
__device__ __forceinline__ float bfhi(unsigned w) { return __uint_as_float(w & 0xffff0000u); }

#define XB_TMO      128
#define XB_XCNT(j)  (256  + 64 * (j))
#define XB_XSUB(j)  (1280 + 64 * (j))
#define XB_XGEN(j)  (2304 + 64 * (j))
#define XB_TOP      3328
#define XB_TOPGEN   3392
#define XCD_BAR_WORDS 3456
#define XB_SPIN_CAP (1u << 22)

__device__ __forceinline__ unsigned xb_ld(unsigned* p)              { return __hip_atomic_load(p, __ATOMIC_RELAXED, __HIP_MEMORY_SCOPE_AGENT); }
__device__ __forceinline__ unsigned xb_add(unsigned* p, unsigned v) { return __hip_atomic_fetch_add(p, v, __ATOMIC_RELAXED, __HIP_MEMORY_SCOPE_AGENT); }
__device__ __forceinline__ unsigned xb_xcc_id() { return (unsigned)__builtin_amdgcn_s_getreg((3 << 11) | 20) & 0xFu; }
#define XB_SPIN(cond, bar) do { unsigned _sp = 0; while (cond) { __builtin_amdgcn_s_sleep(1); \
    if ((++_sp & 255u) == 0u) { if (xb_ld(&(bar)[XB_TMO])) break; if (_sp > XB_SPIN_CAP) { atomicAdd(&(bar)[XB_TMO], 1u); break; } } } } while (0)

struct XcdBarrier { unsigned* bar; unsigned x; volatile LAS unsigned* st; };

__device__ __forceinline__ XcdBarrier xcd_barrier_post(unsigned* bar, volatile LAS unsigned* st) {
    XcdBarrier b; b.bar = bar; b.x = xb_xcc_id(); b.st = st;
    if (threadIdx.x == 0) (void)xb_add(&bar[XB_XCNT(b.x)], 1u);
    return b;
}
__device__ __forceinline__ void xcd_barrier_complete(unsigned* bar, unsigned x, unsigned& nloc, unsigned& nx) {
    const unsigned G = gridDim.x * gridDim.y * gridDim.z;
    unsigned sum, cnt, mine, sp = 0u;
    for (;;) {
        sum = 0u; cnt = 0u; mine = 0u;
#pragma unroll
        for (unsigned j = 0; j < 16; ++j) { const unsigned c = xb_ld(&bar[XB_XCNT(j)]); sum += c; cnt += (c > 0u) ? 1u : 0u; mine = (j == x) ? c : mine; }
        if (sum == G) break;
        __builtin_amdgcn_s_sleep(1);
        if ((++sp & 255u) == 0u) { if (xb_ld(&bar[XB_TMO])) break; if (sp > XB_SPIN_CAP) { atomicAdd(&bar[XB_TMO], 1u); break; } }
    }
    nloc = mine > 0u ? mine : 1u; nx = cnt > 0u ? cnt : 1u;
}
__device__ __forceinline__ void xcd_barrier(const XcdBarrier& b, const int wave_idx) {
    asm volatile("s_waitcnt vmcnt(0)" ::: "memory");
    __syncthreads();
    unsigned lane_b_; asm volatile("v_mbcnt_lo_u32_b32 %0, -1, 0\n\tv_mbcnt_hi_u32_b32 %0, -1, %0" : "=v"(lane_b_));
    if (wave_idx == 0 && lane_b_ == 0u) {
        unsigned* bar = b.bar;
        __builtin_amdgcn_s_waitcnt(0);
        unsigned nloc = b.st[0], nx = b.st[1];
        if (nloc == 0u) { xcd_barrier_complete(bar, b.x, nloc, nx); b.st[0] = nloc; b.st[1] = nx; }
        const unsigned old = __hip_atomic_fetch_add(&bar[XB_XSUB(b.x)], 1u, __ATOMIC_RELAXED, __HIP_MEMORY_SCOPE_WORKGROUP);
        const unsigned gen = old / nloc;
        if (old + 1u == (gen + 1u) * nloc) {
            __builtin_amdgcn_fence(__ATOMIC_RELEASE, "agent");
            asm volatile("s_waitcnt vmcnt(0)" ::: "memory");
            (void)xb_add(&bar[XB_TOP], 1u);
        }
        const unsigned target = (gen + 1u) * nx;
        asm volatile("buffer_inv sc1" ::: "memory");
        XB_SPIN(xb_ld(&bar[XB_TOP]) < target, bar);
        asm volatile("s_waitcnt vmcnt(0)" ::: "memory");
    }
    __syncthreads();
}

__device__ __forceinline__ float wave_sum(float v) {
#pragma unroll
    for (int o = 1; o < 64; o <<= 1) v += __shfl_xor(v, o);
    return v;
}
struct TTile { const float* src; const float* gain; unsigned char* dst; int ldw, ldo_b; float f8sc; };
__device__ __forceinline__ void sincos_turns(double turns, float& c, float& s) {
    const double fr = turns - __builtin_rint(turns);
    const float x = (float)fr * 6.283185307179586f;
    c = cosf(x); s = sinf(x);
}

#ifndef REP_P0
#define REP_P0 1
#endif
#ifndef REP_E2
#define REP_E2 1
#endif
#ifndef REP_SGU
#define REP_SGU 1
#endif
#ifndef REP_ROUTE
#define REP_ROUTE 1
#endif
#ifndef REP_BAR
#define REP_BAR 1
#endif
struct Args { const float* in[33]; float* out; unsigned char* ws; int ph_lo, ph_hi; };

__device__ __forceinline__ const float* in_ptr(int k) {
    const __attribute__((address_space(4))) char* ka = (const __attribute__((address_space(4))) char*)__builtin_amdgcn_kernarg_segment_ptr();
    int off = k * 8; asm volatile("" : "+s"(off));
    return *(const float* const __attribute__((address_space(4)))*)(ka + off);
}
#define INP(k) in_ptr(k)
#ifndef F8_LAST
#define F8_LAST 1
#endif
#ifndef F8_FROM
#define F8_FROM 0
#endif
#ifndef F8_FFN_FROM
#define F8_FFN_FROM 1
#endif
constexpr float F8_W13_SC = 32.f, F8_W2_SC = 64.f, F8_UM_SC = 16.f;
constexpr int TT_EV = 688, TT_OD = 5552, TT_LAYER = TT_EV + TT_OD, TT_EXP = 672, TT_TOTAL = 2 * TT_LAYER;
__device__ __forceinline__ TTile decode_tile(const Args& args, unsigned char* ws, int it) {
    const int li = it / TT_LAYER; int r = it % TT_LAYER;
    const float* W; const float* gain = nullptr; int ldw, nbn, ldo, mode = 0; unsigned char* WT; float f8sc = 0.f; int esz = 2;
    if (r < TT_EV) {
        unsigned char* wb = ws + WS_WEIN + li * EV_STRIDE;
        if (r < 96) { W = args.in[2] + (size_t)li * D * 2048; ldw = 2048; nbn = 12; gain = args.in[1] + li * D; WT = wb + EV_EIN; ldo = D; }
        else if (r < 160) { r -= 96; W = args.in[6] + (size_t)li * D * D; ldw = D; nbn = 8; WT = wb + EV_EOUT; ldo = D; }
        else if (r < 336) { r -= 160; W = args.in[8] + (size_t)li * D * FFN; ldw = FFN; nbn = 22; gain = args.in[7] + li * D; WT = wb + EV_E13; ldo = D; mode = 1; if (F8_LAST && li >= F8_FFN_FROM) { esz = 1; f8sc = F8_W13_SC; } }
        else if (r < 512) { r -= 336; W = args.in[9] + (size_t)li * D * FFN; ldw = FFN; nbn = 22; gain = args.in[7] + li * D; WT = wb + EV_E13; ldo = D; mode = 2; if (F8_LAST && li >= F8_FFN_FROM) { esz = 1; f8sc = F8_W13_SC; } }
        else { r -= 512; W = args.in[10] + (size_t)li * FFN * D; ldw = D; nbn = 8; WT = wb + EV_E2; ldo = FFN; if (F8_LAST && li >= F8_FFN_FROM) { esz = 1; f8sc = F8_W2_SC; } }
    } else {
        r -= TT_EV; unsigned char* wb = ws + WS_WODD + li * OD_STRIDE;
        if (r < 96) { W = args.in[12] + (size_t)li * D * 1536; ldw = 1536; nbn = 12; gain = args.in[11] + li * D; WT = wb + OD_OIN; ldo = D; }
        else if (r < 112) { r -= 96; W = args.in[21] + (size_t)li * 512 * 512; ldw = 512; nbn = 4; WT = wb + OD_GLU; ldo = 512; }
        else if (r < 176) { r -= 112; W = args.in[26] + (size_t)li * D * D; ldw = D; nbn = 8; WT = wb + OD_OOUT; ldo = D; }
        else { r -= 176; const int e = r / TT_EXP; r %= TT_EXP; const bool f8 = F8_LAST && li >= F8_FROM; if (f8) esz = 1;
            if (r < 224) { W = args.in[29] + ((size_t)li * NEXP + e) * D * EXD; ldw = EXD; nbn = 28; gain = args.in[27] + li * D; WT = wb + OD_M13 + (size_t)e * 2 * EXD * D * esz; ldo = D; mode = 1; if (f8) f8sc = F8_W13_SC; }
            else if (r < 448) { r -= 224; W = args.in[30] + ((size_t)li * NEXP + e) * D * EXD; ldw = EXD; nbn = 28; gain = args.in[27] + li * D; WT = wb + OD_M13 + (size_t)e * 2 * EXD * D * esz; ldo = D; mode = 2; if (f8) f8sc = F8_W13_SC; }
            else { r -= 448; W = args.in[31] + ((size_t)li * NEXP + e) * EXD * D; ldw = D; nbn = 8; WT = wb + OD_M2 + (size_t)e * D * EXD * esz; ldo = EXD; if (f8) f8sc = F8_W2_SC; } }
    }
    const int kb = r / nbn, nb = r % nbn, k0 = 128 * kb, n0 = 128 * nb;
    const size_t orow0 = mode == 0 ? (size_t)n0 : (size_t)(nb * 256 + (mode == 2 ? 128 : 0));
    TTile d; d.src = W + (size_t)k0 * ldw + n0; d.gain = gain ? gain + k0 : nullptr; d.ldw = ldw; d.f8sc = f8sc;
    d.dst = WT + (orow0 * ldo + k0) * esz; d.ldo_b = ldo * esz; return d;
}

__global__ void __launch_bounds__(NWAVES * 64, 2) trunk_fwd(Args args) {
    extern __shared__ __attribute__((aligned(16))) unsigned char lds_raw[];
    LAS unsigned char* lds = (LAS unsigned char*)lds_raw;
    volatile LAS unsigned* MISC = (volatile LAS unsigned*)(lds + MISC_OFF);
    const int G = gridDim.x, bx = blockIdx.x;
#define G_O ({ int g_ = G; asm volatile("" : "+s"(g_)); g_; })
#define BX_O ({ int b_ = bx; asm volatile("" : "+s"(b_)); b_; })
    const int wave_s = __builtin_amdgcn_readfirstlane((int)threadIdx.x >> 6);
#define PHASE_IDS int lane_o_; asm volatile("v_mbcnt_lo_u32_b32 %0, -1, 0\n\tv_mbcnt_hi_u32_b32 %0, -1, %0" : "=v"(lane_o_)); const int lane = lane_o_, wave = wave_s, tid = wave * 64 + lane; (void)tid;
#define P_ws ({ unsigned char* w_ = args.ws; asm volatile("" : "+s"(w_)); w_; })
#define P_ctl ((unsigned*)(P_ws + WS_CTL))
#define P_sm (P_ws + WS_SMALL)
#define P_SSQ ((float*)(P_ws + WS_SMALL + SM_SSQ))
#define P_HB ((bf16*)(P_ws + WS_HB))
#define P_arena (P_ws + WS_ARENA)
#define P_H ({ float* h_ = args.out; asm volatile("" : "+s"(h_)); h_; })
#define P_x_in INP(0)
#define P_wev (P_ws + WS_WEIN + lp * EV_STRIDE)
#define P_wod (P_ws + WS_WODD + lp * OD_STRIDE)
#define P_Z ((bf16*)(P_arena + AR_Z))
#define P_MIX ((bf16*)(P_arena + AR_MIX))
#define P_UF ((bf16*)(P_arena + AR_UF))
#define P_AG ((bf16*)(P_arena + AR_AG))
#define P_ZUV ((bf16*)(P_arena + AR_ZUV))
#define P_GY ((bf16*)(P_arena + AR_GY))
#define P_XS ((bf16*)(P_arena + AR_XS))
#define P_UM ((bf16*)(P_arena + AR_UM))
#define P_TOKE ((int*)(P_sm + SM_TOKE))
#define P_TOKW ((float*)(P_sm + SM_TOKW))
#define P_TOKR ((int*)(P_sm + SM_TOKR))
#define P_TOKP ((int*)(P_sm + SM_TOKP))
#define P_RSTD ((float*)(P_sm + SM_RSTD))
#define P_WGCNT ((int*)(P_sm + SM_WGCNT))
#define P_PANEL ((int*)(P_sm + SM_PANEL))
#define P_ROWT ((int*)(P_sm + SM_ROWG))

    for (int u = threadIdx.x; u < (LDS_BYTES - LDSCTL_OFF) / 4; u += NWAVES * 64) ((LAS unsigned*)(lds + LDSCTL_OFF))[u] = 0u;
    __syncthreads();
    (void)xcd_barrier_post(P_ctl + CW_BAR, MISC + 8);
    const int lo = args.ph_lo, hi = args.ph_hi;
#define IN(k) (lo <= (k) && (k) < hi)
#define RST_PREAMBLE(S) do { PHASE_IDS LAS float* rst_ = (LAS float*)(lds + RST_OFF); pg8::Unit u_; \
        for (int i_ = 0; i_ < RST_UNITS && (S).next(i_, u_); ++i_) { const int row_ = u_.pm * 256 + (tid >> 1); \
            const f32x4 a_ = *(const f32x4*)(P_SSQ + (size_t)row_ * 16 + (tid & 1) * 8), b_ = *(const f32x4*)(P_SSQ + (size_t)row_ * 16 + (tid & 1) * 8 + 4); \
            float s_ = ((a_[0] + a_[1]) + (a_[2] + a_[3])) + ((b_[0] + b_[1]) + (b_[2] + b_[3])); s_ += __shfl_xor(s_, 1); \
            if ((tid & 1) == 0) rst_[i_ * 256 + (tid >> 1)] = 1.0f / sqrtf(s_ * (1.0f / 1024.0f) + 1e-5f); } \
        __syncthreads(); } while (0)
#define SEAM(k) do { if (IN(k) && IN((k) + 1)) { for (int rb_ = 0; rb_ < REP_BAR; ++rb_) { XcdBarrier bar_; bar_.bar = P_ctl + CW_BAR; bar_.x = xb_xcc_id(); bar_.st = (volatile LAS unsigned*)(lds + MISC_OFF) + 8; xcd_barrier(bar_, wave_s); } } } while (0)

    for (int rep_ = 0; rep_ < REP_P0; ++rep_)
    if (IN(0)) {
        PHASE_IDS
        LAS float* scr = (LAS float*)(lds + RING_OFF + wave * 16384);
        const int gw = bx * NWAVES + wave, NGW = G * NWAVES;
        for (int task = bx; task < 64; task += G) {
            const int li = task >> 5, g = task & 31;
            LAS float* PWr = (LAS float*)(lds + RING_OFF);
            LAS float* PWi = PWr + 33 * 64;
            LAS float* BBr = PWi + 33 * 64;
            LAS float* BBi = BBr + 1024;
            LAS float* CRe = BBi + 1024;
            LAS float* CIm = CRe + 1024;
            LAS float* KT = CIm + 1024;
            __syncthreads();
            if (tid < 64) {
                const int p = tid; const int gp = (li * 32 + g) * 64 + p;
                const float lr = args.in[13][gp], lim = args.in[14][gp], dt = expf(args.in[15][li * 32 + g]);
                const float rho = lr * dt; const double td = (double)lim * (double)dt * 0.15915494309189535;
                for (int tau = 0; tau <= 32; ++tau) { float c, s; sincos_turns(td * (double)tau, c, s); const float mg = expf(rho * (float)tau); PWr[tau * 64 + p] = mg * c; PWi[tau * 64 + p] = mg * s; }
                float c1, s1, ch, sh; sincos_turns(td, c1, s1); sincos_turns(td * 0.5, ch, sh);
                const float mg = expf(rho), qr = expm1f(rho) * c1 - 2.0f * sh * sh, qi = mg * s1, den = lr * lr + lim * lim;
                const float fre = (qr * lr + qi * lim) / den, fim = (qi * lr - qr * lim) / den;
                for (int h = 0; h < 16; ++h) { const float br = args.in[16][(size_t)gp * 16 + h], bi = args.in[17][(size_t)gp * 16 + h]; BBr[p * 16 + h] = fre * br - fim * bi; BBi[p * 16 + h] = fre * bi + fim * br; }
                float* AT = (float*)(P_sm + SM_AT) + (size_t)gp * 2; AT[0] = PWr[32 * 64 + p]; AT[1] = PWi[32 * 64 + p];
            }
            for (int e = tid; e < 1024; e += 512) { CRe[e] = args.in[18][(size_t)(li * 32 + g) * 1024 + e]; CIm[e] = args.in[19][(size_t)(li * 32 + g) * 1024 + e]; }
            __syncthreads();
            for (int r = 0; r < 16; ++r) { const int o = tid + 512 * r, tau = o >> 8, hp = (o >> 4) & 15, h = o & 15; float a = 0.f;
                for (int p = 0; p < 64; ++p) { const float cr = CRe[hp * 64 + p], ci = CIm[hp * 64 + p], wr_ = PWr[tau * 64 + p], wi_ = PWi[tau * 64 + p];
                    const float car = cr * wr_ - ci * wi_, cai = cr * wi_ + ci * wr_; a += car * BBr[p * 16 + h] - cai * BBi[p * 16 + h]; }
                KT[o] = a; }
            __syncthreads();
            bf16* MY = (bf16*)(P_ws + WS_WODD + li * OD_STRIDE + OD_MY) + (size_t)g * 512 * 640;
            for (int r = 0; r < 80; ++r) { const int q = tid + 512 * r, n = q / 80, k0 = (q % 80) * 8, j = n >> 4, hp = n & 15; float v[8];
                if (k0 < 64) {
#pragma unroll
                    for (int e = 0; e < 8; ++e) { const int p = k0 + e; v[e] = CRe[hp * 64 + p] * PWr[(j + 1) * 64 + p] - CIm[hp * 64 + p] * PWi[(j + 1) * 64 + p]; }
                } else if (k0 < 128) {
#pragma unroll
                    for (int e = 0; e < 8; ++e) { const int p = k0 - 64 + e; v[e] = -(CRe[hp * 64 + p] * PWi[(j + 1) * 64 + p] + CIm[hp * 64 + p] * PWr[(j + 1) * 64 + p]); }
                } else { const int s = (k0 - 128) >> 4, h0 = (k0 - 128) & 15;
#pragma unroll
                    for (int e = 0; e < 8; ++e) v[e] = (s <= j) ? KT[(j - s) * 256 + hp * 16 + h0 + e] : 0.f; }
                v4u o; o.x = pk2(v[0], v[1]); o.y = pk2(v[2], v[3]); o.z = pk2(v[4], v[5]); o.w = pk2(v[6], v[7]);
                *(GAS v4u*)(MY + (size_t)n * 640 + k0) = o; }
            bf16* WST = (bf16*)(P_ws + WS_WODD + li * OD_STRIDE + OD_WST) + (size_t)g * 256 * 512;
            for (int r = 0; r < 32; ++r) { const int q = tid + 512 * r, n = q >> 6, k0 = (q & 63) * 8, s = k0 >> 4, h0 = k0 & 15; float v[8];
                if (n < 64) {
#pragma unroll
                    for (int e = 0; e < 8; ++e) v[e] = PWr[(31 - s) * 64 + n] * BBr[n * 16 + h0 + e] - PWi[(31 - s) * 64 + n] * BBi[n * 16 + h0 + e];
                } else if (n < 128) { const int p = n - 64;
#pragma unroll
                    for (int e = 0; e < 8; ++e) v[e] = PWr[(31 - s) * 64 + p] * BBi[p * 16 + h0 + e] + PWi[(31 - s) * 64 + p] * BBr[p * 16 + h0 + e];
                } else {
#pragma unroll
                    for (int e = 0; e < 8; ++e) v[e] = 0.f; }
                v4u o; o.x = pk2(v[0], v[1]); o.y = pk2(v[2], v[3]); o.z = pk2(v[4], v[5]); o.w = pk2(v[6], v[7]);
                *(GAS v4u*)(WST + (size_t)n * 512 + k0) = o; }
            __syncthreads();
        }
        for (int it = gw; it < 2 * 256; it += NGW) {
            const int li = it >> 8, r = it & 255, kb = r >> 4, gi = (r >> 2) & 3, db = r & 3, k = kb * 64 + lane;
            const float* wrow = args.in[2] + ((size_t)li * D + k) * 2048 + 1536 + gi * 128;
            const float* pw = args.in[4] + ((size_t)li * 4 + gi) * 128 * 128 + db * 32;
            float a[32];
#pragma unroll
            for (int d = 0; d < 32; ++d) a[d] = 0.f;
            for (int c4 = 0; c4 < 32; ++c4) { const f32x4 xv = *(const f32x4*)(wrow + c4 * 4);
#pragma unroll
                for (int cc = 0; cc < 4; ++cc) { const float xs = xv[cc]; const float* pr = pw + (size_t)(c4 * 4 + cc) * 128;
#pragma unroll
                    for (int d = 0; d < 32; ++d) a[d] += xs * pr[d]; } }
            const float gk = args.in[1][li * D + k];
            bf16* WT = (bf16*)(P_ws + WS_WEIN + li * EV_STRIDE + EV_EIN);
#pragma unroll
            for (int d = 0; d < 32; ++d) { const int n = gi * 128 + db * 32 + d; WT[(size_t)(1536 + n) * D + k] = (bf16)f2bf(a[d] * gk * args.in[5][li * 512 + n]); }
        }
        for (int q = bx * 512 + tid; q < 2 * 4 * 128 * 16; q += G * 512) {
            const int li = q >> 13, rem = q & 8191, hh = rem >> 11, i = (rem >> 4) & 127, j0 = (rem & 15) * 8;
            const float* src = args.in[24] + (((size_t)li * 4 + hh) * 128 + i) * 128 + j0;
            const f32x4 a = *(const f32x4*)src, b = *(const f32x4*)(src + 4);
            const bool keep = (j0 >> 6) <= (i >> 6);
            v4u o; o.x = keep ? pk2(a[0], a[1]) : 0u; o.y = keep ? pk2(a[2], a[3]) : 0u; o.z = keep ? pk2(b[0], b[1]) : 0u; o.w = keep ? pk2(b[2], b[3]) : 0u;
            *(GAS v4u*)((bf16*)(P_ws + WS_WODD + li * OD_STRIDE + OD_SGU) + ((size_t)hh * 128 + i) * 128 + j0) = o;
        }
        for (int m = gw; m < M; m += NGW) {
            const GAS f32x4* xr = (const GAS f32x4*)(args.in[0] + (size_t)m * D) + lane; f32x4 v[4]; float s = 0.f;
#pragma unroll
            for (int j = 0; j < 4; ++j) { v[j] = xr[64 * j]; s += (v[j].x * v[j].x + v[j].y * v[j].y) + (v[j].z * v[j].z + v[j].w * v[j].w); }
            s = wave_sum(s);
            GAS v2u* o8 = (GAS v2u*)(P_HB + (size_t)m * D) + lane;
#pragma unroll
            for (int j = 0; j < 4; ++j) { v2u w; w.x = pk2(v[j].x, v[j].y); w.y = pk2(v[j].z, v[j].w); o8[64 * j] = w; }
            if (lane < 16) P_SSQ[(size_t)m * 16 + lane] = lane == 0 ? s : 0.f;
        }
        {
            LAS float* tile = (LAS float*)(lds + RING_OFF); volatile LAS int* nxt = (volatile LAS int*)(lds + RING_OFF + 65536);
            unsigned* qctr = P_ctl + CW_QUEUE; int it = bx;
            const int lr = lane >> 5, nc4 = (lane & 31) * 4;
            const int cch = lane & 15, nro = lane >> 4;
#define TT_LOAD(RG, DD) do { _Pragma("unroll") for (int i = 0; i < 8; ++i) RG[i] = *(const f32x4*)((DD).src + (size_t)(wave * 16 + 2 * i + lr) * (DD).ldw + nc4); } while (0)
#define TT_STEP(RG, DD, ITC) do { \
                __syncthreads();                                                \
                _Pragma("unroll") for (int i = 0; i < 8; ++i) { const int k = wave * 16 + 2 * i + lr; *(LAS f32x4*)(tile + k * 128 + (nc4 ^ (((k >> 3) & 7) << 2))) = RG[i]; } \
                if (tid == 0) { nxt[0] = tk; tk = 2 * G + (int)__hip_atomic_fetch_add(qctr, 1u, RLX_AGENT); }     \
                __syncthreads(); \
                const int itn_ = nxt[0]; const TTile dc_ = DD; DD = decode_tile(args, P_ws, itn_ < TT_TOTAL ? itn_ : 0); \
                if (itn_ < TT_TOTAL) TT_LOAD(RG, DD); \
                f32x4 g0 = {1.f, 1.f, 1.f, 1.f}, g1 = {1.f, 1.f, 1.f, 1.f}; \
                if (dc_.gain) { g0 = *(const f32x4*)(dc_.gain + 8 * cch); g1 = *(const f32x4*)(dc_.gain + 8 * cch + 4); } \
                _Pragma("unroll") for (int i = 0; i < 4; ++i) { const int n = wave * 16 + i * 4 + nro; const int sw = n ^ ((cch & 7) << 2); const LAS float* s = tile + (8 * cch) * 128 + sw; \
                    const float e0 = s[0 * 128] * g0[0], e1 = s[1 * 128] * g0[1], e2 = s[2 * 128] * g0[2], e3 = s[3 * 128] * g0[3], e4 = s[4 * 128] * g1[0], e5 = s[5 * 128] * g1[1], e6 = s[6 * 128] * g1[2], e7 = s[7 * 128] * g1[3]; \
                    if (dc_.f8sc != 0.f) { const float q = dc_.f8sc; v2u o; o.x = pg8::pk4_fp8(e0 * q, e1 * q, e2 * q, e3 * q); o.y = pg8::pk4_fp8(e4 * q, e5 * q, e6 * q, e7 * q); \
                        *(GAS v2u*)(dc_.dst + (size_t)n * dc_.ldo_b + 8 * cch) = o; } \
                    else { v4u o; o.x = pk2(e0, e1); o.y = pk2(e2, e3); o.z = pk2(e4, e5); o.w = pk2(e6, e7); \
                        *(GAS v4u*)(dc_.dst + (size_t)n * dc_.ldo_b + 16 * cch) = o; } } \
                ITC = itn_; } while (0)
            int tk = 0; if (tid == 0) tk = 2 * G + (int)__hip_atomic_fetch_add(qctr, 1u, RLX_AGENT);
            f32x4 rgA[8], rgB[8]; int itA = bx, itB = bx + G;
            TTile dA = decode_tile(args, P_ws, itA < TT_TOTAL ? itA : 0), dB = decode_tile(args, P_ws, itB < TT_TOTAL ? itB : 0);
            if (itA < TT_TOTAL) TT_LOAD(rgA, dA);
            if (itB < TT_TOTAL) TT_LOAD(rgB, dB);
            for (;;) {
                if (itA < TT_TOTAL) TT_STEP(rgA, dA, itA);
                if (itB < TT_TOTAL) TT_STEP(rgB, dB, itB);
                if (itA >= TT_TOTAL && itB >= TT_TOTAL) break;
            }
#undef TT_LOAD
#undef TT_STEP
            __syncthreads();
        }
    }
    SEAM(0);

    for (int lp = 0; lp < 2; ++lp) {
        const int pb = 1 + lp * 15;
        if (IN(pb + 0)) {
            pg8::GDs g{P_HB, (const bf16*)(P_wev + EV_EIN), D, D, D, 30, 0}; pg8::Order S; S.init(M / 256, 2048 / 256, G_O, BX_O);
            RST_PREAMBLE(S);
            pg8::EpiScaleBf16 E{P_Z, 2048, (const LAS float*)(lds + RST_OFF)};
            pg8::gemm_phase<pg8::EpiScaleBf16, pg8::Order, pg8::GDs>(lds + RING_OFF, g, S, E, wave_s);
        }
        SEAM(pb + 0);
        for (int rep_ = 0; rep_ < REP_E2; ++rep_)
        if (IN(pb + 1)) {
            PHASE_IDS
            const float* cw = INP(3) + (size_t)lp * 3 * 512;
            const int cv = tid & 63, c0 = 8 * cv;
            f32x4 cwv[3][2];
#pragma unroll
            for (int k = 0; k < 3; ++k) { cwv[k][0] = *(const f32x4*)(cw + (2 - k) * 512 + c0); cwv[k][1] = *(const f32x4*)(cw + (2 - k) * 512 + c0 + 4); }
            const int gi = wave & 3;
            for (int vb = bx; vb < 256; vb += G) {
                for (int itx = 0; itx < 8; ++itx) {
                    const int tc = vb * 64 + itx * 8 + (tid >> 6), lc = tc & (SEQ - 1);
                    const bf16* zr = P_Z + (size_t)tc * 2048 + c0; const bool v1 = lc >= 1, v2 = lc >= 2;
                    const bf16* zr1 = v1 ? zr - 2048 : zr; const bf16* zr2 = v2 ? zr - 4096 : zr;
                    const v4u gb = *(const GAS v4u*)(zr), gc0 = *(const GAS v4u*)(zr + 512), xa0 = *(const GAS v4u*)(zr + 1024);
                    const v4u gc1 = *(const GAS v4u*)(zr1 + 512), xa1 = *(const GAS v4u*)(zr1 + 1024), gc2 = *(const GAS v4u*)(zr2 + 512), xa2 = *(const GAS v4u*)(zr2 + 1024);
                    const int t = vb * 64 + itx * 8 + 4 * (wave >> 2) + (lane >> 4), l = t & (SEQ - 1), pc0 = gi * 128 + 8 * (lane & 15);
                    const bf16* qr = P_Z + (size_t)t * 2048 + 1536 + pc0; float s[8];
#pragma unroll
                    for (int e = 0; e < 8; ++e) s[e] = 0.f;
                    v4u q0;
#define POOLW(WN) { v4u q[WN]; _Pragma("unroll") for (int k = 0; k < WN; ++k) q[k] = *(const GAS v4u*)(k <= l ? qr - (size_t)k * 2048 : qr); q0 = q[0]; \
                        _Pragma("unroll") for (int k = 0; k < WN; ++k) { const float mk = k <= l ? 1.f : 0.f; s[0] += mk * bflo(q[k].x); s[1] += mk * bfhi(q[k].x); s[2] += mk * bflo(q[k].y); s[3] += mk * bfhi(q[k].y); \
                            s[4] += mk * bflo(q[k].z); s[5] += mk * bfhi(q[k].z); s[6] += mk * bflo(q[k].w); s[7] += mk * bfhi(q[k].w); } }
                    if (gi == 0) POOLW(2) else if (gi == 1) POOLW(4) else if (gi == 2) POOLW(8) else POOLW(16)
#undef POOLW
                    {
                        const float m1 = v1 ? 1.f : 0.f, m2 = v2 ? 1.f : 0.f; float o[8];
#define CONV1(e, G0, X0, G1, X1, G2, X2, W) o[e] = cwv[0][(e) >> 2][(e) & 3] * W(G0) * W(X0) + m1 * cwv[1][(e) >> 2][(e) & 3] * W(G1) * W(X1) + m2 * cwv[2][(e) >> 2][(e) & 3] * W(G2) * W(X2)
                        CONV1(0, gc0.x, xa0.x, gc1.x, xa1.x, gc2.x, xa2.x, bflo); CONV1(1, gc0.x, xa0.x, gc1.x, xa1.x, gc2.x, xa2.x, bfhi);
                        CONV1(2, gc0.y, xa0.y, gc1.y, xa1.y, gc2.y, xa2.y, bflo); CONV1(3, gc0.y, xa0.y, gc1.y, xa1.y, gc2.y, xa2.y, bfhi);
                        CONV1(4, gc0.z, xa0.z, gc1.z, xa1.z, gc2.z, xa2.z, bflo); CONV1(5, gc0.z, xa0.z, gc1.z, xa1.z, gc2.z, xa2.z, bfhi);
                        CONV1(6, gc0.w, xa0.w, gc1.w, xa1.w, gc2.w, xa2.w, bflo); CONV1(7, gc0.w, xa0.w, gc1.w, xa1.w, gc2.w, xa2.w, bfhi);
#undef CONV1
                        v4u ov; ov.x = pk2(bflo(gb.x) * o[0], bfhi(gb.x) * o[1]); ov.y = pk2(bflo(gb.y) * o[2], bfhi(gb.y) * o[3]); ov.z = pk2(bflo(gb.z) * o[4], bfhi(gb.z) * o[5]); ov.w = pk2(bflo(gb.w) * o[6], bfhi(gb.w) * o[7]);
                        *(GAS v4u*)(P_MIX + (size_t)tc * 1024 + c0) = ov;
                    }
                    {
                        const int w = 2 << gi, cnt = (l + 1) < w ? (l + 1) : w; const float inv = 1.0f / (float)cnt;
                        v4u ov; ov.x = pk2(s[0] * inv - bflo(q0.x), s[1] * inv - bfhi(q0.x)); ov.y = pk2(s[2] * inv - bflo(q0.y), s[3] * inv - bfhi(q0.y));
                        ov.z = pk2(s[4] * inv - bflo(q0.z), s[5] * inv - bfhi(q0.z)); ov.w = pk2(s[6] * inv - bflo(q0.w), s[7] * inv - bfhi(q0.w));
                        *(GAS v4u*)(P_MIX + (size_t)t * 1024 + 512 + pc0) = ov;
                    }
                }
            }
        }
        SEAM(pb + 1);
        const bool ffn8 = F8_LAST && lp >= F8_FFN_FROM;
        if (IN(pb + 2)) {
            pg8::GDs g{P_MIX, (const bf16*)(P_wev + EV_EOUT), D, D, D, 30, 0}; pg8::Order S; S.init(M / 256, D / 256, G_O, BX_O);
            pg8::EpiResidB<false> E{P_HB, P_SSQ, 1.0f, ffn8 ? (unsigned char*)P_Z : nullptr};
            pg8::gemm_phase<pg8::EpiResidB<false>, pg8::Order, pg8::GDs>(lds + RING_OFF, g, S, E, wave_s);
        }
        SEAM(pb + 2);
        if (IN(pb + 3)) {
            pg8::Order S; S.init(M / 256, FFN / 128, G_O, BX_O);
            RST_PREAMBLE(S);
            if (ffn8) {
                pg8::GDs g{P_Z, (const bf16*)(P_wev + EV_E13), D / 2, D / 2, D / 2, 30, 0};
                pg8::EpiSwiGLUF8<true> E{(unsigned char*)P_UF, FFN, 1.0f / F8_W13_SC, F8_UM_SC, (const LAS float*)(lds + RST_OFF)};
                pg8::gemm_phase<pg8::EpiSwiGLUF8<true>, pg8::Order, pg8::GDs, 1>(lds + RING_OFF, g, S, E, wave_s);
            } else {
                pg8::GDs g{P_HB, (const bf16*)(P_wev + EV_E13), D, D, D, 30, 0};
                pg8::EpiSwiGLU<false> E{P_UF, FFN, (const LAS float*)(lds + RST_OFF)};
                pg8::gemm_phase<pg8::EpiSwiGLU<false>, pg8::Order, pg8::GDs>(lds + RING_OFF, g, S, E, wave_s);
            }
        }
        SEAM(pb + 3);
        if (IN(pb + 4)) {
            pg8::Order S; S.init(M / 256, D / 256, G_O, BX_O);
            if (ffn8) {
                pg8::GDs g{P_UF, (const bf16*)(P_wev + EV_E2), FFN / 2, FFN / 2, FFN / 2, 30, 0};
                pg8::EpiResidB<true> E{P_HB, P_SSQ, 1.0f / (F8_UM_SC * F8_W2_SC), nullptr};
                pg8::gemm_phase<pg8::EpiResidB<true>, pg8::Order, pg8::GDs, 1>(lds + RING_OFF, g, S, E, wave_s);
            } else {
                pg8::GDs g{P_UF, (const bf16*)(P_wev + EV_E2), FFN, FFN, FFN, 30, 0};
                pg8::EpiResidB<false> E{P_HB, P_SSQ, 1.0f, nullptr};
                pg8::gemm_phase<pg8::EpiResidB<false>, pg8::Order, pg8::GDs>(lds + RING_OFF, g, S, E, wave_s);
            }
        }
        SEAM(pb + 4);
        if (IN(pb + 5)) {
            pg8::GDs g{P_HB, (const bf16*)(P_wod + OD_OIN), D, D, D, 30, 0}; pg8::Order S; S.init(M / 256, 1536 / 256, G_O, BX_O);
            RST_PREAMBLE(S);
            pg8::EpiOddIn E{P_AG, P_ZUV, (const LAS float*)(lds + RST_OFF)};
            pg8::gemm_phase<pg8::EpiOddIn, pg8::Order, pg8::GDs>(lds + RING_OFF, g, S, E, wave_s);
        }
        SEAM(pb + 5);
        if (IN(pb + 6)) {
            const int NS5 = G >= 128 ? 64 : 0;
            if (NS5 == 0 || bx < NS5) {
                pg8::GDs g{P_AG + 128, (const bf16*)(P_wod + OD_WST), 640, 512, 512, 1, (size_t)256 * 512}; pg8::Order S; S.init(64, 1, NS5 ? NS5 : G_O, BX_O);
                pg8::EpiS5Scan E{P_AG, (const float*)(P_sm + SM_AT) + (size_t)lp * 32 * 64 * 2};
                pg8::gemm_phase<pg8::EpiS5Scan, pg8::Order, pg8::GDs>(lds + RING_OFF, g, S, E, wave_s);
            }
            for (int rep_ = 0; rep_ < REP_SGU; ++rep_)
            if (NS5 == 0 || bx >= NS5) {
                PHASE_IDS
                const int nwk = NS5 ? G - NS5 : G, wk = NS5 ? bx - NS5 : bx;
                LAS bf16* vT = (LAS bf16*)(lds + RING_OFF);
                const bf16* Wm = (const bf16*)(P_wod + OD_SGU);
                const float* lng = INP(23) + lp * 512; const float* sb = INP(25) + lp * 512;
                const int j_ln = tid >> 2, cq = tid & 3, fr = lane & 15, fq = lane >> 4, i_pos = wave * 16 + fr;
                for (int un = wk; un < 512; un += nwk) {
                    const int nb = un >> 2, hh = un & 3;
                    v4u vraw[4];
                    { const bf16* src = P_ZUV + (size_t)(nb * 128 + j_ln) * 1024 + 512 + hh * 128 + cq * 32;
#pragma unroll
                      for (int q4 = 0; q4 < 4; ++q4) vraw[q4] = *(const GAS v4u*)(src + q4 * 8); }
                    bf16x8 wf[4];
#pragma unroll
                    for (int ks = 0; ks < 4; ++ks) wf[ks] = *(const GAS bf16x8*)(Wm + ((size_t)hh * 128 + i_pos) * 128 + ks * 32 + fq * 8);
                    const float bias = sb[hh * 128 + i_pos]; const size_t tok = (size_t)(nb * 128 + i_pos);
                    v2u uu[8];
#pragma unroll
                    for (int ct = 0; ct < 8; ++ct) uu[ct] = *(const GAS v2u*)(P_ZUV + tok * 1024 + hh * 128 + ct * 16 + fq * 4);
                    __syncthreads();
                    {
                        float v[32]; float s = 0.f;
#pragma unroll
                        for (int q4 = 0; q4 < 4; ++q4) { const v4u w = vraw[q4];
                            v[q4 * 8 + 0] = bflo(w.x); v[q4 * 8 + 1] = bfhi(w.x); v[q4 * 8 + 2] = bflo(w.y); v[q4 * 8 + 3] = bfhi(w.y);
                            v[q4 * 8 + 4] = bflo(w.z); v[q4 * 8 + 5] = bfhi(w.z); v[q4 * 8 + 6] = bflo(w.w); v[q4 * 8 + 7] = bfhi(w.w); }
#pragma unroll
                        for (int e = 0; e < 32; ++e) s += v[e];
                        s += __shfl_xor(s, 1); s += __shfl_xor(s, 2);
                        const float mu = s * (1.0f / 128.0f); float q = 0.f;
#pragma unroll
                        for (int e = 0; e < 32; ++e) { v[e] -= mu; q += v[e] * v[e]; }
                        q += __shfl_xor(q, 1); q += __shfl_xor(q, 2);
                        const float rstd = 1.0f / sqrtf(q * (1.0f / 128.0f) + 1e-5f);
#pragma unroll
                        for (int e = 0; e < 32; ++e) { const int c = cq * 32 + e; vT[c * 136 + j_ln] = (bf16)f2bf(v[e] * rstd * lng[hh * 128 + c]); }
                    }
                    __syncthreads();
                    {
                        f32x4 acc[8];
#pragma unroll
                        for (int ct = 0; ct < 8; ++ct) acc[ct] = (f32x4){0.f, 0.f, 0.f, 0.f};
#pragma unroll
                        for (int ks = 0; ks < 4; ++ks) {
#pragma unroll
                            for (int ct = 0; ct < 8; ++ct) { const bf16x8 vf = *(const LAS bf16x8*)(vT + (ct * 16 + fr) * 136 + ks * 32 + fq * 8);
                                acc[ct] = __builtin_amdgcn_mfma_f32_16x16x32_bf16(vf, wf[ks], acc[ct], 0, 0, 0); }
                        }
#pragma unroll
                        for (int ct = 0; ct < 8; ++ct) { const int c = ct * 16 + fq * 4;
                            v2u o; o.x = pk2(bflo(uu[ct].x) * (acc[ct][0] + bias), bfhi(uu[ct].x) * (acc[ct][1] + bias)); o.y = pk2(bflo(uu[ct].y) * (acc[ct][2] + bias), bfhi(uu[ct].y) * (acc[ct][3] + bias));
                            *(GAS v2u*)(P_MIX + tok * 1024 + 512 + hh * 128 + c) = o; }
                    }
                }
                __syncthreads();
            }
        }
        SEAM(pb + 6);
        if (IN(pb + 7)) {
            pg8::GDh g{P_AG, (const bf16*)(P_wod + OD_MY), 640, 640, 640, 1, (size_t)512 * 640}; pg8::Order S; S.init(64, 4, G_O, BX_O);
            pg8::EpiS5Y E{P_AG, INP(20) + lp * 512, P_GY};
            pg8::gemm_phase<pg8::EpiS5Y, pg8::Order, pg8::GDh>(lds + RING_OFF, g, S, E, wave_s);
        }
        SEAM(pb + 7);
        if (IN(pb + 8)) {
            pg8::GDh g{P_GY, (const bf16*)(P_wod + OD_GLU), 512, 512, 512, 30, 0}; pg8::Order S; S.init(M / 256, 4, G_O, BX_O);
            pg8::EpiGLU E{P_GY, INP(22) + lp * 512, P_MIX};
            pg8::gemm_phase<pg8::EpiGLU, pg8::Order, pg8::GDh>(lds + RING_OFF, g, S, E, wave_s);
        }
        SEAM(pb + 8);
        if (IN(pb + 9)) {
            pg8::GDs g{P_MIX, (const bf16*)(P_wod + OD_OOUT), D, D, D, 30, 0}; pg8::Order S; S.init(M / 256, D / 256, G_O, BX_O);
            pg8::EpiResidB<false> E{P_HB, P_SSQ, 1.0f, nullptr};
            pg8::gemm_phase<pg8::EpiResidB<false>, pg8::Order, pg8::GDs>(lds + RING_OFF, g, S, E, wave_s);
        }
        SEAM(pb + 9);
        for (int rep_ = 0; rep_ < REP_ROUTE; ++rep_)
        if (IN(pb + 10)) {
            PHASE_IDS
            LAS int* tE = (LAS int*)(lds + RING_OFF);
            const float* Wr = INP(28) + (size_t)lp * D * 8; const float* g2 = INP(27) + lp * D;
            float gw[4][4][8];
#pragma unroll
            for (int j = 0; j < 4; ++j) { const f32x4 gv = *(const f32x4*)(g2 + 256 * j + 4 * lane);
#pragma unroll
                for (int i = 0; i < 4; ++i) { const float* wp = Wr + (size_t)(256 * j + 4 * lane + i) * 8; const f32x4 w0 = *(const f32x4*)wp, w1 = *(const f32x4*)(wp + 4);
#pragma unroll
                    for (int e = 0; e < 4; ++e) { gw[j][i][e] = w0[e] * gv[i]; gw[j][i][4 + e] = w1[e] * gv[i]; } } }
            const bool b0 = lane & 1, b1 = lane & 2, b2 = lane & 4;
            __syncthreads();
            for (int vb = bx; vb < 256; vb += G) {
                v2u hw8[8][4];
                { const GAS v2u* hr8 = (const GAS v2u*)(P_HB + (size_t)(vb * 64 + wave * 8) * D) + lane;
#pragma unroll
                  for (int q = 0; q < 8; ++q)
#pragma unroll
                      for (int j = 0; j < 4; ++j) hw8[q][j] = hr8[q * 256 + 64 * j]; }
#pragma unroll
                for (int tt = 0; tt < 8; tt += 2) {
                    const int tl = wave * 8 + tt, t = vb * 64 + tl;
                    v2u hw2[2][4];
#pragma unroll
                    for (int q = 0; q < 2; ++q)
#pragma unroll
                        for (int j = 0; j < 4; ++j) hw2[q][j] = hw8[tt + q][j];
                    f32x4 hv2[2][4];
#pragma unroll
                    for (int q = 0; q < 2; ++q)
#pragma unroll
                        for (int j = 0; j < 4; ++j) { hv2[q][j].x = bflo(hw2[q][j].x); hv2[q][j].y = bfhi(hw2[q][j].x); hv2[q][j].z = bflo(hw2[q][j].y); hv2[q][j].w = bfhi(hw2[q][j].y); }
#pragma unroll
                    for (int q = 0; q < 2; ++q) {
                        float lg[8]; float ss = 0.f;
#pragma unroll
                        for (int e = 0; e < 8; ++e) lg[e] = 0.f;
#pragma unroll
                        for (int j = 0; j < 4; ++j) { const f32x4 hv = hv2[q][j]; ss += (hv.x * hv.x + hv.y * hv.y) + (hv.z * hv.z + hv.w * hv.w);
#pragma unroll
                            for (int i = 0; i < 4; ++i) { const float hvi = hv[i];
#pragma unroll
                                for (int e = 0; e < 8; ++e) lg[e] += hvi * gw[j][i][e]; } }
                        ss = wave_sum(ss);
                        float ra[4], rb[2], rc;
#pragma unroll
                        for (int qq = 0; qq < 4; ++qq) { const float mine = b0 ? lg[4 + qq] : lg[qq], oth = b0 ? lg[qq] : lg[4 + qq]; ra[qq] = mine + __shfl_xor(oth, 1); }
#pragma unroll
                        for (int r = 0; r < 2; ++r) { const float mine = b1 ? ra[2 + r] : ra[r], oth = b1 ? ra[r] : ra[2 + r]; rb[r] = mine + __shfl_xor(oth, 2); }
                        { const float mine = b2 ? rb[1] : rb[0], oth = b2 ? rb[0] : rb[1]; rc = mine + __shfl_xor(oth, 4); }
                        rc += __shfl_xor(rc, 8); rc += __shfl_xor(rc, 16); rc += __shfl_xor(rc, 32);
                        const float rstd = 1.0f / sqrtf(ss * (1.0f / 1024.0f) + 1e-5f);
                        float lv[8];
#pragma unroll
                        for (int e = 0; e < 8; ++e) lv[e] = __shfl(rc, (e >> 2) + 2 * ((e >> 1) & 1) + 4 * (e & 1)) * rstd;
                        int e0 = 0; float v0 = lv[0];
#pragma unroll
                        for (int e = 1; e < 8; ++e) { if (lv[e] > v0) { v0 = lv[e]; e0 = e; } }
                        int e1 = -1; float v1 = 0.f;
#pragma unroll
                        for (int e = 0; e < 8; ++e) { if (e != e0 && (e1 < 0 || lv[e] > v1)) { v1 = lv[e]; e1 = e; } }
                        const float ex = __expf(v1 - v0), w0 = 1.0f / (1.0f + ex), w1 = ex * w0;
                        if (lane == 0) { tE[(tl + q) * 2] = e0; tE[(tl + q) * 2 + 1] = e1; P_TOKE[(t + q) * 2] = e0; P_TOKE[(t + q) * 2 + 1] = e1; P_TOKW[(t + q) * 2] = w0; P_TOKW[(t + q) * 2 + 1] = w1; P_RSTD[t + q] = rstd; }
                    }
                }
                __syncthreads();
                if (wave == 0) { const int e0 = tE[lane * 2], e1 = tE[lane * 2 + 1], t = vb * 64 + lane; int r0 = 0, r1 = 0;
#pragma unroll
                    for (int e = 0; e < 8; ++e) { const unsigned long long mk = __ballot(e0 == e || e1 == e); const int rk = __popcll(mk & ((1ull << lane) - 1ull));
                        if (e0 == e) r0 = rk; if (e1 == e) r1 = rk; if (lane == 0) P_WGCNT[vb * 8 + e] = __popcll(mk); }
                    P_TOKR[t * 2] = r0; P_TOKR[t * 2 + 1] = r1; }
                __syncthreads();
            }
        }
        SEAM(pb + 10);
        for (int rep_ = 0; rep_ < REP_ROUTE; ++rep_)
        if (IN(pb + 11)) {
            PHASE_IDS
            const bool f8 = F8_LAST && lp >= F8_FROM;
            LAS int* cntT = (LAS int*)(lds + RING_OFF);
            LAS int* pre = cntT + 32;
            __syncthreads();
            {
                const int e = wave; int s = 0;
#pragma unroll
                for (int i = 0; i < 4; ++i) s += P_WGCNT[(lane * 4 + i) * 8 + e];
#pragma unroll
                for (int o = 1; o < 64; o <<= 1) s += __shfl_xor(s, o);
                if (lane == 0) { cntT[e] = s; cntT[16 + e] = (s + 255) & ~255; }
            }
            __syncthreads();
            if (tid == 0) { int b = 0; for (int e = 0; e < 8; ++e) { cntT[8 + e] = b; b += cntT[16 + e]; } cntT[24] = b >> 8; }
            __syncthreads();
            if (bx == 0) { const int np = cntT[24];
                if (tid < MAXPAN) { int ex = 0; for (int e = 0; e < 8; ++e) if (tid * 256 >= cntT[8 + e]) ex = e; P_PANEL[tid] = tid < np ? ex : 0; }
                if (tid == 0) P_PANEL[MAXPAN] = np; }
            for (int e = bx; e < 8; e += G) {
                const int r0 = cntT[8 + e] + cntT[e], r1 = cntT[8 + e] + cntT[16 + e];
                if (tid < r1 - r0 && r0 + tid >= 128 * 256) P_ROWT[r0 + tid] = -1;
                if (f8) { for (int q = tid; q < (r1 - r0) * 64; q += 512) { const int r = r0 + (q >> 6); *(GAS v4u*)((unsigned char*)P_XS + (size_t)r * D + (q & 63) * 16) = (v4u){0u, 0u, 0u, 0u}; } }
                else { for (int q = tid; q < (r1 - r0) * 128; q += 512) { const int r = r0 + (q >> 7); *(GAS v4u*)(P_XS + (size_t)r * D + (q & 127) * 8) = (v4u){0u, 0u, 0u, 0u}; } }
            }
            for (int vb = bx; vb < 256; vb += G) {
                __syncthreads();
                {   const int e = wave; int s = 0;
#pragma unroll
                    for (int i = 0; i < 4; ++i) { const int b2 = lane * 4 + i; s += b2 < vb ? P_WGCNT[b2 * 8 + e] : 0; }
#pragma unroll
                    for (int o = 1; o < 64; o <<= 1) s += __shfl_xor(s, o);
                    if (lane == 0) pre[e] = s; }
                __syncthreads();
                int mp0 = 0, mp1 = 0; float mrs = 0.f;
                if (lane < 8) { const int t = vb * 64 + wave * 8 + lane; const int e0 = P_TOKE[t * 2], e1 = P_TOKE[t * 2 + 1];
                    mp0 = cntT[8 + e0] + pre[e0] + P_TOKR[t * 2]; mp1 = cntT[8 + e1] + pre[e1] + P_TOKR[t * 2 + 1]; mrs = P_RSTD[t];
                    P_TOKP[t * 2] = mp0; P_TOKP[t * 2 + 1] = mp1; if (mp0 >= 128 * 256) P_ROWT[mp0] = t; if (mp1 >= 128 * 256) P_ROWT[mp1] = t; }
                for (int tt = 0; tt < 8; tt += 2) {
                    const int t = vb * 64 + wave * 8 + tt;
                    const GAS v2u* hr = (const GAS v2u*)(P_HB + (size_t)t * D) + lane;
                    v2u hw2[2][4];
#pragma unroll
                    for (int q = 0; q < 2; ++q)
#pragma unroll
                        for (int j = 0; j < 4; ++j) hw2[q][j] = hr[q * 256 + 64 * j];
                    f32x4 hv2[2][4];
#pragma unroll
                    for (int q = 0; q < 2; ++q)
#pragma unroll
                        for (int j = 0; j < 4; ++j) { hv2[q][j].x = bflo(hw2[q][j].x); hv2[q][j].y = bfhi(hw2[q][j].x); hv2[q][j].z = bflo(hw2[q][j].y); hv2[q][j].w = bfhi(hw2[q][j].y); }
#pragma unroll
                    for (int q = 0; q < 2; ++q) {
                        const int p0 = __shfl(mp0, tt + q), p1 = __shfl(mp1, tt + q); const float rstd = __shfl(mrs, tt + q);
                        if (f8) { GAS unsigned* o0 = (GAS unsigned*)((unsigned char*)P_XS + (size_t)p0 * D) + lane; GAS unsigned* o1 = (GAS unsigned*)((unsigned char*)P_XS + (size_t)p1 * D) + lane;
#pragma unroll
                            for (int j = 0; j < 4; ++j) { const f32x4 hv = hv2[q][j]; const unsigned w = pg8::pk4_fp8(hv.x * rstd, hv.y * rstd, hv.z * rstd, hv.w * rstd); o0[64 * j] = w; o1[64 * j] = w; }
                        } else { GAS v2u* o0 = (GAS v2u*)(P_XS + (size_t)p0 * D) + lane; GAS v2u* o1 = (GAS v2u*)(P_XS + (size_t)p1 * D) + lane;
#pragma unroll
                            for (int j = 0; j < 4; ++j) { const f32x4 hv = hv2[q][j]; v2u w; w.x = pk2(hv.x * rstd, hv.y * rstd); w.y = pk2(hv.z * rstd, hv.w * rstd); o0[64 * j] = w; o1[64 * j] = w; } }
                    }
                }
            }
        }
        SEAM(pb + 11);
        LAS int* ptab = (LAS int*)(lds + PTAB_OFF);
        if (IN(pb + 12) || IN(pb + 13)) {
            PHASE_IDS
            __syncthreads();
            if (tid <= MAXPAN) ptab[tid] = (int)__hip_atomic_load((unsigned*)P_PANEL + tid, RLX_AGENT);
            __syncthreads();
        }
        if (IN(pb + 12)) {
            const int np = __builtin_amdgcn_readfirstlane(ptab[MAXPAN]);
            pg8::Order S; S.init(np, EXD / 128, G_O, BX_O);
            if (F8_LAST && lp >= F8_FROM) {
                pg8::GDt g{P_XS, (const bf16*)(P_wod + OD_M13), D / 2, D / 2, D / 2, (size_t)EXD * D, ptab};
                pg8::EpiSwiGLUF8<false> E{(unsigned char*)P_UM, EXD, 1.0f / F8_W13_SC, F8_UM_SC, nullptr};
                pg8::gemm_phase<pg8::EpiSwiGLUF8<false>, pg8::Order, pg8::GDt, 1>(lds + RING_OFF, g, S, E, wave_s);
            } else {
                pg8::GDt g{P_XS, (const bf16*)(P_wod + OD_M13), D, D, D, (size_t)2 * EXD * D, ptab};
                pg8::EpiSwiGLU<true> E{P_UM, EXD, nullptr};
                pg8::gemm_phase<pg8::EpiSwiGLU<true>, pg8::Order, pg8::GDt>(lds + RING_OFF, g, S, E, wave_s);
            }
        }
        SEAM(pb + 12);
        if (IN(pb + 13)) {
            const int np = __builtin_amdgcn_readfirstlane(ptab[MAXPAN]);
            if (F8_LAST && lp >= F8_FROM) {
                const float osc = 1.0f / (F8_UM_SC * F8_W2_SC);
                {   pg8::GDt g{P_UM, (const bf16*)(P_wod + OD_M2), EXD / 2, EXD / 2, EXD / 2, (size_t)D * EXD / 2, ptab}; pg8::Order S; S.init(np < 128 ? np : 128, D / 256, G_O, BX_O);
                    pg8::EpiBf16 E{P_XS, D, osc};
                    pg8::gemm_phase<pg8::EpiBf16, pg8::Order, pg8::GDt, 1>(lds + RING_OFF, g, S, E, wave_s); }
                if (np > 128) {
                    pg8::GDk g{P_UM, (const bf16*)(P_wod + OD_M2), EXD / 2, EXD / 2, 256, (size_t)D * EXD / 2, ptab, 128, 256}; pg8::Order S; S.init(np - 128, 28, G_O, BX_O);
                    pg8::EpiPartF32 E{(float*)(P_ws + WS_PART), osc};
                    pg8::gemm_phase<pg8::EpiPartF32, pg8::Order, pg8::GDk, 1>(lds + RING_OFF, g, S, E, wave_s); }
            } else {
                {
                    pg8::GDt g{P_UM, (const bf16*)(P_wod + OD_M2), EXD, EXD, EXD, (size_t)D * EXD, ptab}; pg8::Order S; S.init(np < 128 ? np : 128, D / 256, G_O, BX_O);
                    pg8::EpiBf16 E{P_XS, D, 1.0f};
                    pg8::gemm_phase<pg8::EpiBf16, pg8::Order, pg8::GDt>(lds + RING_OFF, g, S, E, wave_s); }
                if (np > 128) {
                    pg8::GDk g{P_UM, (const bf16*)(P_wod + OD_M2), EXD, EXD, 512, (size_t)D * EXD, ptab, 128, 512}; pg8::Order S; S.init(np - 128, 28, G_O, BX_O);
                    pg8::EpiPartF32 E{(float*)(P_ws + WS_PART), 1.0f};
                    pg8::gemm_phase<pg8::EpiPartF32, pg8::Order, pg8::GDk>(lds + RING_OFF, g, S, E, wave_s); }
            }
        }
        SEAM(pb + 13);
        if (IN(pb + 14)) {
            PHASE_IDS
            const int gw = bx * NWAVES + wave, NGW = G * NWAVES; const bf16* YC = P_XS; const float* fg = INP(32); const float* PART = (const float*)(P_ws + WS_PART);
            int mp0 = 0, mp1 = 0; float mw0 = 0.f, mw1 = 0.f;
            if (lane < 8 && gw + lane * NGW < M) { const int t = gw + lane * NGW; mp0 = P_TOKP[t * 2]; mp1 = P_TOKP[t * 2 + 1]; mw0 = P_TOKW[t * 2]; mw1 = P_TOKW[t * 2 + 1]; }
#define COMBINE_FIN(T, V, AV, BV, FAST, PP0, PP1, GW0, GW1) do { GAS f32x4* hr_ = (GAS f32x4*)(P_H + (size_t)(T) * D) + lane; float s_ = 0.f;   \
                if (FAST) { _Pragma("unroll") for (int j = 0; j < 4; ++j) { V[j].x += GW0 * bflo(AV[j].x) + GW1 * bflo(BV[j].x); V[j].y += GW0 * bfhi(AV[j].x) + GW1 * bfhi(BV[j].x); V[j].z += GW0 * bflo(AV[j].y) + GW1 * bflo(BV[j].y); V[j].w += GW0 * bfhi(AV[j].y) + GW1 * bfhi(BV[j].y); } } \
                else { _Pragma("unroll") for (int sl = 0; sl < 2; ++sl) { const int p_ = sl ? PP1 : PP0; const float gwt_ = sl ? GW1 : GW0; \
                        if (p_ < 128 * 256) { const GAS v2u* y_ = (const GAS v2u*)(YC + (size_t)p_ * D) + lane; \
                            _Pragma("unroll") for (int j = 0; j < 4; ++j) { const v2u a_ = y_[64 * j]; V[j].x += gwt_ * bflo(a_.x); V[j].y += gwt_ * bfhi(a_.x); V[j].z += gwt_ * bflo(a_.y); V[j].w += gwt_ * bfhi(a_.y); } } \
                        else { const int q_ = (p_ - 128 * 256) >> 8, r_ = p_ & 255; \
                            for (int ks = 0; ks < 7; ++ks) { const GAS f32x4* y_ = (const GAS f32x4*)(PART + ((size_t)(q_ * 7 + ks) * 256 + r_) * D) + lane; \
                                _Pragma("unroll") for (int j = 0; j < 4; ++j) V[j] += gwt_ * y_[64 * j]; } } } } \
                _Pragma("unroll") for (int j = 0; j < 4; ++j) s_ += (V[j].x * V[j].x + V[j].y * V[j].y) + (V[j].z * V[j].z + V[j].w * V[j].w); \
                s_ = wave_sum(s_); \
                if (lp == 1) { const float rstd_ = 1.0f / sqrtf(s_ * (1.0f / 1024.0f) + 1e-5f); \
                    _Pragma("unroll") for (int j = 0; j < 4; ++j) { const f32x4 gv_ = *((const GAS f32x4*)fg + lane + 64 * j); f32x4 o_; o_.x = V[j].x * rstd_ * gv_.x; o_.y = V[j].y * rstd_ * gv_.y; o_.z = V[j].z * rstd_ * gv_.z; o_.w = V[j].w * rstd_ * gv_.w; hr_[64 * j] = o_; } } \
                else { GAS v2u* o8_ = (GAS v2u*)(P_HB + (size_t)(T) * D) + lane; \
                    _Pragma("unroll") for (int j = 0; j < 4; ++j) { v2u w_; w_.x = pk2(V[j].x, V[j].y); w_.y = pk2(V[j].z, V[j].w); o8_[64 * j] = w_; } \
                    if (lane < 16) P_SSQ[(size_t)(T) * 16 + lane] = lane == 0 ? s_ : 0.f; } } while (0)
            for (int it = 0; it < 8; it += 2) {
                const int t0 = gw + it * NGW, t1 = t0 + NGW; if (t0 >= M) break;
                const bool ok1 = t1 < M;
                const int p00 = __shfl(mp0, it), p01 = __shfl(mp1, it), p10 = __shfl(mp0, it + 1), p11 = __shfl(mp1, it + 1);
                const float g00 = __shfl(mw0, it), g01 = __shfl(mw1, it), g10 = __shfl(mw0, it + 1), g11 = __shfl(mw1, it + 1);
                const bool fast0 = p00 < 128 * 256 && p01 < 128 * 256, fast1 = ok1 && p10 < 128 * 256 && p11 < 128 * 256;
                f32x4 v0[4], v1[4]; v2u a0[4], b0[4], a1[4], b1[4], h0w[4], h1w[4];
                const int t1c = ok1 ? t1 : t0;
                const GAS v2u* hr0 = (const GAS v2u*)(P_HB + (size_t)t0 * D) + lane; const GAS v2u* hr1 = (const GAS v2u*)(P_HB + (size_t)t1c * D) + lane;
                const GAS v2u* y00 = (const GAS v2u*)(YC + (size_t)(fast0 ? p00 : 0) * D) + lane; const GAS v2u* y01 = (const GAS v2u*)(YC + (size_t)(fast0 ? p01 : 0) * D) + lane;
                const GAS v2u* y10 = (const GAS v2u*)(YC + (size_t)(fast1 ? p10 : 0) * D) + lane; const GAS v2u* y11 = (const GAS v2u*)(YC + (size_t)(fast1 ? p11 : 0) * D) + lane;
#pragma unroll
                for (int j = 0; j < 4; ++j) { h0w[j] = hr0[64 * j]; a0[j] = y00[64 * j]; b0[j] = y01[64 * j]; }
#pragma unroll
                for (int j = 0; j < 4; ++j) { h1w[j] = hr1[64 * j]; a1[j] = y10[64 * j]; b1[j] = y11[64 * j]; }
#pragma unroll
                for (int j = 0; j < 4; ++j) { v0[j].x = bflo(h0w[j].x); v0[j].y = bfhi(h0w[j].x); v0[j].z = bflo(h0w[j].y); v0[j].w = bfhi(h0w[j].y); v1[j].x = bflo(h1w[j].x); v1[j].y = bfhi(h1w[j].x); v1[j].z = bflo(h1w[j].y); v1[j].w = bfhi(h1w[j].y); }
                if (fast0) COMBINE_FIN(t0, v0, a0, b0, true, p00, p01, g00, g01);
                if (fast1) COMBINE_FIN(t1, v1, a1, b1, true, p10, p11, g10, g11);
            }
            {
                const int nrow = (int)__hip_atomic_load((unsigned*)P_PANEL + MAXPAN, RLX_AGENT) * 256;
                for (int r = 128 * 256 + gw; r < nrow; r += NGW) {
                    const int t = __builtin_amdgcn_readfirstlane(P_ROWT[r]); if (t < 0) continue;
                    const int q0 = __builtin_amdgcn_readfirstlane(P_TOKP[t * 2]), q1 = __builtin_amdgcn_readfirstlane(P_TOKP[t * 2 + 1]);
                    if ((q0 >= 128 * 256 ? q0 : q1) != r) continue;
                    const float h0 = P_TOKW[t * 2], h1 = P_TOKW[t * 2 + 1];
                    f32x4 v[4]; v2u ax[4], bx_[4]; const GAS v2u* hrr = (const GAS v2u*)(P_HB + (size_t)t * D) + lane;
#pragma unroll
                    for (int j = 0; j < 4; ++j) { const v2u hw = hrr[64 * j]; v[j].x = bflo(hw.x); v[j].y = bfhi(hw.x); v[j].z = bflo(hw.y); v[j].w = bfhi(hw.y); ax[j] = (v2u){0u, 0u}; bx_[j] = (v2u){0u, 0u}; }
                    COMBINE_FIN(t, v, ax, bx_, false, q0, q1, h0, h1);
                }
            }
#undef COMBINE_FIN
        }
        if (lp == 0) SEAM(pb + 14);
    }
#undef IN
#undef SEAM
}

#ifndef MK_PER_PHASE
#define MK_PER_PHASE 0
#endif
extern "C" void kernel_launch(void* const* d_in, const int* in_sizes, int n_in, void* d_out, int out_size, void* d_ws, size_t ws_size, hipStream_t stream) {
    static int grid = 0;
    if (grid == 0) {
        if (n_in != 33 || out_size != M * D || ws_size < WS_END) { fprintf(stderr, "kernel_launch: unexpected shapes (n_in %d, out %d, ws %zu, need %zu)\n", n_in, out_size, ws_size, (size_t)WS_END); grid = -1; return; }
        int dev = 0, cus = 0, per_cu = 0;
        if (hipGetDevice(&dev) != hipSuccess || hipDeviceGetAttribute(&cus, hipDeviceAttributeMultiprocessorCount, dev) != hipSuccess) { grid = -1; return; }
        if (hipFuncSetAttribute((const void*)trunk_fwd, hipFuncAttributeMaxDynamicSharedMemorySize, LDS_BYTES) != hipSuccess) { fprintf(stderr, "kernel_launch: hipFuncSetAttribute failed\n"); grid = -1; return; }
        if (hipOccupancyMaxActiveBlocksPerMultiprocessor(&per_cu, (const void*)trunk_fwd, NWAVES * 64, LDS_BYTES) != hipSuccess || per_cu < 1) fprintf(stderr, "kernel_launch: occupancy query reports %d\n", per_cu);
        (void)hipGetLastError();
        grid = cus;
    }
    if (grid < 0) return;
    if (hipMemsetAsync((char*)d_ws + WS_CTL, 0, CTL_ZERO_BYTES, stream) != hipSuccess) return;
    Args a{};
    for (int i = 0; i < 33; ++i) a.in[i] = (const float*)d_in[i];
    a.out = (float*)d_out; a.ws = (unsigned char*)d_ws;
#if MK_PER_PHASE
    for (int p = 0; p < NPH; ++p) { a.ph_lo = p; a.ph_hi = p + 1; hipLaunchKernelGGL(trunk_fwd, dim3(grid), dim3(NWAVES * 64), LDS_BYTES, stream, a); }
#elif defined(PROBE_PRE_LO)
    for (int rp = 0; rp < PROBE_PRE_N; ++rp) { a.ph_lo = PROBE_PRE_LO; a.ph_hi = PROBE_PRE_HI; hipLaunchKernelGGL(trunk_fwd, dim3(grid), dim3(NWAVES * 64), LDS_BYTES, stream, a);
        (void)hipMemsetAsync((char*)d_ws + WS_CTL, 0, CTL_ZERO_BYTES, stream); }
    a.ph_lo = 0; a.ph_hi = NPH;
    hipLaunchKernelGGL(trunk_fwd, dim3(grid), dim3(NWAVES * 64), LDS_BYTES, stream, a);
#elif defined(PROBE_POST_LO)
    a.ph_lo = 0; a.ph_hi = NPH;
    hipLaunchKernelGGL(trunk_fwd, dim3(grid), dim3(NWAVES * 64), LDS_BYTES, stream, a);
    for (int rp = 0; rp < PROBE_POST_N; ++rp) { (void)hipMemsetAsync((char*)d_ws + WS_CTL, 0, CTL_ZERO_BYTES, stream);
        a.ph_lo = PROBE_POST_LO; a.ph_hi = PROBE_POST_HI; hipLaunchKernelGGL(trunk_fwd, dim3(grid), dim3(NWAVES * 64), LDS_BYTES, stream, a); }
#else
    a.ph_lo = 0; a.ph_hi = NPH;
    hipLaunchKernelGGL(trunk_fwd, dim3(grid), dim3(NWAVES * 64), LDS_BYTES, stream, a);
#endif
}
```

```cpp
#include <hip/hip_runtime.h>
#include <cstdio>
#include <cstdint>

namespace pg8 {
#define PG8_LAS __attribute__((address_space(3)))
typedef unsigned short bf16_t;
typedef short bf16x8 __attribute__((ext_vector_type(8)));
typedef float f32x4 __attribute__((ext_vector_type(4)));
typedef float f32x2 __attribute__((ext_vector_type(2)));
typedef unsigned u32x4 __attribute__((ext_vector_type(4)));
typedef unsigned u32x2 __attribute__((ext_vector_type(2)));
constexpr int BM = 256, BK = 64, HALF = 128, HTB = HALF * BK * 2  , STAGE_BYTES = 8 * HTB, NXCD = 8, WGM = 8;

__host__ __device__ __forceinline__ int lds_byte(int r, int c) { const int st = (r >> 4) * 2 + (c >> 5), rr = r & 15, cc = c & 31, ob = rr * 64 + cc * 2; return st * 1024 + (ob ^ (((ob >> 9) & 1) << 5)); }
__host__ __device__ __forceinline__ void stage_rc(int b, int& R, int& C) { const int st = b / 1024, sb = b % 1024, swz = sb ^ (((sb >> 9) & 1) << 5); R = (st >> 1) * 16 + swz / 64; C = (st & 1) * 32 + (swz % 64) / 2; }
__host__ __device__ __forceinline__ int perm32(int rho) { const int n = rho >> 4, i = rho & 15; return 8 * (i >> 2) + 4 * n + (i & 3); }

typedef int i32x4 __attribute__((ext_vector_type(4)));
typedef int i32x8 __attribute__((ext_vector_type(8)));
__device__ __forceinline__ i32x8 cat8(const bf16x8 a, const bf16x8 b) { return __builtin_shufflevector(__builtin_bit_cast(i32x4, a), __builtin_bit_cast(i32x4, b), 0, 1, 2, 3, 4, 5, 6, 7); }
__device__ __forceinline__ unsigned pk4_fp8(float a, float b, float c, float d) {
    a = __builtin_fminf(__builtin_fmaxf(a, -448.f), 448.f); b = __builtin_fminf(__builtin_fmaxf(b, -448.f), 448.f); c = __builtin_fminf(__builtin_fmaxf(c, -448.f), 448.f); d = __builtin_fminf(__builtin_fmaxf(d, -448.f), 448.f);
    int p = __builtin_amdgcn_cvt_pk_fp8_f32(a, b, 0, false); p = __builtin_amdgcn_cvt_pk_fp8_f32(c, d, p, true); return (unsigned)p;
}
struct Unit { int pm, pn, idx; };

struct Order {
    int nM, nN, nwg, G, c;
    __device__ __forceinline__ void init(int nM_, int nN_, int G_, int c_) { nM = nM_; nN = nN_; nwg = nM * nN; G = G_; c = c_; }
    __device__ __forceinline__ bool next(int i, Unit& u) const {
        const long L = (long)i * G + c; if (L >= nwg) return false;
        int wgid = (int)L; { const int q = nwg / NXCD, r = nwg % NXCD, xcd = wgid % NXCD, off = wgid / NXCD; wgid = (xcd < r ? xcd * (q + 1) : r * (q + 1) + (xcd - r) * q) + off; }
        const int nig = WGM * nN, gid = wgid / nig, fm = gid * WGM, gsz = (nM - fm) < WGM ? (nM - fm) : WGM;
        u.pm = fm + ((wgid % nig) % gsz); u.pn = (wgid % nig) / gsz; u.idx = i; return true;
    }
    __device__ __forceinline__ void a_ready(const Unit&) const {}
    __device__ __forceinline__ void done(const Unit&) const {}
};

struct GDs {
    const bf16_t* A; const bf16_t* Bt; int lda, ldb, K, gshift; size_t gstride;
    __device__ __forceinline__ const char* a_ptr(const Unit& u) const { return (const char*)(A + (size_t)u.pm * BM * lda); }
    __device__ __forceinline__ const char* b_ptr(const Unit& u) const { return (const char*)(Bt + (size_t)(u.pm >> gshift) * gstride + (size_t)u.pn * BM * ldb); }
};
struct GDh {
    const bf16_t* A; const bf16_t* Bt; int lda, ldb, K, gshift; size_t gstride;
    __device__ __forceinline__ const char* a_ptr(const Unit& u) const { return (const char*)(A + (size_t)u.pm * BM * lda); }
    __device__ __forceinline__ const char* b_ptr(const Unit& u) const { return (const char*)(Bt + (size_t)(u.pm >> gshift) * gstride + (size_t)u.pn * HALF * ldb); }
};
struct GDt {
    const bf16_t* A; const bf16_t* Bt; int lda, ldb, K; size_t gstride; const PG8_LAS int* tab;
    __device__ __forceinline__ const char* a_ptr(const Unit& u) const { return (const char*)(A + (size_t)u.pm * BM * lda); }
    __device__ __forceinline__ const char* b_ptr(const Unit& u) const { const int grp = __builtin_amdgcn_readfirstlane(tab[u.pm]); return (const char*)(Bt + (size_t)grp * gstride + (size_t)u.pn * BM * ldb); }
};

struct GDk {
    const bf16_t* A; const bf16_t* Bt; int lda, ldb, K; size_t gstride; const PG8_LAS int* tab; int pm0, ksl;
    __device__ __forceinline__ const char* a_ptr(const Unit& u) const { return (const char*)(A + (size_t)(pm0 + u.pm) * BM * lda + (size_t)(u.pn >> 2) * ksl); }
    __device__ __forceinline__ const char* b_ptr(const Unit& u) const { const int grp = __builtin_amdgcn_readfirstlane(tab[pm0 + u.pm]); return (const char*)(Bt + (size_t)grp * gstride + (size_t)(u.pn & 3) * BM * ldb + (size_t)(u.pn >> 2) * ksl); }
};

__device__ __forceinline__ unsigned cvt_pk_bf16(float lo, float hi) { unsigned r; asm volatile("v_cvt_pk_bf16_f32 %0, %1, %2" : "=v"(r) : "v"(lo), "v"(hi)); return r; }
__device__ __forceinline__ float bf_lo(unsigned w) { return __uint_as_float(w << 16); }
__device__ __forceinline__ float bf_hi(unsigned w) { return __uint_as_float(w & 0xffff0000u); }
__device__ __forceinline__ float sigmoid_f(float x) { return __builtin_amdgcn_rcpf(1.0f + __expf(-x)); }
__device__ __forceinline__ float silu_f(float x) { return x * sigmoid_f(x); }
__device__ __forceinline__ float gelu_f(float x) { const float z2 = 1.5957691216057308f * (x + 0.044715f * x * x * x); return x * sigmoid_f(z2); }

constexpr float RMS_EPS_F = 1e-5f;
__device__ __forceinline__ float row_rstd(const float* ssq, int row, int fq) {
    const f32x4 p = *(const f32x4*)(ssq + (size_t)row * 16 + 4 * fq);
    float s = (p[0] + p[1]) + (p[2] + p[3]);
    s += __shfl_xor(s, 16); s += __shfl_xor(s, 32);
    return 1.0f / sqrtf(s * (1.0f / 1024.0f) + RMS_EPS_F);
}
__device__ __forceinline__ void rows_rstd(const float* ssq, int row0, int fq, float (&rs)[2][4]) {
    f32x4 p[2][4];
#pragma unroll
    for (int ai = 0; ai < 2; ++ai)
#pragma unroll
        for (int m = 0; m < 4; ++m) p[ai][m] = *(const f32x4*)(ssq + (size_t)(row0 + ai * HALF + m * 16) * 16 + 4 * fq);
#pragma unroll
    for (int ai = 0; ai < 2; ++ai)
#pragma unroll
        for (int m = 0; m < 4; ++m) { float s = (p[ai][m][0] + p[ai][m][1]) + (p[ai][m][2] + p[ai][m][3]); s += __shfl_xor(s, 16); s += __shfl_xor(s, 32); rs[ai][m] = 1.0f / sqrtf(s * (1.0f / 1024.0f) + RMS_EPS_F); }
}
__device__ __forceinline__ void rows_rstd_lds(const PG8_LAS float* t, float (&rs)[2][4]) {
#pragma unroll
    for (int ai = 0; ai < 2; ++ai)
#pragma unroll
        for (int m = 0; m < 4; ++m) rs[ai][m] = t[ai * HALF + m * 16];
}
__device__ __forceinline__ u32x4 pack8(const f32x4& a, const f32x4& b) { u32x4 w; w.x = cvt_pk_bf16(a[0], a[1]); w.y = cvt_pk_bf16(a[2], a[3]); w.z = cvt_pk_bf16(b[0], b[1]); w.w = cvt_pk_bf16(b[2], b[3]); return w; }

struct EpiScaleBf16 {
    static constexpr bool PERM = true, AFTER_DRAIN = false;
    bf16_t* O; int ldc; const PG8_LAS float* rst;
    __device__ __forceinline__ void operator()(const f32x4 (&acc)[2][2][4][2], const Unit& u, int wr, int wc, int fr, int fq) const {
        const int row0 = u.pm * BM + wr * 64 + fr, col0 = u.pn * BM + wc * 32 + 8 * fq;
        float rsv[2][4]; rows_rstd_lds(rst + u.idx * 256 + wr * 64 + fr, rsv);
#pragma unroll
        for (int ai = 0; ai < 2; ++ai)
#pragma unroll
            for (int m = 0; m < 4; ++m) { const int row = row0 + ai * HALF + m * 16; const float rs = rsv[ai][m]; bf16_t* rowp = O + (size_t)row * ldc + col0;
#pragma unroll
                for (int bj = 0; bj < 2; ++bj) *(u32x4*)(rowp + bj * HALF) = pack8(acc[ai][bj][m][0] * rs, acc[ai][bj][m][1] * rs); }
    }
};
template <bool SCALED> struct EpiResid {
    static constexpr bool PERM = false, AFTER_DRAIN = false;
    const float* resid; float* H; bf16_t* HB; float* ssq; float sc; unsigned char* H8;
    __device__ __forceinline__ void operator()(const f32x4 (&acc)[2][2][4][2], const Unit& u, int wr, int wc, int fr, int fq) const {
        const int row0 = u.pm * BM + wr * 64 + fr, col0 = u.pn * BM + wc * 32 + 4 * fq;
#pragma unroll
        for (int ai = 0; ai < 2; ++ai)
#pragma unroll
            for (int m = 0; m < 4; ++m) { const int row = row0 + ai * HALF + m * 16; const size_t off = (size_t)row * 1024 + col0; float q = 0.f;
#pragma unroll
                for (int bj = 0; bj < 2; ++bj)
#pragma unroll
                    for (int n = 0; n < 2; ++n) { const f32x4 bs = *(const f32x4*)(resid + off + bj * HALF + n * 16); f32x4 o; if (SCALED) { const f32x4 a4 = acc[ai][bj][m][n]; o[0] = __builtin_fmaf(a4[0], sc, bs[0]); o[1] = __builtin_fmaf(a4[1], sc, bs[1]); o[2] = __builtin_fmaf(a4[2], sc, bs[2]); o[3] = __builtin_fmaf(a4[3], sc, bs[3]); } else o = bs + acc[ai][bj][m][n];
                        *(f32x4*)(H + off + bj * HALF + n * 16) = o;
                        if (HB) { u32x2 w; w.x = cvt_pk_bf16(o[0], o[1]); w.y = cvt_pk_bf16(o[2], o[3]); *(u32x2*)(HB + off + bj * HALF + n * 16) = w; q += (o[0] * o[0] + o[1] * o[1]) + (o[2] * o[2] + o[3] * o[3]); }
                        if (H8) *(unsigned*)(H8 + off + bj * HALF + n * 16) = pk4_fp8(o[0], o[1], o[2], o[3]); }
                if (HB) { q += __shfl_xor(q, 16); q += __shfl_xor(q, 32); if (fq == 0) ssq[(size_t)row * 16 + u.pn * 4 + wc] = q; }
                asm volatile("" ::: "memory"); }
    }
};
template <bool SCALED> struct EpiResidB {
    static constexpr bool PERM = true, AFTER_DRAIN = false;
    bf16_t* HB; float* ssq; float sc; unsigned char* H8;
    __device__ __forceinline__ void operator()(const f32x4 (&acc)[2][2][4][2], const Unit& u, int wr, int wc, int fr, int fq) const {
        const int row0 = u.pm * BM + wr * 64 + fr, col0 = u.pn * BM + wc * 32 + 8 * fq;
        u32x4 rs[2][2][2];
#define PG8_RLOAD(P, B) do { _Pragma("unroll") for (int g_ = 0; g_ < 2; ++g_) { const int gi_ = 2 * (P) + g_; \
            _Pragma("unroll") for (int bj = 0; bj < 2; ++bj) rs[B][g_][bj] = *(const u32x4*)(HB + (size_t)(row0 + (gi_ >> 2) * HALF + (gi_ & 3) * 16) * 1024 + col0 + bj * HALF); } } while (0)
        PG8_RLOAD(0, 0);
#pragma unroll
        for (int p = 0; p < 4; ++p) {
            if (p < 3) PG8_RLOAD(p + 1, (p + 1) & 1);
            asm volatile("" ::: "memory");
#pragma unroll
            for (int g = 0; g < 2; ++g) { const int gi = 2 * p + g, ai = gi >> 2, m = gi & 3; const int row = row0 + ai * HALF + m * 16; const size_t off = (size_t)row * 1024 + col0; float q = 0.f;
#pragma unroll
                for (int bj = 0; bj < 2; ++bj) { const u32x4 r = rs[p & 1][g][bj]; const f32x4 a0 = acc[ai][bj][m][0], a1 = acc[ai][bj][m][1]; f32x4 o0, o1;
                    if (SCALED) { o0[0] = __builtin_fmaf(a0[0], sc, bf_lo(r.x)); o0[1] = __builtin_fmaf(a0[1], sc, bf_hi(r.x)); o0[2] = __builtin_fmaf(a0[2], sc, bf_lo(r.y)); o0[3] = __builtin_fmaf(a0[3], sc, bf_hi(r.y));
                        o1[0] = __builtin_fmaf(a1[0], sc, bf_lo(r.z)); o1[1] = __builtin_fmaf(a1[1], sc, bf_hi(r.z)); o1[2] = __builtin_fmaf(a1[2], sc, bf_lo(r.w)); o1[3] = __builtin_fmaf(a1[3], sc, bf_hi(r.w)); }
                    else { o0[0] = a0[0] + bf_lo(r.x); o0[1] = a0[1] + bf_hi(r.x); o0[2] = a0[2] + bf_lo(r.y); o0[3] = a0[3] + bf_hi(r.y); o1[0] = a1[0] + bf_lo(r.z); o1[1] = a1[1] + bf_hi(r.z); o1[2] = a1[2] + bf_lo(r.w); o1[3] = a1[3] + bf_hi(r.w); }
                    *(u32x4*)(HB + off + bj * HALF) = pack8(o0, o1);
                    q += ((o0[0] * o0[0] + o0[1] * o0[1]) + (o0[2] * o0[2] + o0[3] * o0[3])) + ((o1[0] * o1[0] + o1[1] * o1[1]) + (o1[2] * o1[2] + o1[3] * o1[3]));
                    if (H8) { u32x2 w; w.x = pk4_fp8(o0[0], o0[1], o0[2], o0[3]); w.y = pk4_fp8(o1[0], o1[1], o1[2], o1[3]); *(u32x2*)(H8 + off + bj * HALF) = w; } }
                q += __shfl_xor(q, 16); q += __shfl_xor(q, 32); if (fq == 0) ssq[(size_t)row * 16 + u.pn * 4 + wc] = q; }
            asm volatile("" ::: "memory");
        }
#undef PG8_RLOAD
    }
};
__device__ __forceinline__ f32x2 swiglu2(const f32x2 g, const f32x2 u, const float c1, const float c2) {
    const f32x2 t = g * c1; f32x2 e; e.x = __builtin_amdgcn_exp2f(t.x); e.y = __builtin_amdgcn_exp2f(t.y);
    const f32x2 d = e + 1.0f; f32x2 r; r.x = __builtin_amdgcn_rcpf(d.x); r.y = __builtin_amdgcn_rcpf(d.y);
    return ((g * u) * r) * c2;
}
template <bool MOE> struct EpiSwiGLU {
    static constexpr bool PERM = true, AFTER_DRAIN = false;
    bf16_t* U; int ldc; const PG8_LAS float* rst;
    __device__ __forceinline__ void operator()(const f32x4 (&acc)[2][2][4][2], const Unit& u, int wr, int wc, int fr, int fq) const {
        const int row0 = u.pm * BM + wr * 64 + fr, col0 = u.pn * HALF + wc * 32 + 8 * fq;
        float rsv[2][4];
        if (!MOE) rows_rstd_lds(rst + u.idx * 256 + wr * 64 + fr, rsv);
#pragma unroll
        for (int ai = 0; ai < 2; ++ai)
#pragma unroll
            for (int m = 0; m < 4; ++m) { const int row = row0 + ai * HALF + m * 16;
                const float rs = MOE ? 1.0f : rsv[ai][m], c1 = rs * -1.4426950408889634f, c2 = rs * rs;
                const f32x4 g0 = acc[ai][0][m][0], g1 = acc[ai][0][m][1], u0 = acc[ai][1][m][0], u1 = acc[ai][1][m][1];
                const f32x2 a = swiglu2((f32x2){g0[0], g0[1]}, (f32x2){u0[0], u0[1]}, c1, c2), b = swiglu2((f32x2){g0[2], g0[3]}, (f32x2){u0[2], u0[3]}, c1, c2);
                const f32x2 c = swiglu2((f32x2){g1[0], g1[1]}, (f32x2){u1[0], u1[1]}, c1, c2), d = swiglu2((f32x2){g1[2], g1[3]}, (f32x2){u1[2], u1[3]}, c1, c2);
                u32x4 w; w.x = cvt_pk_bf16(a.x, a.y); w.y = cvt_pk_bf16(b.x, b.y); w.z = cvt_pk_bf16(c.x, c.y); w.w = cvt_pk_bf16(d.x, d.y);
                *(u32x4*)(U + (size_t)row * ldc + col0) = w; }
    }
};
__device__ __forceinline__ unsigned pk4_fp8v(const f32x2 a, const f32x2 b) {
    const float a0 = __builtin_amdgcn_fmed3f(a.x, -448.f, 448.f), a1 = __builtin_amdgcn_fmed3f(a.y, -448.f, 448.f), b0 = __builtin_amdgcn_fmed3f(b.x, -448.f, 448.f), b1 = __builtin_amdgcn_fmed3f(b.y, -448.f, 448.f);
    int p = __builtin_amdgcn_cvt_pk_fp8_f32(a0, a1, 0, false); p = __builtin_amdgcn_cvt_pk_fp8_f32(b0, b1, p, true); return (unsigned)p;
}
template <bool RS> struct EpiSwiGLUF8 {
    static constexpr bool PERM = true, AFTER_DRAIN = false;
    unsigned char* U; int ldc; float isc, osc; const PG8_LAS float* rst;
    __device__ __forceinline__ void operator()(const f32x4 (&acc)[2][2][4][2], const Unit& u, int wr, int wc, int fr, int fq) const {
        const int row0 = u.pm * BM + wr * 64 + fr, col0 = u.pn * HALF + wc * 32 + 8 * fq;
        float rsv[2][4];
        if (RS) rows_rstd_lds(rst + u.idx * 256 + wr * 64 + fr, rsv);
#pragma unroll
        for (int ai = 0; ai < 2; ++ai)
#pragma unroll
            for (int m = 0; m < 4; ++m) { const int row = row0 + ai * HALF + m * 16; const float is = RS ? isc * rsv[ai][m] : isc, c1 = is * -1.4426950408889634f, c2 = is * is * osc;
                const f32x4 g0 = acc[ai][0][m][0], g1 = acc[ai][0][m][1], u0 = acc[ai][1][m][0], u1 = acc[ai][1][m][1];
                const f32x2 a = swiglu2((f32x2){g0[0], g0[1]}, (f32x2){u0[0], u0[1]}, c1, c2), b = swiglu2((f32x2){g0[2], g0[3]}, (f32x2){u0[2], u0[3]}, c1, c2);
                const f32x2 c = swiglu2((f32x2){g1[0], g1[1]}, (f32x2){u1[0], u1[1]}, c1, c2), d = swiglu2((f32x2){g1[2], g1[3]}, (f32x2){u1[2], u1[3]}, c1, c2);
                u32x2 w; w.x = pk4_fp8v(a, b); w.y = pk4_fp8v(c, d);
                *(u32x2*)(U + (size_t)row * ldc + col0) = w; }
    }
};
struct EpiOddIn {
    static constexpr bool PERM = true, AFTER_DRAIN = false;
    bf16_t* AG; bf16_t* ZUV; const PG8_LAS float* rst;
    __device__ __forceinline__ void operator()(const f32x4 (&acc)[2][2][4][2], const Unit& u, int wr, int wc, int fr, int fq) const {
        const int row0 = u.pm * BM + wr * 64 + fr;
        float rsv[2][4]; rows_rstd_lds(rst + u.idx * 256 + wr * 64 + fr, rsv);
#pragma unroll
        for (int ai = 0; ai < 2; ++ai)
#pragma unroll
            for (int m = 0; m < 4; ++m) { const int row = row0 + ai * HALF + m * 16; const float rs = rsv[ai][m];
#pragma unroll
                for (int bj = 0; bj < 2; ++bj) { f32x4 v0 = acc[ai][bj][m][0] * rs, v1 = acc[ai][bj][m][1] * rs;
                    if (u.pn < 2) { const int cc = u.pn * BM + bj * HALF + wc * 32 + 8 * fq, g = cc >> 4, h0 = cc & 15;
                        *(u32x4*)(AG + ((size_t)g * 512 + (row >> 5)) * 640 + 128 + (row & 31) * 16 + h0) = pack8(v0, v1); }
                    else { const int cc = (u.pn - 2) * BM + bj * HALF + wc * 32 + 8 * fq;
#pragma unroll
                        for (int j = 0; j < 4; ++j) { v0[j] = gelu_f(v0[j]); v1[j] = gelu_f(v1[j]); }
                        *(u32x4*)(ZUV + (size_t)row * 1024 + cc) = pack8(v0, v1); } } }
    }
};
struct EpiS5Scan {
    static constexpr bool PERM = false, AFTER_DRAIN = true;
    bf16_t* AG; const float* AT;
    __device__ __forceinline__ void operator()(const f32x4 (&)[2][2][4][2], const Unit&, int, int, int, int) const {}
    __device__ __forceinline__ void fused(const f32x4 (&acc)[2][2][4][2], const Unit& u, int wr, int wc, int fr, int fq, PG8_LAS unsigned char* lds, int wid, int lane) const {
#pragma unroll
        for (int ai = 0; ai < 2; ++ai)
#pragma unroll
            for (int m = 0; m < 4; ++m) { const int r = ai * HALF + wr * 64 + m * 16 + fr;
#pragma unroll
                for (int n = 0; n < 2; ++n) { const int gq = (wc * 32 + n * 16 + 4 * fq) >> 2; *(PG8_LAS f32x4*)(lds + r * 512 + ((gq ^ (r & 15)) << 4)) = acc[ai][0][m][n]; } }
        asm volatile("s_waitcnt lgkmcnt(0)" ::: "memory"); __builtin_amdgcn_s_barrier(); asm volatile("" ::: "memory");
        if (wid == 0) { const int g = u.pm >> 1, p = lane;
            const float ar = AT[(g * 64 + p) * 2], ai_ = AT[(g * 64 + p) * 2 + 1]; float hr = 0.f, hi = 0.f;
            bf16_t* ap = AG + (size_t)u.pm * BM * 640 + p;
            const int g0 = p >> 2, g1 = (64 + p) >> 2, sub = (p & 3) << 2;
            for (int c0 = 0; c0 < 256; c0 += 8) { float sr[8], si[8];
#pragma unroll
                for (int e = 0; e < 8; ++e) { const int c = c0 + e; sr[e] = *(const PG8_LAS float*)(lds + c * 512 + ((g0 ^ (c & 15)) << 4) + sub); si[e] = *(const PG8_LAS float*)(lds + c * 512 + ((g1 ^ (c & 15)) << 4) + sub); }
#pragma unroll
                for (int e = 0; e < 8; ++e) { const unsigned w = cvt_pk_bf16(hr, hi); ap[(size_t)(c0 + e) * 640] = (bf16_t)(w & 0xffffu); ap[(size_t)(c0 + e) * 640 + 64] = (bf16_t)(w >> 16);
                    const float nr = ar * hr - ai_ * hi + sr[e], ni = ar * hi + ai_ * hr + si[e]; hr = nr; hi = ni; } }
        }
    }
};
struct EpiS5Y {
    static constexpr bool PERM = true, AFTER_DRAIN = false;
    const bf16_t* AG; const float* dskip; bf16_t* GY;
    __device__ __forceinline__ void operator()(const f32x4 (&acc)[2][2][4][2], const Unit& u, int wr, int wc, int fr, int fq) const {
        const int row0 = u.pm * BM + wr * 64 + fr, g = u.pm >> 1;
        const int n0 = u.pn * HALF + wc * 32 + 8 * fq, jl = n0 >> 4, h0 = n0 & 15;
        const f32x4 d0 = *(const f32x4*)(dskip + g * 16 + h0), d1 = *(const f32x4*)(dskip + g * 16 + h0 + 4);
#pragma unroll
        for (int ai = 0; ai < 2; ++ai)
#pragma unroll
            for (int m = 0; m < 4; ++m) { const int row = row0 + ai * HALF + m * 16;
                const u32x4 uu = *(const u32x4*)(AG + (size_t)row * 640 + 128 + n0);
                f32x4 y0 = acc[ai][0][m][0], y1 = acc[ai][0][m][1];
                y0[0] += d0[0] * bf_lo(uu.x); y0[1] += d0[1] * bf_hi(uu.x); y0[2] += d0[2] * bf_lo(uu.y); y0[3] += d0[3] * bf_hi(uu.y);
                y1[0] += d1[0] * bf_lo(uu.z); y1[1] += d1[1] * bf_hi(uu.z); y1[2] += d1[2] * bf_lo(uu.w); y1[3] += d1[3] * bf_hi(uu.w);
#pragma unroll
                for (int j = 0; j < 4; ++j) { y0[j] = gelu_f(y0[j]); y1[j] = gelu_f(y1[j]); }
                const int chunk = row & 511, token = chunk * 32 + jl;
                *(u32x4*)(GY + (size_t)token * 512 + g * 16 + h0) = pack8(y0, y1); }
    }
};
struct EpiGLU {
    static constexpr bool PERM = true, AFTER_DRAIN = false;
    const bf16_t* GY; const float* bias; bf16_t* MIX;
    __device__ __forceinline__ void operator()(const f32x4 (&acc)[2][2][4][2], const Unit& u, int wr, int wc, int fr, int fq) const {
        const int row0 = u.pm * BM + wr * 64 + fr, c0 = u.pn * HALF + wc * 32 + 8 * fq;
        const f32x4 b0 = *(const f32x4*)(bias + c0), b1 = *(const f32x4*)(bias + c0 + 4);
#pragma unroll
        for (int ai = 0; ai < 2; ++ai)
#pragma unroll
            for (int m = 0; m < 4; ++m) { const int row = row0 + ai * HALF + m * 16;
                const u32x4 gg = *(const u32x4*)(GY + (size_t)row * 512 + c0);
                const f32x4 a0 = acc[ai][0][m][0] + b0, a1 = acc[ai][0][m][1] + b1; f32x4 o0, o1;
                o0[0] = bf_lo(gg.x) * sigmoid_f(a0[0]); o0[1] = bf_hi(gg.x) * sigmoid_f(a0[1]); o0[2] = bf_lo(gg.y) * sigmoid_f(a0[2]); o0[3] = bf_hi(gg.y) * sigmoid_f(a0[3]);
                o1[0] = bf_lo(gg.z) * sigmoid_f(a1[0]); o1[1] = bf_hi(gg.z) * sigmoid_f(a1[1]); o1[2] = bf_lo(gg.w) * sigmoid_f(a1[2]); o1[3] = bf_hi(gg.w) * sigmoid_f(a1[3]);
                *(u32x4*)(MIX + (size_t)row * 1024 + c0) = pack8(o0, o1); }
    }
};
struct EpiBf16 {
    static constexpr bool PERM = true, AFTER_DRAIN = false;
    bf16_t* O; int ldc; float sc;
    __device__ __forceinline__ void operator()(const f32x4 (&acc)[2][2][4][2], const Unit& u, int wr, int wc, int fr, int fq) const {
        const int row0 = u.pm * BM + wr * 64 + fr, col0 = u.pn * BM + wc * 32 + 8 * fq;
#pragma unroll
        for (int ai = 0; ai < 2; ++ai)
#pragma unroll
            for (int m = 0; m < 4; ++m) { bf16_t* rowp = O + (size_t)(row0 + ai * HALF + m * 16) * ldc + col0;
#pragma unroll
                for (int bj = 0; bj < 2; ++bj) *(u32x4*)(rowp + bj * HALF) = pack8(acc[ai][bj][m][0] * sc, acc[ai][bj][m][1] * sc); }
    }
};

struct EpiPartF32 {
    static constexpr bool PERM = false, AFTER_DRAIN = false;
    float* P; float sc;
    __device__ __forceinline__ void operator()(const f32x4 (&acc)[2][2][4][2], const Unit& u, int wr, int wc, int fr, int fq) const {
        float* base = P + ((size_t)(u.pm * 7 + (u.pn >> 2)) * 256 + wr * 64 + fr) * 1024 + (u.pn & 3) * BM + wc * 32 + 4 * fq;
#pragma unroll
        for (int ai = 0; ai < 2; ++ai)
#pragma unroll
            for (int m = 0; m < 4; ++m) { float* rowp = base + (size_t)(ai * HALF + m * 16) * 1024;
#pragma unroll
                for (int bj = 0; bj < 2; ++bj)
#pragma unroll
                    for (int n = 0; n < 2; ++n) *(f32x4*)(rowp + bj * HALF + n * 16) = acc[ai][bj][m][n] * sc; }
    }
};

template <class Epi, class Sched, class GD, int MMODE = 0, bool ALIGN_EPI = true, bool SP2 = true>
__device__ __forceinline__ void gemm_phase(PG8_LAS unsigned char* lds, const GD& g, const Sched& S, const Epi& E, const int wid) {
    int lane_o; asm volatile("v_mbcnt_lo_u32_b32 %0, -1, 0\n\tv_mbcnt_hi_u32_b32 %0, -1, %0" : "=v"(lane_o));
    const int lane = lane_o, tid = wid * 64 + lane, wr = wid >> 2, wc = wid & 3, fr = lane & 15, fq = lane >> 4;
    const int K = g.K, nt = K / BK, lda = g.lda, ldb = g.ldb;
    unsigned voffA[2], voffB[2];
#pragma unroll
    for (int i = 0; i < 2; ++i) { int R, C; stage_rc(tid * 16 + i * 8192, R, C); const int Rb = Epi::PERM ? ((R & ~31) + perm32(R & 31)) : R;
        voffA[i] = (unsigned)(R * lda + C) * 2u; voffB[i] = (unsigned)(Rb * ldb + C) * 2u; }
    const size_t kstep = (size_t)(BK * 2);
    const size_t hstepA = (size_t)HALF * lda * 2, hstepB = (size_t)HALF * ldb * 2;
    const unsigned ldsw = (unsigned)wid * 1024u;
    const int aoff = lds_byte(wr * 64 + fr, fq * 8), boff = lds_byte(wc * 32 + fr, fq * 8);
#define PG8_SA(b, h) (((b) * 2 + (h)) * HTB)
#define PG8_SB(b, h) ((4 + (b) * 2 + (h)) * HTB)
#define PG8_STAGE(bufoff, gbase, voff) do { _Pragma("unroll") for (int _i = 0; _i < 2; ++_i) \
        __builtin_amdgcn_global_load_lds((const unsigned*)((const char*)(gbase) + (voff)[_i]), (PG8_LAS unsigned*)(lds + (bufoff) + ldsw + _i * 8192), 16, 0, 0); } while (0)
#define PG8_LDA(dst, b, h) do { if constexpr (MMODE == 0) { _Pragma("unroll") for (int m = 0; m < 4; ++m) _Pragma("unroll") for (int k = 0; k < 2; ++k) dst[m][k] = *(const PG8_LAS bf16x8*)(lds + PG8_SA(b, h) + aoff + m * 2048 + k * 1024); } \
        else { _Pragma("unroll") for (int m = 0; m < 4; ++m) dst##8[m] = cat8(*(const PG8_LAS bf16x8*)(lds + PG8_SA(b, h) + aoff + m * 2048), *(const PG8_LAS bf16x8*)(lds + PG8_SA(b, h) + aoff + m * 2048 + 1024)); } } while (0)
#define PG8_LDB(dst, b, h) do { if constexpr (MMODE == 0) { _Pragma("unroll") for (int n = 0; n < 2; ++n) _Pragma("unroll") for (int k = 0; k < 2; ++k) dst[n][k] = *(const PG8_LAS bf16x8*)(lds + PG8_SB(b, h) + boff + n * 2048 + k * 1024); } \
        else { _Pragma("unroll") for (int n = 0; n < 2; ++n) dst##8[n] = cat8(*(const PG8_LAS bf16x8*)(lds + PG8_SB(b, h) + boff + n * 2048), *(const PG8_LAS bf16x8*)(lds + PG8_SB(b, h) + boff + n * 2048 + 1024)); } } while (0)
#define PG8_MMA(ai, bj, At, Bt) do { __builtin_amdgcn_s_setprio(1); \
        if constexpr (MMODE == 0) { _Pragma("unroll") for (int m = 0; m < 4; ++m) _Pragma("unroll") for (int n = 0; n < 2; ++n) _Pragma("unroll") for (int k = 0; k < 2; ++k) \
            acc[ai][bj][m][n] = __builtin_amdgcn_mfma_f32_16x16x32_bf16(Bt[n][k], At[m][k], acc[ai][bj][m][n], 0, 0, 0); } \
        else { asm volatile("s_nop 1"); _Pragma("unroll") for (int m = 0; m < 4; ++m) _Pragma("unroll") for (int n = 0; n < 2; ++n) \
            asm volatile("v_mfma_scale_f32_16x16x128_f8f6f4 %0, %1, %2, %0, %3, %3 op_sel_hi:[0,0,0]" : "+v"(acc[ai][bj][m][n]) : "v"(Bt##8[n]), "v"(At##8[m]), "v"(f8one)); } \
        __builtin_amdgcn_s_setprio(0); } while (0)
#define PG8_WAIT_V(n) asm volatile("s_waitcnt vmcnt(" #n ")" ::: "memory")
#define PG8_WAIT_L(n) asm volatile("s_waitcnt lgkmcnt(" #n ")" ::: "memory")
#define PG8_BAR __builtin_amdgcn_s_barrier()
#define PG8_SCHED __builtin_amdgcn_sched_barrier(0)
    Unit cur, nxt; int ui = 0;
    if (!S.next(0, cur)) return;
    f32x4 acc[2][2][4][2];
#pragma unroll
    for (int a = 0; a < 2; ++a)
#pragma unroll
        for (int b = 0; b < 2; ++b)
#pragma unroll
            for (int m = 0; m < 4; ++m)
#pragma unroll
                for (int n = 0; n < 2; ++n) acc[a][b][m][n] = (f32x4){0.f, 0.f, 0.f, 0.f};
    const int f8one = 0x7f7f7f7f;
    bf16x8 At[4][2], B0[2][2], B1[2][2]; i32x8 At8[4], B08[2], B18[2];
    const char* cA = g.a_ptr(cur); const char* cB = g.b_ptr(cur);
    S.a_ready(cur);
    if constexpr (SP2) {
        PG8_STAGE(PG8_SB(0, 0), cB, voffB); PG8_STAGE(PG8_SB(0, 1), cB + hstepB, voffB); PG8_STAGE(PG8_SA(0, 0), cA, voffA); PG8_STAGE(PG8_SA(0, 1), cA + hstepA, voffA);
        if (wr == 1) PG8_BAR;
        PG8_WAIT_V(2); PG8_BAR;
        PG8_STAGE(PG8_SB(1, 0), cB + kstep, voffB); PG8_STAGE(PG8_SA(1, 0), cA + kstep, voffA); PG8_STAGE(PG8_SB(1, 1), cB + hstepB + kstep, voffB);
        PG8_WAIT_V(6); PG8_BAR;
    } else {
        PG8_STAGE(PG8_SB(0, 0), cB, voffB); PG8_STAGE(PG8_SA(0, 0), cA, voffA); PG8_STAGE(PG8_SB(0, 1), cB + hstepB, voffB); PG8_STAGE(PG8_SA(0, 1), cA + hstepA, voffA);
        if (wr == 1) PG8_BAR;
        PG8_WAIT_V(4); PG8_BAR;
        PG8_STAGE(PG8_SB(1, 0), cB + kstep, voffB); PG8_STAGE(PG8_SA(1, 0), cA + kstep, voffA); PG8_STAGE(PG8_SB(1, 1), cB + hstepB + kstep, voffB);
        PG8_WAIT_V(6); PG8_BAR;
    }
    for (;;) {
        const bool has_next = S.next(ui + 1, nxt);
        const char* nA = has_next ? g.a_ptr(nxt) : cA; const char* nB = has_next ? g.b_ptr(nxt) : cB;
        for (int t = 0; t < nt; t += 2) {
            const bool last = (t == nt - 2);
            const char* a1 = cA + (size_t)(t + 1) * kstep;
            const char* a2 = last ? nA : cA + (size_t)(t + 2) * kstep; const char* b2 = last ? nB : cB + (size_t)(t + 2) * kstep;
            const char* a3 = a2 + kstep; const char* b3 = b2 + kstep;
            if (last && has_next) S.a_ready(nxt);
            if constexpr (SP2) {
            PG8_LDB(B0, 0, 0); PG8_LDB(B1, 0, 1); PG8_SCHED; PG8_LDA(At, 0, 0); PG8_STAGE(PG8_SA(1, 1), a1 + hstepA, voffA);
            PG8_WAIT_V(8); PG8_WAIT_L(0); PG8_BAR; PG8_MMA(0, 0, At, B0); PG8_MMA(0, 1, At, B1); PG8_BAR; PG8_SCHED;
            PG8_LDA(At, 0, 1); PG8_STAGE(PG8_SB(0, 0), b2, voffB); PG8_STAGE(PG8_SB(0, 1), b2 + hstepB, voffB); PG8_STAGE(PG8_SA(0, 0), a2, voffA);
            PG8_WAIT_V(8); PG8_WAIT_L(0); PG8_BAR; PG8_MMA(1, 0, At, B0); PG8_MMA(1, 1, At, B1); PG8_BAR; PG8_SCHED;
            PG8_LDB(B0, 1, 0); PG8_LDB(B1, 1, 1); PG8_SCHED; PG8_LDA(At, 1, 0); PG8_STAGE(PG8_SA(0, 1), a2 + hstepA, voffA);
            PG8_WAIT_V(8); PG8_WAIT_L(0); PG8_BAR; PG8_MMA(0, 0, At, B0); PG8_MMA(0, 1, At, B1); PG8_BAR; PG8_SCHED;
            PG8_LDA(At, 1, 1); PG8_STAGE(PG8_SB(1, 0), b3, voffB); PG8_STAGE(PG8_SB(1, 1), b3 + hstepB, voffB); PG8_STAGE(PG8_SA(1, 0), a3, voffA);
            PG8_WAIT_V(8); PG8_WAIT_L(0); PG8_BAR; PG8_MMA(1, 0, At, B0); PG8_MMA(1, 1, At, B1); PG8_BAR; PG8_SCHED;
            } else {
            PG8_LDB(B0, 0, 0); PG8_SCHED; PG8_LDA(At, 0, 0); PG8_STAGE(PG8_SA(1, 1), a1 + hstepA, voffA);
            PG8_WAIT_L(8); PG8_BAR; PG8_WAIT_L(0); PG8_MMA(0, 0, At, B0); PG8_BAR; PG8_SCHED;
            PG8_LDB(B1, 0, 1); PG8_STAGE(PG8_SB(0, 0), b2, voffB);
            PG8_BAR; PG8_WAIT_L(0); PG8_MMA(0, 1, At, B1); PG8_BAR;
            PG8_LDA(At, 0, 1); PG8_STAGE(PG8_SA(0, 0), a2, voffA);
            PG8_BAR; PG8_WAIT_L(0); PG8_MMA(1, 0, At, B0); PG8_BAR; PG8_SCHED;
            PG8_STAGE(PG8_SB(0, 1), b2 + hstepB, voffB);
            PG8_WAIT_V(6); PG8_BAR; PG8_MMA(1, 1, At, B1); PG8_BAR;
            PG8_LDB(B0, 1, 0); PG8_SCHED; PG8_LDA(At, 1, 0); PG8_STAGE(PG8_SA(0, 1), a2 + hstepA, voffA);
            PG8_WAIT_L(8); PG8_BAR; PG8_WAIT_L(0); PG8_MMA(0, 0, At, B0); PG8_BAR; PG8_SCHED;
            PG8_LDB(B1, 1, 1); PG8_STAGE(PG8_SB(1, 0), b3, voffB);
            PG8_BAR; PG8_WAIT_L(0); PG8_MMA(0, 1, At, B1); PG8_BAR;
            PG8_LDA(At, 1, 1); PG8_STAGE(PG8_SA(1, 0), a3, voffA);
            PG8_BAR; PG8_WAIT_L(0); PG8_MMA(1, 0, At, B0); PG8_BAR; PG8_SCHED;
            PG8_STAGE(PG8_SB(1, 1), b3 + hstepB, voffB);
            PG8_WAIT_V(6); PG8_BAR; PG8_MMA(1, 1, At, B1); PG8_BAR;
            }
        }
        if constexpr (MMODE == 1) asm volatile("s_nop 15\n\ts_nop 15" ::: "memory");
        if constexpr (ALIGN_EPI) { if (wr == 0) PG8_BAR; }
        if constexpr (!Epi::AFTER_DRAIN) { E(acc, cur, wr, wc, fr, fq); S.done(cur); }
        if (!has_next) break;
#pragma unroll
        for (int a = 0; a < 2; ++a)
#pragma unroll
            for (int b = 0; b < 2; ++b)
#pragma unroll
                for (int m = 0; m < 4; ++m)
#pragma unroll
                    for (int n = 0; n < 2; ++n) acc[a][b][m][n] = (f32x4){0.f, 0.f, 0.f, 0.f};
        cur = nxt; cA = nA; cB = nB; ++ui;
        if constexpr (ALIGN_EPI) { if (wr == 1) PG8_BAR; }
    }
    PG8_WAIT_V(0);
    if constexpr (!ALIGN_EPI) { if (wr == 0) PG8_BAR; }
    PG8_BAR;
    if constexpr (Epi::AFTER_DRAIN) { E.fused(acc, cur, wr, wc, fr, fq, lds, wid, lane); S.done(cur); }
#undef PG8_SA
#undef PG8_SB
#undef PG8_STAGE
#undef PG8_LDA
#undef PG8_LDB
#undef PG8_MMA
#undef PG8_WAIT_V
#undef PG8_WAIT_L
#undef PG8_BAR
#undef PG8_SCHED
}
}

constexpr int NWAVES = 8;
constexpr int D = 1024, SEQ = 8192, M = 16384;
constexpr int FFN = 2816, EXD = 3584, NEXP = 8;
constexpr int XS_ROWS = 2 * M + NEXP * 256;
constexpr int MAXPAN = XS_ROWS / 256;
constexpr int NPH = 31;

constexpr size_t MiB = 1u << 20;
constexpr size_t WS_CTL = 0, CTL_ZERO_BYTES = 1 * MiB;
constexpr size_t WS_SMALL = 1 * MiB;
constexpr size_t SM_AT = 0;
constexpr size_t SM_TOKE = 64 * 1024;
constexpr size_t SM_TOKW = SM_TOKE + 128 * 1024;
constexpr size_t SM_TOKR = SM_TOKW + 128 * 1024;
constexpr size_t SM_TOKP = SM_TOKR + 128 * 1024;
constexpr size_t SM_RSTD = SM_TOKP + 128 * 1024;
constexpr size_t SM_WGCNT = SM_RSTD + 64 * 1024;
constexpr size_t SM_ROWG = SM_WGCNT + 8 * 1024;
constexpr size_t SM_PANEL = SM_ROWG + 192 * 1024;
constexpr size_t SM_SSQ = 1 * MiB;
constexpr size_t WS_WEIN = 9 * MiB;
constexpr size_t EV_EIN = 0, EV_EOUT = 4 * MiB, EV_E13 = 6 * MiB, EV_E2 = 17 * MiB, EV_STRIDE = 23 * MiB;
constexpr size_t WS_WODD = WS_WEIN + 2 * EV_STRIDE;
constexpr size_t OD_OIN = 0, OD_GLU = 3 * MiB, OD_OOUT = 4 * MiB, OD_SGU = 6 * MiB, OD_WST = 7 * MiB, OD_MY = 15 * MiB, OD_M13 = 35 * MiB, OD_M2 = 147 * MiB, OD_STRIDE = 203 * MiB;
constexpr size_t WS_HB = WS_WODD + 2 * OD_STRIDE;
constexpr size_t WS_ARENA = WS_HB + 32 * MiB;
constexpr size_t AR_UM = 0;
constexpr size_t AR_Z = 0, AR_MIX = 64 * MiB, AR_UF = 96 * MiB;
constexpr size_t AR_AG = 0, AR_SST = 20 * MiB, AR_ZUV = 32 * MiB, AR_GY = 96 * MiB;
constexpr size_t AR_XS = 238 * MiB;
constexpr size_t WS_PART = WS_ARENA + 306 * MiB;
constexpr size_t WS_END = WS_PART + 56 * MiB;
static_assert((size_t)XS_ROWS * EXD * 2 <= 238 * MiB && (size_t)XS_ROWS * D * 2 <= 68 * MiB, "arena");
static_assert(SM_PANEL + 1024 <= SM_SSQ && SM_SSQ + (size_t)M * 16 * 4 <= 8 * MiB, "small tables");
constexpr int CW_TMO = 0;
constexpr int CW_BAR = 4096;
constexpr int CW_QUEUE = 64;

constexpr int RING_OFF = 0, RING_BYTES = 131072;
constexpr int LDSCTL_OFF = RING_BYTES, MISC_OFF = LDSCTL_OFF + 320;
constexpr int PTAB_OFF = LDSCTL_OFF + 1024;
constexpr int RST_OFF = LDSCTL_OFF + 2048;
constexpr int RST_UNITS = 6;
constexpr int LDS_BYTES = 147456;

#define GAS __attribute__((address_space(1)))
#define LAS __attribute__((address_space(3)))
typedef unsigned short bf16;
typedef unsigned v4u __attribute__((ext_vector_type(4)));
typedef unsigned v2u __attribute__((ext_vector_type(2)));
typedef float f32x4 __attribute__((ext_vector_type(4)));
typedef short bf16x8 __attribute__((ext_vector_type(8)));
#define RLX_AGENT __ATOMIC_RELAXED, __HIP_MEMORY_SCOPE_AGENT
#define LDS_WAIT() asm volatile("s_waitcnt lgkmcnt(0)" ::: "memory")
#define VM_WAIT() asm volatile("s_waitcnt vmcnt(0)" ::: "memory")
__device__ __forceinline__ unsigned f2bf(float f) { unsigned u = __builtin_bit_cast(unsigned, f); return (u + 0x7fffu + ((u >> 16) & 1u)) >> 16; }
__device__ __forceinline__ unsigned pk2(float lo, float hi) { return f2bf(lo) | (f2bf(hi) << 16); }
__device__ __forceinline__ float bflo(unsigned w) { return __uint_as_float(w << 16); }
__device__ __forceinline__ float bfhi(unsigned w) { return __uint_as_float(w & 0xffff0000u); }

#define XB_TMO      128
#define XB_XCNT(j)  (256  + 64 * (j))
#define XB_XSUB(j)  (1280 + 64 * (j))
#define XB_XGEN(j)  (2304 + 64 * (j))
#define XB_TOP      3328
#define XB_TOPGEN   3392
#define XCD_BAR_WORDS 3456
#define XB_SPIN_CAP (1u << 22)

__device__ __forceinline__ unsigned xb_ld(unsigned* p)              { return __hip_atomic_load(p, __ATOMIC_RELAXED, __HIP_MEMORY_SCOPE_AGENT); }
__device__ __forceinline__ unsigned xb_add(unsigned* p, unsigned v) { return __hip_atomic_fetch_add(p, v, __ATOMIC_RELAXED, __HIP_MEMORY_SCOPE_AGENT); }
__device__ __forceinline__ unsigned xb_xcc_id() { return (unsigned)__builtin_amdgcn_s_getreg((3 << 11) | 20) & 0xFu; }
#define XB_SPIN(cond, bar) do { unsigned _sp = 0; while (cond) { __builtin_amdgcn_s_sleep(1); \
    if ((++_sp & 255u) == 0u) { if (xb_ld(&(bar)[XB_TMO])) break; if (_sp > XB_SPIN_CAP) { atomicAdd(&(bar)[XB_TMO], 1u); break; } } } } while (0)

struct XcdBarrier { unsigned* bar; unsigned x; volatile LAS unsigned* st; };

__device__ __forceinline__ XcdBarrier xcd_barrier_post(unsigned* bar, volatile LAS unsigned* st) {
    XcdBarrier b; b.bar = bar; b.x = xb_xcc_id(); b.st = st;
    if (threadIdx.x == 0) st[2] = xb_add(&bar[XB_XCNT(b.x)], 1u);
    return b;
}
__device__ __forceinline__ void xcd_barrier_complete(unsigned* bar, unsigned x, unsigned& nloc, unsigned& nx, unsigned& uni, unsigned& xidx) {
    const unsigned G = gridDim.x * gridDim.y * gridDim.z;
    unsigned sum, cnt, mine, below, odd, sp = 0u;
    for (;;) {
        sum = 0u; cnt = 0u; mine = 0u; below = 0u; odd = 0u;
#pragma unroll
        for (unsigned j = 0; j < 16; ++j) { const unsigned c = xb_ld(&bar[XB_XCNT(j)]); sum += c; cnt += (c > 0u) ? 1u : 0u; mine = (j == x) ? c : mine; below += (j < x && c > 0u) ? 1u : 0u; odd += (c > 0u && c * 8u != G) ? 1u : 0u; }
        if (sum == G) break;
        __builtin_amdgcn_s_sleep(1);
        if ((++sp & 255u) == 0u) { if (xb_ld(&bar[XB_TMO])) break; if (sp > XB_SPIN_CAP) { atomicAdd(&bar[XB_TMO], 1u); break; } }
    }
    nloc = mine > 0u ? mine : 1u; nx = cnt > 0u ? cnt : 1u;
    uni = (sum == G && cnt == 8u && odd == 0u) ? 1u : 0u; xidx = below;
}
__device__ __forceinline__ void xcd_barrier(const XcdBarrier& b, const int wave_idx, const bool rel = true) {
    asm volatile("s_waitcnt vmcnt(0)" ::: "memory");
    __syncthreads();
    unsigned lane_b_; asm volatile("v_mbcnt_lo_u32_b32 %0, -1, 0\n\tv_mbcnt_hi_u32_b32 %0, -1, %0" : "=v"(lane_b_));
    if (wave_idx == 0 && lane_b_ == 0u) {
        unsigned* bar = b.bar;
        __builtin_amdgcn_s_waitcnt(0);
        unsigned nloc = b.st[0], nx = b.st[1];
        if (nloc == 0u) { unsigned uni, xidx; xcd_barrier_complete(bar, b.x, nloc, nx, uni, xidx); b.st[0] = nloc; b.st[1] = nx; b.st[3] = uni; b.st[4] = xidx; }
        const unsigned old = __hip_atomic_fetch_add(&bar[XB_XSUB(b.x)], 1u, __ATOMIC_RELAXED, __HIP_MEMORY_SCOPE_WORKGROUP);
        const unsigned gen = old / nloc;
        if (old + 1u == (gen + 1u) * nloc) {
            if (rel) { __builtin_amdgcn_fence(__ATOMIC_RELEASE, "agent"); asm volatile("s_waitcnt vmcnt(0)" ::: "memory"); }
            (void)xb_add(&bar[XB_TOP], 1u);
        }
        const unsigned target = (gen + 1u) * nx;
        asm volatile("buffer_inv sc1" ::: "memory");
        XB_SPIN(xb_ld(&bar[XB_TOP]) < target, bar);
        asm volatile("s_waitcnt vmcnt(0)" ::: "memory");
    }
    __syncthreads();
}

__device__ __forceinline__ float wave_sum(float v) {
#pragma unroll
    for (int o = 1; o < 64; o <<= 1) v += __shfl_xor(v, o);
    return v;
}
struct TTile { const float* src; const float* gain; unsigned char* dst; int ldw, ldo_b; float f8sc; };
__device__ __forceinline__ void sincos_turns(double turns, float& c, float& s) {
    const double fr = turns - __builtin_rint(turns);
    const float x = (float)fr * 6.283185307179586f;
    c = cosf(x); s = sinf(x);
}

#ifndef REP_P0
#define REP_P0 1
#endif
#ifndef REP_E2
#define REP_E2 1
#endif
#ifndef REP_SGU
#define REP_SGU 1
#endif
#ifndef REP_ROUTE
#define REP_ROUTE 1
#endif
#ifndef REP_BAR
#define REP_BAR 1
#endif
struct Args { const float* in[33]; float* out; unsigned char* ws; int ph_lo, ph_hi; };

__device__ __forceinline__ const float* in_ptr(int k) {
    const __attribute__((address_space(4))) char* ka = (const __attribute__((address_space(4))) char*)__builtin_amdgcn_kernarg_segment_ptr();
    int off = k * 8; asm volatile("" : "+s"(off));
    return *(const float* const __attribute__((address_space(4)))*)(ka + off);
}
#define INP(k) in_ptr(k)
#ifndef F8_LAST
#define F8_LAST 1
#endif
#ifndef F8_FROM
#define F8_FROM 0
#endif
#ifndef F8_FFN_FROM
#define F8_FFN_FROM 1
#endif
constexpr float F8_W13_SC = 32.f, F8_W2_SC = 64.f, F8_UM_SC = 16.f;
constexpr int TT_EV = 688, TT_OD = 5552, TT_LAYER = TT_EV + TT_OD, TT_EXP = 672, TT_TOTAL = 2 * TT_LAYER;
__device__ __forceinline__ TTile decode_tile(const Args& args, unsigned char* ws, int it) {
    const int li = it / TT_LAYER; int r = it % TT_LAYER;
    const float* W; const float* gain = nullptr; int ldw, nbn, ldo, mode = 0; unsigned char* WT; float f8sc = 0.f; int esz = 2;
    if (r < TT_EV) {
        unsigned char* wb = ws + WS_WEIN + li * EV_STRIDE;
        if (r < 96) { W = args.in[2] + (size_t)li * D * 2048; ldw = 2048; nbn = 12; gain = args.in[1] + li * D; WT = wb + EV_EIN; ldo = D; }
        else if (r < 160) { r -= 96; W = args.in[6] + (size_t)li * D * D; ldw = D; nbn = 8; WT = wb + EV_EOUT; ldo = D; }
        else if (r < 336) { r -= 160; W = args.in[8] + (size_t)li * D * FFN; ldw = FFN; nbn = 22; gain = args.in[7] + li * D; WT = wb + EV_E13; ldo = D; mode = 1; if (F8_LAST && li >= F8_FFN_FROM) { esz = 1; f8sc = F8_W13_SC; } }
        else if (r < 512) { r -= 336; W = args.in[9] + (size_t)li * D * FFN; ldw = FFN; nbn = 22; gain = args.in[7] + li * D; WT = wb + EV_E13; ldo = D; mode = 2; if (F8_LAST && li >= F8_FFN_FROM) { esz = 1; f8sc = F8_W13_SC; } }
        else { r -= 512; W = args.in[10] + (size_t)li * FFN * D; ldw = D; nbn = 8; WT = wb + EV_E2; ldo = FFN; if (F8_LAST && li >= F8_FFN_FROM) { esz = 1; f8sc = F8_W2_SC; } }
    } else {
        r -= TT_EV; unsigned char* wb = ws + WS_WODD + li * OD_STRIDE;
        if (r < 96) { W = args.in[12] + (size_t)li * D * 1536; ldw = 1536; nbn = 12; gain = args.in[11] + li * D; WT = wb + OD_OIN; ldo = D; }
        else if (r < 112) { r -= 96; W = args.in[21] + (size_t)li * 512 * 512; ldw = 512; nbn = 4; WT = wb + OD_GLU; ldo = 512; }
        else if (r < 176) { r -= 112; W = args.in[26] + (size_t)li * D * D; ldw = D; nbn = 8; WT = wb + OD_OOUT; ldo = D; }
        else { r -= 176; const int e = r / TT_EXP; r %= TT_EXP; const bool f8 = F8_LAST && li >= F8_FROM; if (f8) esz = 1;
            if (r < 224) { W = args.in[29] + ((size_t)li * NEXP + e) * D * EXD; ldw = EXD; nbn = 28; gain = args.in[27] + li * D; WT = wb + OD_M13 + (size_t)e * 2 * EXD * D * esz; ldo = D; mode = 1; if (f8) f8sc = F8_W13_SC; }
            else if (r < 448) { r -= 224; W = args.in[30] + ((size_t)li * NEXP + e) * D * EXD; ldw = EXD; nbn = 28; gain = args.in[27] + li * D; WT = wb + OD_M13 + (size_t)e * 2 * EXD * D * esz; ldo = D; mode = 2; if (f8) f8sc = F8_W13_SC; }
            else { r -= 448; W = args.in[31] + ((size_t)li * NEXP + e) * EXD * D; ldw = D; nbn = 8; WT = wb + OD_M2 + (size_t)e * D * EXD * esz; ldo = EXD; if (f8) f8sc = F8_W2_SC; } }
    }
    const int kb = r / nbn, nb = r % nbn, k0 = 128 * kb, n0 = 128 * nb;
    const size_t orow0 = mode == 0 ? (size_t)n0 : (size_t)(nb * 256 + (mode == 2 ? 128 : 0));
    TTile d; d.src = W + (size_t)k0 * ldw + n0; d.gain = gain ? gain + k0 : nullptr; d.ldw = ldw; d.f8sc = f8sc;
    d.dst = WT + (orow0 * ldo + k0) * esz; d.ldo_b = ldo * esz; return d;
}

__global__ void __launch_bounds__(NWAVES * 64, 2) trunk_fwd(Args args) {
    extern __shared__ __attribute__((aligned(16))) unsigned char lds_raw[];
    LAS unsigned char* lds = (LAS unsigned char*)lds_raw;
    volatile LAS unsigned* MISC = (volatile LAS unsigned*)(lds + MISC_OFF);
    const int G = gridDim.x, bx = blockIdx.x;
#define G_O ({ int g_ = G; asm volatile("" : "+s"(g_)); g_; })
#define BX_O ({ int b_ = cx; asm volatile("" : "+s"(b_)); b_; })
    const int wave_s = __builtin_amdgcn_readfirstlane((int)threadIdx.x >> 6);
#define PHASE_IDS int lane_o_; asm volatile("v_mbcnt_lo_u32_b32 %0, -1, 0\n\tv_mbcnt_hi_u32_b32 %0, -1, %0" : "=v"(lane_o_)); const int lane = lane_o_, wave = wave_s, tid = wave * 64 + lane; (void)tid;
#define P_ws ({ unsigned char* w_ = args.ws; asm volatile("" : "+s"(w_)); w_; })
#define P_ctl ((unsigned*)(P_ws + WS_CTL))
#define P_sm (P_ws + WS_SMALL)
#define P_SSQ ((float*)(P_ws + WS_SMALL + SM_SSQ))
#define P_HB ((bf16*)(P_ws + WS_HB))
#define P_arena (P_ws + WS_ARENA)
#define P_H ({ float* h_ = args.out; asm volatile("" : "+s"(h_)); h_; })
#define P_x_in INP(0)
#define P_wev (P_ws + WS_WEIN + lp * EV_STRIDE)
#define P_wod (P_ws + WS_WODD + lp * OD_STRIDE)
#define P_Z ((bf16*)(P_arena + AR_Z))
#define P_MIX ((bf16*)(P_arena + AR_MIX))
#define P_UF ((bf16*)(P_arena + AR_UF))
#define P_AG ((bf16*)(P_arena + AR_AG))
#define P_ZUV ((bf16*)(P_arena + AR_ZUV))
#define P_GY ((bf16*)(P_arena + AR_GY))
#define P_XS ((bf16*)(P_arena + AR_XS))
#define P_UM ((bf16*)(P_arena + AR_UM))
#define P_TOKE ((int*)(P_sm + SM_TOKE))
#define P_TOKW ((float*)(P_sm + SM_TOKW))
#define P_TOKR ((int*)(P_sm + SM_TOKR))
#define P_TOKP ((int*)(P_sm + SM_TOKP))
#define P_RSTD ((float*)(P_sm + SM_RSTD))
#define P_WGCNT ((int*)(P_sm + SM_WGCNT))
#define P_PANEL ((int*)(P_sm + SM_PANEL))
#define P_ROWT ((int*)(P_sm + SM_ROWG))

    for (int u = threadIdx.x; u < (LDS_BYTES - LDSCTL_OFF) / 4; u += NWAVES * 64) ((LAS unsigned*)(lds + LDSCTL_OFF))[u] = 0u;
    __syncthreads();
    (void)xcd_barrier_post(P_ctl + CW_BAR, MISC + 8);
    const int lo = args.ph_lo, hi = args.ph_hi;
#define IN(k) (lo <= (k) && (k) < hi)
#define RST_PREAMBLE(S) do { PHASE_IDS LAS float* rst_ = (LAS float*)(lds + RST_OFF); pg8::Unit u_; \
        for (int i_ = 0; i_ < RST_UNITS && (S).next(i_, u_); ++i_) { const int row_ = u_.pm * 256 + (tid >> 1); \
            const f32x4 a_ = *(const f32x4*)(P_SSQ + (size_t)row_ * 16 + (tid & 1) * 8), b_ = *(const f32x4*)(P_SSQ + (size_t)row_ * 16 + (tid & 1) * 8 + 4); \
            float s_ = ((a_[0] + a_[1]) + (a_[2] + a_[3])) + ((b_[0] + b_[1]) + (b_[2] + b_[3])); s_ += __shfl_xor(s_, 1); \
            if ((tid & 1) == 0) rst_[i_ * 256 + (tid >> 1)] = 1.0f / sqrtf(s_ * (1.0f / 1024.0f) + 1e-5f); } \
        __syncthreads(); } while (0)
#define SEAM_X(k, REL) do { if (IN(k) && IN((k) + 1)) { for (int rb_ = 0; rb_ < REP_BAR; ++rb_) { XcdBarrier bar_; bar_.bar = P_ctl + CW_BAR; bar_.x = xb_xcc_id(); bar_.st = (volatile LAS unsigned*)(lds + MISC_OFF) + 8; xcd_barrier(bar_, wave_s, REL); } } } while (0)
#define SEAM(k) SEAM_X(k, true)
#define SEAM_L(k) SEAM_X(k, uni_ == 0)

    for (int rep_ = 0; rep_ < REP_P0; ++rep_)
    if (IN(0)) {
        PHASE_IDS
        LAS float* scr = (LAS float*)(lds + RING_OFF + wave * 16384);
        const int gw = bx * NWAVES + wave, NGW = G * NWAVES;
        for (int task = bx; task < 64; task += G) {
            const int li = task >> 5, g = task & 31;
            LAS float* PWr = (LAS float*)(lds + RING_OFF);
            LAS float* PWi = PWr + 33 * 64;
            LAS float* BBr = PWi + 33 * 64;
            LAS float* BBi = BBr + 1024;
            LAS float* CRe = BBi + 1024;
            LAS float* CIm = CRe + 1024;
            LAS float* KT = CIm + 1024;
            __syncthreads();
            if (tid < 64) {
                const int p = tid; const int gp = (li * 32 + g) * 64 + p;
                const float lr = args.in[13][gp], lim = args.in[14][gp], dt = expf(args.in[15][li * 32 + g]);
                const float rho = lr * dt; const double td = (double)lim * (double)dt * 0.15915494309189535;
                for (int tau = 0; tau <= 32; ++tau) { float c, s; sincos_turns(td * (double)tau, c, s); const float mg = expf(rho * (float)tau); PWr[tau * 64 + p] = mg * c; PWi[tau * 64 + p] = mg * s; }
                float c1, s1, ch, sh; sincos_turns(td, c1, s1); sincos_turns(td * 0.5, ch, sh);
                const float mg = expf(rho), qr = expm1f(rho) * c1 - 2.0f * sh * sh, qi = mg * s1, den = lr * lr + lim * lim;
                const float fre = (qr * lr + qi * lim) / den, fim = (qi * lr - qr * lim) / den;
                for (int h = 0; h < 16; ++h) { const float br = args.in[16][(size_t)gp * 16 + h], bi = args.in[17][(size_t)gp * 16 + h]; BBr[p * 16 + h] = fre * br - fim * bi; BBi[p * 16 + h] = fre * bi + fim * br; }
                float* AT = (float*)(P_sm + SM_AT) + (size_t)gp * 2; AT[0] = PWr[32 * 64 + p]; AT[1] = PWi[32 * 64 + p];
            }
            for (int e = tid; e < 1024; e += 512) { CRe[e] = args.in[18][(size_t)(li * 32 + g) * 1024 + e]; CIm[e] = args.in[19][(size_t)(li * 32 + g) * 1024 + e]; }
            __syncthreads();
            for (int r = 0; r < 16; ++r) { const int o = tid + 512 * r, tau = o >> 8, hp = (o >> 4) & 15, h = o & 15; float a = 0.f;
                for (int p = 0; p < 64; ++p) { const float cr = CRe[hp * 64 + p], ci = CIm[hp * 64 + p], wr_ = PWr[tau * 64 + p], wi_ = PWi[tau * 64 + p];
                    const float car = cr * wr_ - ci * wi_, cai = cr * wi_ + ci * wr_; a += car * BBr[p * 16 + h] - cai * BBi[p * 16 + h]; }
                KT[o] = a; }
            __syncthreads();
            bf16* MY = (bf16*)(P_ws + WS_WODD + li * OD_STRIDE + OD_MY) + (size_t)g * 512 * 640;
            for (int r = 0; r < 80; ++r) { const int q = tid + 512 * r, n = q / 80, k0 = (q % 80) * 8, j = n >> 4, hp = n & 15; float v[8];
                if (k0 < 64) {
#pragma unroll
                    for (int e = 0; e < 8; ++e) { const int p = k0 + e; v[e] = CRe[hp * 64 + p] * PWr[(j + 1) * 64 + p] - CIm[hp * 64 + p] * PWi[(j + 1) * 64 + p]; }
                } else if (k0 < 128) {
#pragma unroll
                    for (int e = 0; e < 8; ++e) { const int p = k0 - 64 + e; v[e] = -(CRe[hp * 64 + p] * PWi[(j + 1) * 64 + p] + CIm[hp * 64 + p] * PWr[(j + 1) * 64 + p]); }
                } else { const int s = (k0 - 128) >> 4, h0 = (k0 - 128) & 15;
#pragma unroll
                    for (int e = 0; e < 8; ++e) v[e] = (s <= j) ? KT[(j - s) * 256 + hp * 16 + h0 + e] : 0.f; }
                v4u o; o.x = pk2(v[0], v[1]); o.y = pk2(v[2], v[3]); o.z = pk2(v[4], v[5]); o.w = pk2(v[6], v[7]);
                *(GAS v4u*)(MY + (size_t)n * 640 + k0) = o; }
            bf16* WST = (bf16*)(P_ws + WS_WODD + li * OD_STRIDE + OD_WST) + (size_t)g * 256 * 512;
            for (int r = 0; r < 32; ++r) { const int q = tid + 512 * r, n = q >> 6, k0 = (q & 63) * 8, s = k0 >> 4, h0 = k0 & 15; float v[8];
                if (n < 64) {
#pragma unroll
                    for (int e = 0; e < 8; ++e) v[e] = PWr[(31 - s) * 64 + n] * BBr[n * 16 + h0 + e] - PWi[(31 - s) * 64 + n] * BBi[n * 16 + h0 + e];
                } else if (n < 128) { const int p = n - 64;
#pragma unroll
                    for (int e = 0; e < 8; ++e) v[e] = PWr[(31 - s) * 64 + p] * BBi[p * 16 + h0 + e] + PWi[(31 - s) * 64 + p] * BBr[p * 16 + h0 + e];
                } else {
#pragma unroll
                    for (int e = 0; e < 8; ++e) v[e] = 0.f; }
                v4u o; o.x = pk2(v[0], v[1]); o.y = pk2(v[2], v[3]); o.z = pk2(v[4], v[5]); o.w = pk2(v[6], v[7]);
                *(GAS v4u*)(WST + (size_t)n * 512 + k0) = o; }
            __syncthreads();
        }
        for (int it = gw; it < 2 * 256; it += NGW) {
            const int li = it >> 8, r = it & 255, kb = r >> 4, gi = (r >> 2) & 3, db = r & 3, k = kb * 64 + lane;
            const float* wrow = args.in[2] + ((size_t)li * D + k) * 2048 + 1536 + gi * 128;
            const float* pw = args.in[4] + ((size_t)li * 4 + gi) * 128 * 128 + db * 32;
            float a[32];
#pragma unroll
            for (int d = 0; d < 32; ++d) a[d] = 0.f;
            for (int c4 = 0; c4 < 32; ++c4) { const f32x4 xv = *(const f32x4*)(wrow + c4 * 4);
#pragma unroll
                for (int cc = 0; cc < 4; ++cc) { const float xs = xv[cc]; const float* pr = pw + (size_t)(c4 * 4 + cc) * 128;
#pragma unroll
                    for (int d = 0; d < 32; ++d) a[d] += xs * pr[d]; } }
            const float gk = args.in[1][li * D + k];
            bf16* WT = (bf16*)(P_ws + WS_WEIN + li * EV_STRIDE + EV_EIN);
#pragma unroll
            for (int d = 0; d < 32; ++d) { const int n = gi * 128 + db * 32 + d; WT[(size_t)(1536 + n) * D + k] = (bf16)f2bf(a[d] * gk * args.in[5][li * 512 + n]); }
        }
        for (int q = bx * 512 + tid; q < 2 * 4 * 128 * 16; q += G * 512) {
            const int li = q >> 13, rem = q & 8191, hh = rem >> 11, i = (rem >> 4) & 127, j0 = (rem & 15) * 8;
            const float* src = args.in[24] + (((size_t)li * 4 + hh) * 128 + i) * 128 + j0;
            const f32x4 a = *(const f32x4*)src, b = *(const f32x4*)(src + 4);
            const bool keep = (j0 >> 6) <= (i >> 6);
            v4u o; o.x = keep ? pk2(a[0], a[1]) : 0u; o.y = keep ? pk2(a[2], a[3]) : 0u; o.z = keep ? pk2(b[0], b[1]) : 0u; o.w = keep ? pk2(b[2], b[3]) : 0u;
            *(GAS v4u*)((bf16*)(P_ws + WS_WODD + li * OD_STRIDE + OD_SGU) + ((size_t)hh * 128 + i) * 128 + j0) = o;
        }
        for (int m = gw; m < M; m += NGW) {
            const GAS f32x4* xr = (const GAS f32x4*)(args.in[0] + (size_t)m * D) + lane; f32x4 v[4]; float s = 0.f;
#pragma unroll
            for (int j = 0; j < 4; ++j) { v[j] = xr[64 * j]; s += (v[j].x * v[j].x + v[j].y * v[j].y) + (v[j].z * v[j].z + v[j].w * v[j].w); }
            s = wave_sum(s);
            GAS v2u* o8 = (GAS v2u*)(P_HB + (size_t)m * D) + lane;
#pragma unroll
            for (int j = 0; j < 4; ++j) { v2u w; w.x = pk2(v[j].x, v[j].y); w.y = pk2(v[j].z, v[j].w); o8[64 * j] = w; }
            if (lane < 16) P_SSQ[(size_t)m * 16 + lane] = lane == 0 ? s : 0.f;
        }
        {
            LAS float* tile = (LAS float*)(lds + RING_OFF); volatile LAS int* nxt = (volatile LAS int*)(lds + RING_OFF + 65536);
            unsigned* qctr = P_ctl + CW_QUEUE; int it = bx;
            const int lr = lane >> 5, nc4 = (lane & 31) * 4;
            const int cch = lane & 15, nro = lane >> 4;
#define TT_LOAD(RG, DD) do { _Pragma("unroll") for (int i = 0; i < 8; ++i) RG[i] = *(const f32x4*)((DD).src + (size_t)(wave * 16 + 2 * i + lr) * (DD).ldw + nc4); } while (0)
#define TT_STEP(RG, DD, ITC) do { \
                __syncthreads();                                                \
                _Pragma("unroll") for (int i = 0; i < 8; ++i) { const int k = wave * 16 + 2 * i + lr; *(LAS f32x4*)(tile + k * 128 + (nc4 ^ (((k >> 3) & 7) << 2))) = RG[i]; } \
                if (tid == 0) { nxt[0] = tk; tk = 2 * G + (int)__hip_atomic_fetch_add(qctr, 1u, RLX_AGENT); }     \
                __syncthreads(); \
                const int itn_ = nxt[0]; const TTile dc_ = DD; DD = decode_tile(args, P_ws, itn_ < TT_TOTAL ? itn_ : 0); \
                if (itn_ < TT_TOTAL) TT_LOAD(RG, DD); \
                f32x4 g0 = {1.f, 1.f, 1.f, 1.f}, g1 = {1.f, 1.f, 1.f, 1.f}; \
                if (dc_.gain) { g0 = *(const f32x4*)(dc_.gain + 8 * cch); g1 = *(const f32x4*)(dc_.gain + 8 * cch + 4); } \
                _Pragma("unroll") for (int i = 0; i < 4; ++i) { const int n = wave * 16 + i * 4 + nro; const int sw = n ^ ((cch & 7) << 2); const LAS float* s = tile + (8 * cch) * 128 + sw; \
                    const float e0 = s[0 * 128] * g0[0], e1 = s[1 * 128] * g0[1], e2 = s[2 * 128] * g0[2], e3 = s[3 * 128] * g0[3], e4 = s[4 * 128] * g1[0], e5 = s[5 * 128] * g1[1], e6 = s[6 * 128] * g1[2], e7 = s[7 * 128] * g1[3]; \
                    if (dc_.f8sc != 0.f) { const float q = dc_.f8sc; v2u o; o.x = pg8::pk4_fp8(e0 * q, e1 * q, e2 * q, e3 * q); o.y = pg8::pk4_fp8(e4 * q, e5 * q, e6 * q, e7 * q); \
                        *(GAS v2u*)(dc_.dst + (size_t)n * dc_.ldo_b + 8 * cch) = o; } \
                    else { v4u o; o.x = pk2(e0, e1); o.y = pk2(e2, e3); o.z = pk2(e4, e5); o.w = pk2(e6, e7); \
                        *(GAS v4u*)(dc_.dst + (size_t)n * dc_.ldo_b + 16 * cch) = o; } } \
                ITC = itn_; } while (0)
            int tk = 0; if (tid == 0) tk = 2 * G + (int)__hip_atomic_fetch_add(qctr, 1u, RLX_AGENT);
            f32x4 rgA[8], rgB[8]; int itA = bx, itB = bx + G;
            TTile dA = decode_tile(args, P_ws, itA < TT_TOTAL ? itA : 0), dB = decode_tile(args, P_ws, itB < TT_TOTAL ? itB : 0);
            if (itA < TT_TOTAL) TT_LOAD(rgA, dA);
            if (itB < TT_TOTAL) TT_LOAD(rgB, dB);
            for (;;) {
                if (itA < TT_TOTAL) TT_STEP(rgA, dA, itA);
                if (itB < TT_TOTAL) TT_STEP(rgB, dB, itB);
                if (itA >= TT_TOTAL && itB >= TT_TOTAL) break;
            }
#undef TT_LOAD
#undef TT_STEP
            __syncthreads();
        }
    }
    SEAM(0);
    const int uni_ = __builtin_amdgcn_readfirstlane((int)MISC[11]);
    const int cx = uni_ ? __builtin_amdgcn_readfirstlane((int)(MISC[10] * 8u + MISC[12])) : bx;
    const int vbx = uni_ ? ((cx & 7) << 5) + (cx >> 3) : bx;

    for (int lp = 0; lp < 2; ++lp) {
        const int pb = 1 + lp * 15;
        if (IN(pb + 0)) {
            pg8::GDs g{P_HB, (const bf16*)(P_wev + EV_EIN), D, D, D, 30, 0}; pg8::Order S; S.init(M / 256, 2048 / 256, G_O, BX_O);
            RST_PREAMBLE(S);
            pg8::EpiScaleBf16 E{P_Z, 2048, (const LAS float*)(lds + RST_OFF)};
            pg8::gemm_phase<pg8::EpiScaleBf16, pg8::Order, pg8::GDs>(lds + RING_OFF, g, S, E, wave_s);
        }
        SEAM(pb + 0);
        for (int rep_ = 0; rep_ < REP_E2; ++rep_)
        if (IN(pb + 1)) {
            PHASE_IDS
            const float* cw = INP(3) + (size_t)lp * 3 * 512;
            const int cv = tid & 63, c0 = 8 * cv;
            f32x4 cwv[3][2];
#pragma unroll
            for (int k = 0; k < 3; ++k) { cwv[k][0] = *(const f32x4*)(cw + (2 - k) * 512 + c0); cwv[k][1] = *(const f32x4*)(cw + (2 - k) * 512 + c0 + 4); }
            const int gi = wave & 3;
            for (int vb = vbx; vb < 256; vb += G) {
                for (int itx = 0; itx < 8; ++itx) {
                    const int tc = vb * 64 + itx * 8 + (tid >> 6), lc = tc & (SEQ - 1);
                    const bf16* zr = P_Z + (size_t)tc * 2048 + c0; const bool v1 = lc >= 1, v2 = lc >= 2;
                    const bf16* zr1 = v1 ? zr - 2048 : zr; const bf16* zr2 = v2 ? zr - 4096 : zr;
                    const v4u gb = *(const GAS v4u*)(zr), gc0 = *(const GAS v4u*)(zr + 512), xa0 = *(const GAS v4u*)(zr + 1024);
                    const v4u gc1 = *(const GAS v4u*)(zr1 + 512), xa1 = *(const GAS v4u*)(zr1 + 1024), gc2 = *(const GAS v4u*)(zr2 + 512), xa2 = *(const GAS v4u*)(zr2 + 1024);
                    const int t = vb * 64 + itx * 8 + 4 * (wave >> 2) + (lane >> 4), l = t & (SEQ - 1), pc0 = gi * 128 + 8 * (lane & 15);
                    const bf16* qr = P_Z + (size_t)t * 2048 + 1536 + pc0; float s[8];
#pragma unroll
                    for (int e = 0; e < 8; ++e) s[e] = 0.f;
                    v4u q0;
#define POOLW(WN) { v4u q[WN]; _Pragma("unroll") for (int k = 0; k < WN; ++k) q[k] = *(const GAS v4u*)(k <= l ? qr - (size_t)k * 2048 : qr); q0 = q[0]; \
                        _Pragma("unroll") for (int k = 0; k < WN; ++k) { const float mk = k <= l ? 1.f : 0.f; s[0] += mk * bflo(q[k].x); s[1] += mk * bfhi(q[k].x); s[2] += mk * bflo(q[k].y); s[3] += mk * bfhi(q[k].y); \
                            s[4] += mk * bflo(q[k].z); s[5] += mk * bfhi(q[k].z); s[6] += mk * bflo(q[k].w); s[7] += mk * bfhi(q[k].w); } }
                    if (gi == 0) POOLW(2) else if (gi == 1) POOLW(4) else if (gi == 2) POOLW(8) else POOLW(16)
#undef POOLW
                    {
                        const float m1 = v1 ? 1.f : 0.f, m2 = v2 ? 1.f : 0.f; float o[8];
#define CONV1(e, G0, X0, G1, X1, G2, X2, W) o[e] = cwv[0][(e) >> 2][(e) & 3] * W(G0) * W(X0) + m1 * cwv[1][(e) >> 2][(e) & 3] * W(G1) * W(X1) + m2 * cwv[2][(e) >> 2][(e) & 3] * W(G2) * W(X2)
                        CONV1(0, gc0.x, xa0.x, gc1.x, xa1.x, gc2.x, xa2.x, bflo); CONV1(1, gc0.x, xa0.x, gc1.x, xa1.x, gc2.x, xa2.x, bfhi);
                        CONV1(2, gc0.y, xa0.y, gc1.y, xa1.y, gc2.y, xa2.y, bflo); CONV1(3, gc0.y, xa0.y, gc1.y, xa1.y, gc2.y, xa2.y, bfhi);
                        CONV1(4, gc0.z, xa0.z, gc1.z, xa1.z, gc2.z, xa2.z, bflo); CONV1(5, gc0.z, xa0.z, gc1.z, xa1.z, gc2.z, xa2.z, bfhi);
                        CONV1(6, gc0.w, xa0.w, gc1.w, xa1.w, gc2.w, xa2.w, bflo); CONV1(7, gc0.w, xa0.w, gc1.w, xa1.w, gc2.w, xa2.w, bfhi);
#undef CONV1
                        v4u ov; ov.x = pk2(bflo(gb.x) * o[0], bfhi(gb.x) * o[1]); ov.y = pk2(bflo(gb.y) * o[2], bfhi(gb.y) * o[3]); ov.z = pk2(bflo(gb.z) * o[4], bfhi(gb.z) * o[5]); ov.w = pk2(bflo(gb.w) * o[6], bfhi(gb.w) * o[7]);
                        *(GAS v4u*)(P_MIX + (size_t)tc * 1024 + c0) = ov;
                    }
                    {
                        const int w = 2 << gi, cnt = (l + 1) < w ? (l + 1) : w; const float inv = 1.0f / (float)cnt;
                        v4u ov; ov.x = pk2(s[0] * inv - bflo(q0.x), s[1] * inv - bfhi(q0.x)); ov.y = pk2(s[2] * inv - bflo(q0.y), s[3] * inv - bfhi(q0.y));
                        ov.z = pk2(s[4] * inv - bflo(q0.z), s[5] * inv - bfhi(q0.z)); ov.w = pk2(s[6] * inv - bflo(q0.w), s[7] * inv - bfhi(q0.w));
                        *(GAS v4u*)(P_MIX + (size_t)t * 1024 + 512 + pc0) = ov;
                    }
                }
            }
        }
        SEAM_L(pb + 1);
        const bool ffn8 = F8_LAST && lp >= F8_FFN_FROM;
        if (IN(pb + 2)) {
            pg8::GDs g{P_MIX, (const bf16*)(P_wev + EV_EOUT), D, D, D, 30, 0}; pg8::Order S; S.init(M / 256, D / 256, G_O, BX_O);
            pg8::EpiResidB<false> E{P_HB, P_SSQ, 1.0f, ffn8 ? (unsigned char*)P_Z : nullptr};
            pg8::gemm_phase<pg8::EpiResidB<false>, pg8::Order, pg8::GDs>(lds + RING_OFF, g, S, E, wave_s);
        }
        SEAM_L(pb + 2);
        if (IN(pb + 3)) {
            pg8::Order S; S.init(M / 256, FFN / 128, G_O, BX_O);
            RST_PREAMBLE(S);
            if (ffn8) {
                pg8::GDs g{P_Z, (const bf16*)(P_wev + EV_E13), D / 2, D / 2, D / 2, 30, 0};
                pg8::EpiSwiGLUF8<true> E{(unsigned char*)P_UF, FFN, 1.0f / F8_W13_SC, F8_UM_SC, (const LAS float*)(lds + RST_OFF)};
                pg8::gemm_phase<pg8::EpiSwiGLUF8<true>, pg8::Order, pg8::GDs, 1>(lds + RING_OFF, g, S, E, wave_s);
            } else {
                pg8::GDs g{P_HB, (const bf16*)(P_wev + EV_E13), D, D, D, 30, 0};
                pg8::EpiSwiGLU<false> E{P_UF, FFN, (const LAS float*)(lds + RST_OFF)};
                pg8::gemm_phase<pg8::EpiSwiGLU<false>, pg8::Order, pg8::GDs>(lds + RING_OFF, g, S, E, wave_s);
            }
        }
        SEAM_L(pb + 3);
        if (IN(pb + 4)) {
            pg8::Order S; S.init(M / 256, D / 256, G_O, BX_O);
            if (ffn8) {
                pg8::GDs g{P_UF, (const bf16*)(P_wev + EV_E2), FFN / 2, FFN / 2, FFN / 2, 30, 0};
                pg8::EpiResidB<true> E{P_HB, P_SSQ, 1.0f / (F8_UM_SC * F8_W2_SC), nullptr};
                pg8::gemm_phase<pg8::EpiResidB<true>, pg8::Order, pg8::GDs, 1>(lds + RING_OFF, g, S, E, wave_s);
            } else {
                pg8::GDs g{P_UF, (const bf16*)(P_wev + EV_E2), FFN, FFN, FFN, 30, 0};
                pg8::EpiResidB<false> E{P_HB, P_SSQ, 1.0f, nullptr};
                pg8::gemm_phase<pg8::EpiResidB<false>, pg8::Order, pg8::GDs>(lds + RING_OFF, g, S, E, wave_s);
            }
        }
        SEAM_L(pb + 4);
        if (IN(pb + 5)) {
            pg8::GDs g{P_HB, (const bf16*)(P_wod + OD_OIN), D, D, D, 30, 0}; pg8::Order S; S.init(M / 256, 1536 / 256, G_O, BX_O);
            RST_PREAMBLE(S);
            pg8::EpiOddIn E{P_AG, P_ZUV, (const LAS float*)(lds + RST_OFF)};
            pg8::gemm_phase<pg8::EpiOddIn, pg8::Order, pg8::GDs>(lds + RING_OFF, g, S, E, wave_s);
        }
        SEAM(pb + 5);
        if (IN(pb + 6)) {
            const int NS5 = G >= 128 ? 64 : 0;
            if (NS5 == 0 || cx < NS5) {
                pg8::GDs g{P_AG + 128, (const bf16*)(P_wod + OD_WST), 640, 512, 512, 1, (size_t)256 * 512}; pg8::Order S; S.init(64, 1, NS5 ? NS5 : G_O, BX_O);
                pg8::EpiS5Scan E{P_AG, (const float*)(P_sm + SM_AT) + (size_t)lp * 32 * 64 * 2};
                pg8::gemm_phase<pg8::EpiS5Scan, pg8::Order, pg8::GDs>(lds + RING_OFF, g, S, E, wave_s);
            }
            for (int rep_ = 0; rep_ < REP_SGU; ++rep_)
            if (NS5 == 0 || cx >= NS5) {
                PHASE_IDS
                const int nwk = NS5 ? G - NS5 : G, wk = NS5 ? cx - NS5 : cx;
                LAS bf16* vT = (LAS bf16*)(lds + RING_OFF);
                const bf16* Wm = (const bf16*)(P_wod + OD_SGU);
                const float* lng = INP(23) + lp * 512; const float* sb = INP(25) + lp * 512;
                const int j_ln = tid >> 2, cq = tid & 3, fr = lane & 15, fq = lane >> 4, i_pos = wave * 16 + fr;
                for (int un = wk; un < 512; un += nwk) {
                    const int nb = un >> 2, hh = un & 3;
                    v4u vraw[4];
                    { const bf16* src = P_ZUV + (size_t)(nb * 128 + j_ln) * 1024 + 512 + hh * 128 + cq * 32;
#pragma unroll
                      for (int q4 = 0; q4 < 4; ++q4) vraw[q4] = *(const GAS v4u*)(src + q4 * 8); }
                    bf16x8 wf[4];
#pragma unroll
                    for (int ks = 0; ks < 4; ++ks) wf[ks] = *(const GAS bf16x8*)(Wm + ((size_t)hh * 128 + i_pos) * 128 + ks * 32 + fq * 8);
                    const float bias = sb[hh * 128 + i_pos]; const size_t tok = (size_t)(nb * 128 + i_pos);
                    v2u uu[8];
#pragma unroll
                    for (int ct = 0; ct < 8; ++ct) uu[ct] = *(const GAS v2u*)(P_ZUV + tok * 1024 + hh * 128 + ct * 16 + fq * 4);
                    __syncthreads();
                    {
                        float v[32]; float s = 0.f;
#pragma unroll
                        for (int q4 = 0; q4 < 4; ++q4) { const v4u w = vraw[q4];
                            v[q4 * 8 + 0] = bflo(w.x); v[q4 * 8 + 1] = bfhi(w.x); v[q4 * 8 + 2] = bflo(w.y); v[q4 * 8 + 3] = bfhi(w.y);
                            v[q4 * 8 + 4] = bflo(w.z); v[q4 * 8 + 5] = bfhi(w.z); v[q4 * 8 + 6] = bflo(w.w); v[q4 * 8 + 7] = bfhi(w.w); }
#pragma unroll
                        for (int e = 0; e < 32; ++e) s += v[e];
                        s += __shfl_xor(s, 1); s += __shfl_xor(s, 2);
                        const float mu = s * (1.0f / 128.0f); float q = 0.f;
#pragma unroll
                        for (int e = 0; e < 32; ++e) { v[e] -= mu; q += v[e] * v[e]; }
                        q += __shfl_xor(q, 1); q += __shfl_xor(q, 2);
                        const float rstd = 1.0f / sqrtf(q * (1.0f / 128.0f) + 1e-5f);
#pragma unroll
                        for (int e = 0; e < 32; ++e) { const int c = cq * 32 + e; vT[c * 136 + j_ln] = (bf16)f2bf(v[e] * rstd * lng[hh * 128 + c]); }
                    }
                    __syncthreads();
                    {
                        f32x4 acc[8];
#pragma unroll
                        for (int ct = 0; ct < 8; ++ct) acc[ct] = (f32x4){0.f, 0.f, 0.f, 0.f};
#pragma unroll
                        for (int ks = 0; ks < 4; ++ks) {
#pragma unroll
                            for (int ct = 0; ct < 8; ++ct) { const bf16x8 vf = *(const LAS bf16x8*)(vT + (ct * 16 + fr) * 136 + ks * 32 + fq * 8);
                                acc[ct] = __builtin_amdgcn_mfma_f32_16x16x32_bf16(vf, wf[ks], acc[ct], 0, 0, 0); }
                        }
#pragma unroll
                        for (int ct = 0; ct < 8; ++ct) { const int c = ct * 16 + fq * 4;
                            v2u o; o.x = pk2(bflo(uu[ct].x) * (acc[ct][0] + bias), bfhi(uu[ct].x) * (acc[ct][1] + bias)); o.y = pk2(bflo(uu[ct].y) * (acc[ct][2] + bias), bfhi(uu[ct].y) * (acc[ct][3] + bias));
                            *(GAS v2u*)(P_MIX + tok * 1024 + 512 + hh * 128 + c) = o; }
                    }
                }
                __syncthreads();
            }
        }
        SEAM(pb + 6);
        if (IN(pb + 7)) {
            pg8::GDh g{P_AG, (const bf16*)(P_wod + OD_MY), 640, 640, 640, 1, (size_t)512 * 640}; pg8::Order S; S.init(64, 4, G_O, BX_O);
            pg8::EpiS5Y E{P_AG, INP(20) + lp * 512, P_GY};
            pg8::gemm_phase<pg8::EpiS5Y, pg8::Order, pg8::GDh>(lds + RING_OFF, g, S, E, wave_s);
        }
        SEAM(pb + 7);
        if (IN(pb + 8)) {
            pg8::GDh g{P_GY, (const bf16*)(P_wod + OD_GLU), 512, 512, 512, 30, 0}; pg8::Order S; S.init(M / 256, 4, G_O, BX_O);
            pg8::EpiGLU E{P_GY, INP(22) + lp * 512, P_MIX};
            pg8::gemm_phase<pg8::EpiGLU, pg8::Order, pg8::GDh>(lds + RING_OFF, g, S, E, wave_s);
        }
        SEAM(pb + 8);
        if (IN(pb + 9)) {
            pg8::GDs g{P_MIX, (const bf16*)(P_wod + OD_OOUT), D, D, D, 30, 0}; pg8::Order S; S.init(M / 256, D / 256, G_O, BX_O);
            pg8::EpiResidB<false> E{P_HB, P_SSQ, 1.0f, nullptr};
            pg8::gemm_phase<pg8::EpiResidB<false>, pg8::Order, pg8::GDs>(lds + RING_OFF, g, S, E, wave_s);
        }
        SEAM_L(pb + 9);
        for (int rep_ = 0; rep_ < REP_ROUTE; ++rep_)
        if (IN(pb + 10)) {
            PHASE_IDS
            LAS unsigned short* Bl = (LAS unsigned short*)(lds + RING_OFF);
            LAS float* Cp = (LAS float*)(lds + RING_OFF + 32768);
            const float* Wr = INP(28) + (size_t)lp * D * 8; const float* g2 = INP(27) + lp * D;
            const int fr = lane & 15, fq = lane >> 4, mt = wave & 3, kh = wave >> 2;
            __syncthreads();
#pragma unroll
            for (int kk = 0; kk < 2; ++kk) { const int k = tid * 2 + kk; const float gk = g2[k]; const f32x4 w0 = *(const f32x4*)(Wr + (size_t)k * 8), w1 = *(const f32x4*)(Wr + (size_t)k * 8 + 4);
                LAS unsigned short* dst = Bl + (size_t)(((k >> 5) * 4 + ((k >> 3) & 3)) * 16) * 8 + (k & 7);
#pragma unroll
                for (int e = 0; e < 8; ++e) { const float w = (e < 4 ? w0[e] : w1[e - 4]) * gk; const unsigned hi = f2bf(w), lo = f2bf(w - __uint_as_float(hi << 16)); dst[e * 8] = (unsigned short)hi; dst[(e + 8) * 8] = (unsigned short)lo; } }
            for (int vb = vbx; vb < 256; vb += G) {
                bf16x8 af[16];
                { const bf16* arow = P_HB + (size_t)(vb * 64 + mt * 16 + fr) * D + kh * 512 + fq * 8;
#pragma unroll
                  for (int ks = 0; ks < 16; ++ks) af[ks] = *(const GAS bf16x8*)(arow + ks * 32); }
                __syncthreads();
                f32x4 acc = {0.f, 0.f, 0.f, 0.f};
#pragma unroll
                for (int ks = 0; ks < 16; ++ks) { const bf16x8 bfr = *(const LAS bf16x8*)(Bl + (size_t)(((kh * 16 + ks) * 4 + fq) * 16 + fr) * 8);
                    acc = __builtin_amdgcn_mfma_f32_16x16x32_bf16(af[ks], bfr, acc, 0, 0, 0); }
#pragma unroll
                for (int j = 0; j < 4; ++j) Cp[(wave * 16 + 4 * fq + j) * 16 + fr] = acc[j];
                __syncthreads();
                if (wave == 0) { const int t = vb * 64 + lane; const LAS float* p0 = Cp + ((lane >> 4) * 16 + (lane & 15)) * 16; const LAS float* p1 = p0 + 4 * 256;
                    f32x4 c0[4], c1[4];
#pragma unroll
                    for (int i = 0; i < 4; ++i) { c0[i] = *(const LAS f32x4*)(p0 + 4 * i); c1[i] = *(const LAS f32x4*)(p1 + 4 * i); }
                    const f32x4 s0 = *(const f32x4*)(P_SSQ + (size_t)t * 16), s1 = *(const f32x4*)(P_SSQ + (size_t)t * 16 + 4), s2 = *(const f32x4*)(P_SSQ + (size_t)t * 16 + 8), s3 = *(const f32x4*)(P_SSQ + (size_t)t * 16 + 12);
                    const float ss = (((s0[0] + s0[1]) + (s0[2] + s0[3])) + ((s1[0] + s1[1]) + (s1[2] + s1[3]))) + (((s2[0] + s2[1]) + (s2[2] + s2[3])) + ((s3[0] + s3[1]) + (s3[2] + s3[3])));
                    const float rstd = 1.0f / sqrtf(ss * (1.0f / 1024.0f) + 1e-5f);
                    float lv[8];
#pragma unroll
                    for (int e = 0; e < 8; ++e) lv[e] = ((c0[e >> 2][e & 3] + c0[2 + (e >> 2)][e & 3]) + (c1[e >> 2][e & 3] + c1[2 + (e >> 2)][e & 3])) * rstd;
                    int e0 = 0; float v0 = lv[0];
#pragma unroll
                    for (int e = 1; e < 8; ++e) { if (lv[e] > v0) { v0 = lv[e]; e0 = e; } }
                    int e1 = -1; float v1 = 0.f;
#pragma unroll
                    for (int e = 0; e < 8; ++e) { if (e != e0 && (e1 < 0 || lv[e] > v1)) { v1 = lv[e]; e1 = e; } }
                    const float ex = __expf(v1 - v0), w0 = 1.0f / (1.0f + ex), w1 = ex * w0;
                    P_TOKE[t * 2] = e0; P_TOKE[t * 2 + 1] = e1; P_TOKW[t * 2] = w0; P_TOKW[t * 2 + 1] = w1; P_RSTD[t] = rstd;
                    int r0 = 0, r1 = 0;
#pragma unroll
                    for (int e = 0; e < 8; ++e) { const unsigned long long mk = __ballot(e0 == e || e1 == e); const int rk = __popcll(mk & ((1ull << lane) - 1ull));
                        if (e0 == e) r0 = rk; if (e1 == e) r1 = rk; if (lane == 0) P_WGCNT[vb * 8 + e] = __popcll(mk); }
                    P_TOKR[t * 2] = r0; P_TOKR[t * 2 + 1] = r1; }
            }
            __syncthreads();
        }
        SEAM(pb + 10);
        for (int rep_ = 0; rep_ < REP_ROUTE; ++rep_)
        if (IN(pb + 11)) {
            PHASE_IDS
            const bool f8 = F8_LAST && lp >= F8_FROM;
            LAS int* cntT = (LAS int*)(lds + RING_OFF);
            LAS int* pre = cntT + 32;
            __syncthreads();
            {
                const int e = wave; int s = 0;
#pragma unroll
                for (int i = 0; i < 4; ++i) s += P_WGCNT[(lane * 4 + i) * 8 + e];
#pragma unroll
                for (int o = 1; o < 64; o <<= 1) s += __shfl_xor(s, o);
                if (lane == 0) { cntT[e] = s; cntT[16 + e] = (s + 255) & ~255; }
            }
            __syncthreads();
            if (tid == 0) { int b = 0; for (int e = 0; e < 8; ++e) { cntT[8 + e] = b; b += cntT[16 + e]; } cntT[24] = b >> 8; }
            __syncthreads();
            if (bx == 0) { const int np = cntT[24];
                if (tid < MAXPAN) { int ex = 0; for (int e = 0; e < 8; ++e) if (tid * 256 >= cntT[8 + e]) ex = e; P_PANEL[tid] = tid < np ? ex : 0; }
                if (tid == 0) P_PANEL[MAXPAN] = np; }
            for (int e = bx; e < 8; e += G) {
                const int r0 = cntT[8 + e] + cntT[e], r1 = cntT[8 + e] + cntT[16 + e];
                if (tid < r1 - r0 && r0 + tid >= 128 * 256) P_ROWT[r0 + tid] = -1;
                if (f8) { for (int q = tid; q < (r1 - r0) * 64; q += 512) { const int r = r0 + (q >> 6); *(GAS v4u*)((unsigned char*)P_XS + (size_t)r * D + (q & 63) * 16) = (v4u){0u, 0u, 0u, 0u}; } }
                else { for (int q = tid; q < (r1 - r0) * 128; q += 512) { const int r = r0 + (q >> 7); *(GAS v4u*)(P_XS + (size_t)r * D + (q & 127) * 8) = (v4u){0u, 0u, 0u, 0u}; } }
            }
            for (int vb = bx; vb < 256; vb += G) {
                __syncthreads();
                {   const int e = wave; int s = 0;
#pragma unroll
                    for (int i = 0; i < 4; ++i) { const int b2 = lane * 4 + i; s += b2 < vb ? P_WGCNT[b2 * 8 + e] : 0; }
#pragma unroll
                    for (int o = 1; o < 64; o <<= 1) s += __shfl_xor(s, o);
                    if (lane == 0) pre[e] = s; }
                __syncthreads();
                int mp0 = 0, mp1 = 0; float mrs = 0.f;
                if (lane < 8) { const int t = vb * 64 + wave * 8 + lane; const int e0 = P_TOKE[t * 2], e1 = P_TOKE[t * 2 + 1];
                    mp0 = cntT[8 + e0] + pre[e0] + P_TOKR[t * 2]; mp1 = cntT[8 + e1] + pre[e1] + P_TOKR[t * 2 + 1]; mrs = P_RSTD[t];
                    P_TOKP[t * 2] = mp0; P_TOKP[t * 2 + 1] = mp1; if (mp0 >= 128 * 256) P_ROWT[mp0] = t; if (mp1 >= 128 * 256) P_ROWT[mp1] = t; }
                for (int tt = 0; tt < 8; tt += 2) {
                    const int t = vb * 64 + wave * 8 + tt;
                    const GAS v2u* hr = (const GAS v2u*)(P_HB + (size_t)t * D) + lane;
                    v2u hw2[2][4];
#pragma unroll
                    for (int q = 0; q < 2; ++q)
#pragma unroll
                        for (int j = 0; j < 4; ++j) hw2[q][j] = hr[q * 256 + 64 * j];
                    f32x4 hv2[2][4];
#pragma unroll
                    for (int q = 0; q < 2; ++q)
#pragma unroll
                        for (int j = 0; j < 4; ++j) { hv2[q][j].x = bflo(hw2[q][j].x); hv2[q][j].y = bfhi(hw2[q][j].x); hv2[q][j].z = bflo(hw2[q][j].y); hv2[q][j].w = bfhi(hw2[q][j].y); }
#pragma unroll
                    for (int q = 0; q < 2; ++q) {
                        const int p0 = __shfl(mp0, tt + q), p1 = __shfl(mp1, tt + q); const float rstd = __shfl(mrs, tt + q);
                        if (f8) { GAS unsigned* o0 = (GAS unsigned*)((unsigned char*)P_XS + (size_t)p0 * D) + lane; GAS unsigned* o1 = (GAS unsigned*)((unsigned char*)P_XS + (size_t)p1 * D) + lane;
#pragma unroll
                            for (int j = 0; j < 4; ++j) { const f32x4 hv = hv2[q][j]; const unsigned w = pg8::pk4_fp8(hv.x * rstd, hv.y * rstd, hv.z * rstd, hv.w * rstd); o0[64 * j] = w; o1[64 * j] = w; }
                        } else { GAS v2u* o0 = (GAS v2u*)(P_XS + (size_t)p0 * D) + lane; GAS v2u* o1 = (GAS v2u*)(P_XS + (size_t)p1 * D) + lane;
#pragma unroll
                            for (int j = 0; j < 4; ++j) { const f32x4 hv = hv2[q][j]; v2u w; w.x = pk2(hv.x * rstd, hv.y * rstd); w.y = pk2(hv.z * rstd, hv.w * rstd); o0[64 * j] = w; o1[64 * j] = w; } }
                    }
                }
            }
        }
        SEAM(pb + 11);
        LAS int* ptab = (LAS int*)(lds + PTAB_OFF);
        if (IN(pb + 12) || IN(pb + 13)) {
            PHASE_IDS
            __syncthreads();
            if (tid <= MAXPAN) ptab[tid] = (int)__hip_atomic_load((unsigned*)P_PANEL + tid, RLX_AGENT);
            __syncthreads();
        }
        if (IN(pb + 12)) {
            const int np = __builtin_amdgcn_readfirstlane(ptab[MAXPAN]);
            pg8::Order S; S.init(np, EXD / 128, G_O, BX_O);
            if (F8_LAST && lp >= F8_FROM) {
                pg8::GDt g{P_XS, (const bf16*)(P_wod + OD_M13), D / 2, D / 2, D / 2, (size_t)EXD * D, ptab};
                pg8::EpiSwiGLUF8<false> E{(unsigned char*)P_UM, EXD, 1.0f / F8_W13_SC, F8_UM_SC, nullptr};
                pg8::gemm_phase<pg8::EpiSwiGLUF8<false>, pg8::Order, pg8::GDt, 1>(lds + RING_OFF, g, S, E, wave_s);
            } else {
                pg8::GDt g{P_XS, (const bf16*)(P_wod + OD_M13), D, D, D, (size_t)2 * EXD * D, ptab};
                pg8::EpiSwiGLU<true> E{P_UM, EXD, nullptr};
                pg8::gemm_phase<pg8::EpiSwiGLU<true>, pg8::Order, pg8::GDt>(lds + RING_OFF, g, S, E, wave_s);
            }
        }
        SEAM(pb + 12);
        if (IN(pb + 13)) {
            const int np = __builtin_amdgcn_readfirstlane(ptab[MAXPAN]);
            if (F8_LAST && lp >= F8_FROM) {
                const float osc = 1.0f / (F8_UM_SC * F8_W2_SC);
                {   pg8::GDt g{P_UM, (const bf16*)(P_wod + OD_M2), EXD / 2, EXD / 2, EXD / 2, (size_t)D * EXD / 2, ptab}; pg8::Order S; S.init(np < 128 ? np : 128, D / 256, G_O, BX_O);
                    pg8::EpiBf16 E{P_XS, D, osc};
                    pg8::gemm_phase<pg8::EpiBf16, pg8::Order, pg8::GDt, 1>(lds + RING_OFF, g, S, E, wave_s); }
                if (np > 128) {
                    pg8::GDk g{P_UM, (const bf16*)(P_wod + OD_M2), EXD / 2, EXD / 2, 256, (size_t)D * EXD / 2, ptab, 128, 256}; pg8::Order S; S.init(np - 128, 28, G_O, BX_O);
                    pg8::EpiPartF32 E{(float*)(P_ws + WS_PART), osc};
                    pg8::gemm_phase<pg8::EpiPartF32, pg8::Order, pg8::GDk, 1>(lds + RING_OFF, g, S, E, wave_s); }
            } else {
                {
                    pg8::GDt g{P_UM, (const bf16*)(P_wod + OD_M2), EXD, EXD, EXD, (size_t)D * EXD, ptab}; pg8::Order S; S.init(np < 128 ? np : 128, D / 256, G_O, BX_O);
                    pg8::EpiBf16 E{P_XS, D, 1.0f};
                    pg8::gemm_phase<pg8::EpiBf16, pg8::Order, pg8::GDt>(lds + RING_OFF, g, S, E, wave_s); }
                if (np > 128) {
                    pg8::GDk g{P_UM, (const bf16*)(P_wod + OD_M2), EXD, EXD, 512, (size_t)D * EXD, ptab, 128, 512}; pg8::Order S; S.init(np - 128, 28, G_O, BX_O);
                    pg8::EpiPartF32 E{(float*)(P_ws + WS_PART), 1.0f};
                    pg8::gemm_phase<pg8::EpiPartF32, pg8::Order, pg8::GDk>(lds + RING_OFF, g, S, E, wave_s); }
            }
        }
        SEAM(pb + 13);
        if (IN(pb + 14)) {
            PHASE_IDS
            const int gw = bx * NWAVES + wave, NGW = G * NWAVES; const bf16* YC = P_XS; const float* fg = INP(32); const float* PART = (const float*)(P_ws + WS_PART);
            int mp0 = 0, mp1 = 0; float mw0 = 0.f, mw1 = 0.f;
            if (lane < 8 && gw + lane * NGW < M) { const int t = gw + lane * NGW; mp0 = P_TOKP[t * 2]; mp1 = P_TOKP[t * 2 + 1]; mw0 = P_TOKW[t * 2]; mw1 = P_TOKW[t * 2 + 1]; }
#define COMBINE_FIN(T, V, AV, BV, FAST, PP0, PP1, GW0, GW1) do { GAS f32x4* hr_ = (GAS f32x4*)(P_H + (size_t)(T) * D) + lane; float s_ = 0.f;   \
                if (FAST) { _Pragma("unroll") for (int j = 0; j < 4; ++j) { V[j].x += GW0 * bflo(AV[j].x) + GW1 * bflo(BV[j].x); V[j].y += GW0 * bfhi(AV[j].x) + GW1 * bfhi(BV[j].x); V[j].z += GW0 * bflo(AV[j].y) + GW1 * bflo(BV[j].y); V[j].w += GW0 * bfhi(AV[j].y) + GW1 * bfhi(BV[j].y); } } \
                else { _Pragma("unroll") for (int sl = 0; sl < 2; ++sl) { const int p_ = sl ? PP1 : PP0; const float gwt_ = sl ? GW1 : GW0; \
                        if (p_ < 128 * 256) { const GAS v2u* y_ = (const GAS v2u*)(YC + (size_t)p_ * D) + lane; \
                            _Pragma("unroll") for (int j = 0; j < 4; ++j) { const v2u a_ = y_[64 * j]; V[j].x += gwt_ * bflo(a_.x); V[j].y += gwt_ * bfhi(a_.x); V[j].z += gwt_ * bflo(a_.y); V[j].w += gwt_ * bfhi(a_.y); } } \
                        else { const int q_ = (p_ - 128 * 256) >> 8, r_ = p_ & 255; \
                            for (int ks = 0; ks < 7; ++ks) { const GAS f32x4* y_ = (const GAS f32x4*)(PART + ((size_t)(q_ * 7 + ks) * 256 + r_) * D) + lane; \
                                _Pragma("unroll") for (int j = 0; j < 4; ++j) V[j] += gwt_ * y_[64 * j]; } } } } \
                _Pragma("unroll") for (int j = 0; j < 4; ++j) s_ += (V[j].x * V[j].x + V[j].y * V[j].y) + (V[j].z * V[j].z + V[j].w * V[j].w); \
                s_ = wave_sum(s_); \
                if (lp == 1) { const float rstd_ = 1.0f / sqrtf(s_ * (1.0f / 1024.0f) + 1e-5f); \
                    _Pragma("unroll") for (int j = 0; j < 4; ++j) { const f32x4 gv_ = *((const GAS f32x4*)fg + lane + 64 * j); f32x4 o_; o_.x = V[j].x * rstd_ * gv_.x; o_.y = V[j].y * rstd_ * gv_.y; o_.z = V[j].z * rstd_ * gv_.z; o_.w = V[j].w * rstd_ * gv_.w; hr_[64 * j] = o_; } } \
                else { GAS v2u* o8_ = (GAS v2u*)(P_HB + (size_t)(T) * D) + lane; \
                    _Pragma("unroll") for (int j = 0; j < 4; ++j) { v2u w_; w_.x = pk2(V[j].x, V[j].y); w_.y = pk2(V[j].z, V[j].w); o8_[64 * j] = w_; } \
                    if (lane < 16) P_SSQ[(size_t)(T) * 16 + lane] = lane == 0 ? s_ : 0.f; } } while (0)
            for (int it = 0; it < 8; it += 2) {
                const int t0 = gw + it * NGW, t1 = t0 + NGW; if (t0 >= M) break;
                const bool ok1 = t1 < M;
                const int p00 = __shfl(mp0, it), p01 = __shfl(mp1, it), p10 = __shfl(mp0, it + 1), p11 = __shfl(mp1, it + 1);
                const float g00 = __shfl(mw0, it), g01 = __shfl(mw1, it), g10 = __shfl(mw0, it + 1), g11 = __shfl(mw1, it + 1);
                const bool fast0 = p00 < 128 * 256 && p01 < 128 * 256, fast1 = ok1 && p10 < 128 * 256 && p11 < 128 * 256;
                f32x4 v0[4], v1[4]; v2u a0[4], b0[4], a1[4], b1[4], h0w[4], h1w[4];
                const int t1c = ok1 ? t1 : t0;
                const GAS v2u* hr0 = (const GAS v2u*)(P_HB + (size_t)t0 * D) + lane; const GAS v2u* hr1 = (const GAS v2u*)(P_HB + (size_t)t1c * D) + lane;
                const GAS v2u* y00 = (const GAS v2u*)(YC + (size_t)(fast0 ? p00 : 0) * D) + lane; const GAS v2u* y01 = (const GAS v2u*)(YC + (size_t)(fast0 ? p01 : 0) * D) + lane;
                const GAS v2u* y10 = (const GAS v2u*)(YC + (size_t)(fast1 ? p10 : 0) * D) + lane; const GAS v2u* y11 = (const GAS v2u*)(YC + (size_t)(fast1 ? p11 : 0) * D) + lane;
#pragma unroll
                for (int j = 0; j < 4; ++j) { h0w[j] = hr0[64 * j]; a0[j] = y00[64 * j]; b0[j] = y01[64 * j]; }
#pragma unroll
                for (int j = 0; j < 4; ++j) { h1w[j] = hr1[64 * j]; a1[j] = y10[64 * j]; b1[j] = y11[64 * j]; }
#pragma unroll
                for (int j = 0; j < 4; ++j) { v0[j].x = bflo(h0w[j].x); v0[j].y = bfhi(h0w[j].x); v0[j].z = bflo(h0w[j].y); v0[j].w = bfhi(h0w[j].y); v1[j].x = bflo(h1w[j].x); v1[j].y = bfhi(h1w[j].x); v1[j].z = bflo(h1w[j].y); v1[j].w = bfhi(h1w[j].y); }
                if (fast0) COMBINE_FIN(t0, v0, a0, b0, true, p00, p01, g00, g01);
                if (fast1) COMBINE_FIN(t1, v1, a1, b1, true, p10, p11, g10, g11);
            }
            {
                const int nrow = (int)__hip_atomic_load((unsigned*)P_PANEL + MAXPAN, RLX_AGENT) * 256;
                for (int r = 128 * 256 + gw; r < nrow; r += NGW) {
                    const int t = __builtin_amdgcn_readfirstlane(P_ROWT[r]); if (t < 0) continue;
                    const int q0 = __builtin_amdgcn_readfirstlane(P_TOKP[t * 2]), q1 = __builtin_amdgcn_readfirstlane(P_TOKP[t * 2 + 1]);
                    if ((q0 >= 128 * 256 ? q0 : q1) != r) continue;
                    const float h0 = P_TOKW[t * 2], h1 = P_TOKW[t * 2 + 1];
                    f32x4 v[4]; v2u ax[4], bx_[4]; const GAS v2u* hrr = (const GAS v2u*)(P_HB + (size_t)t * D) + lane;
#pragma unroll
                    for (int j = 0; j < 4; ++j) { const v2u hw = hrr[64 * j]; v[j].x = bflo(hw.x); v[j].y = bfhi(hw.x); v[j].z = bflo(hw.y); v[j].w = bfhi(hw.y); ax[j] = (v2u){0u, 0u}; bx_[j] = (v2u){0u, 0u}; }
                    COMBINE_FIN(t, v, ax, bx_, false, q0, q1, h0, h1);
                }
            }
#undef COMBINE_FIN
        }
        if (lp == 0) SEAM(pb + 14);
    }
#undef IN
#undef SEAM
}

#ifndef MK_PER_PHASE
#define MK_PER_PHASE 0
#endif
extern "C" void kernel_launch(void* const* d_in, const int* in_sizes, int n_in, void* d_out, int out_size, void* d_ws, size_t ws_size, hipStream_t stream) {
    static int grid = 0;
    if (grid == 0) {
        if (n_in != 33 || out_size != M * D || ws_size < WS_END) { fprintf(stderr, "kernel_launch: unexpected shapes (n_in %d, out %d, ws %zu, need %zu)\n", n_in, out_size, ws_size, (size_t)WS_END); grid = -1; return; }
        int dev = 0, cus = 0, per_cu = 0;
        if (hipGetDevice(&dev) != hipSuccess || hipDeviceGetAttribute(&cus, hipDeviceAttributeMultiprocessorCount, dev) != hipSuccess) { grid = -1; return; }
        if (hipFuncSetAttribute((const void*)trunk_fwd, hipFuncAttributeMaxDynamicSharedMemorySize, LDS_BYTES) != hipSuccess) { fprintf(stderr, "kernel_launch: hipFuncSetAttribute failed\n"); grid = -1; return; }
        if (hipOccupancyMaxActiveBlocksPerMultiprocessor(&per_cu, (const void*)trunk_fwd, NWAVES * 64, LDS_BYTES) != hipSuccess || per_cu < 1) fprintf(stderr, "kernel_launch: occupancy query reports %d\n", per_cu);
        (void)hipGetLastError();
        grid = cus;
    }
    if (grid < 0) return;
    if (hipMemsetAsync((char*)d_ws + WS_CTL, 0, CTL_ZERO_BYTES, stream) != hipSuccess) return;
    Args a{};
    for (int i = 0; i < 33; ++i) a.in[i] = (const float*)d_in[i];
    a.out = (float*)d_out; a.ws = (unsigned char*)d_ws;
#if MK_PER_PHASE
    for (int p = 0; p < NPH; ++p) { a.ph_lo = p; a.ph_hi = p + 1; hipLaunchKernelGGL(trunk_fwd, dim3(grid), dim3(NWAVES * 64), LDS_BYTES, stream, a); }
#elif defined(PROBE_PRE_LO)
    for (int rp = 0; rp < PROBE_PRE_N; ++rp) { a.ph_lo = PROBE_PRE_LO; a.ph_hi = PROBE_PRE_HI; hipLaunchKernelGGL(trunk_fwd, dim3(grid), dim3(NWAVES * 64), LDS_BYTES, stream, a);
        (void)hipMemsetAsync((char*)d_ws + WS_CTL, 0, CTL_ZERO_BYTES, stream); }
    a.ph_lo = 0; a.ph_hi = NPH;
    hipLaunchKernelGGL(trunk_fwd, dim3(grid), dim3(NWAVES * 64), LDS_BYTES, stream, a);
#elif defined(PROBE_POST_LO)
    a.ph_lo = 0; a.ph_hi = NPH;
    hipLaunchKernelGGL(trunk_fwd, dim3(grid), dim3(NWAVES * 64), LDS_BYTES, stream, a);
    for (int rp = 0; rp < PROBE_POST_N; ++rp) { (void)hipMemsetAsync((char*)d_ws + WS_CTL, 0, CTL_ZERO_BYTES, stream);
        a.ph_lo = PROBE_POST_LO; a.ph_hi = PROBE_POST_HI; hipLaunchKernelGGL(trunk_fwd, dim3(grid), dim3(NWAVES * 64), LDS_BYTES, stream, a); }
#else
    a.ph_lo = 0; a.ph_hi = NPH;
    hipLaunchKernelGGL(trunk_fwd, dim3(grid), dim3(NWAVES * 64), LDS_BYTES, stream, a);
#endif
}
```

```cpp
#include <hip/hip_runtime.h>
#include <cstdio>
#include <cstdint>

namespace pg8 {
#define PG8_LAS __attribute__((address_space(3)))
typedef unsigned short bf16_t;
typedef short bf16x8 __attribute__((ext_vector_type(8)));
typedef float f32x4 __attribute__((ext_vector_type(4)));
typedef float f32x2 __attribute__((ext_vector_type(2)));
typedef unsigned u32x4 __attribute__((ext_vector_type(4)));
typedef unsigned u32x2 __attribute__((ext_vector_type(2)));
constexpr int BM = 256, BK = 64, HALF = 128, HTB = HALF * BK * 2  , STAGE_BYTES = 8 * HTB, NXCD = 8, WGM = 8;

__host__ __device__ __forceinline__ int lds_byte(int r, int c) { const int st = (r >> 4) * 2 + (c >> 5), rr = r & 15, cc = c & 31, ob = rr * 64 + cc * 2; return st * 1024 + (ob ^ (((ob >> 9) & 1) << 5)); }
__host__ __device__ __forceinline__ void stage_rc(int b, int& R, int& C) { const int st = b / 1024, sb = b % 1024, swz = sb ^ (((sb >> 9) & 1) << 5); R = (st >> 1) * 16 + swz / 64; C = (st & 1) * 32 + (swz % 64) / 2; }
__host__ __device__ __forceinline__ int perm32(int rho) { const int n = rho >> 4, i = rho & 15; return 8 * (i >> 2) + 4 * n + (i & 3); }

typedef int i32x4 __attribute__((ext_vector_type(4)));
typedef int i32x8 __attribute__((ext_vector_type(8)));
__device__ __forceinline__ i32x8 cat8(const bf16x8 a, const bf16x8 b) { return __builtin_shufflevector(__builtin_bit_cast(i32x4, a), __builtin_bit_cast(i32x4, b), 0, 1, 2, 3, 4, 5, 6, 7); }
__device__ __forceinline__ unsigned pk4_fp8(float a, float b, float c, float d) {
    a = __builtin_fminf(__builtin_fmaxf(a, -448.f), 448.f); b = __builtin_fminf(__builtin_fmaxf(b, -448.f), 448.f); c = __builtin_fminf(__builtin_fmaxf(c, -448.f), 448.f); d = __builtin_fminf(__builtin_fmaxf(d, -448.f), 448.f);
    int p = __builtin_amdgcn_cvt_pk_fp8_f32(a, b, 0, false); p = __builtin_amdgcn_cvt_pk_fp8_f32(c, d, p, true); return (unsigned)p;
}
struct Unit { int pm, pn, idx; };

struct Order {
    int nM, nN, nwg, G, c;
    __device__ __forceinline__ void init(int nM_, int nN_, int G_, int c_) { nM = nM_; nN = nN_; nwg = nM * nN; G = G_; c = c_; }
    __device__ __forceinline__ bool next(int i, Unit& u) const {
        const long L = (long)i * G + c; if (L >= nwg) return false;
        int wgid = (int)L; { const int q = nwg / NXCD, r = nwg % NXCD, xcd = wgid % NXCD, off = wgid / NXCD; wgid = (xcd < r ? xcd * (q + 1) : r * (q + 1) + (xcd - r) * q) + off; }
        const int nig = WGM * nN, gid = wgid / nig, fm = gid * WGM, gsz = (nM - fm) < WGM ? (nM - fm) : WGM;
        u.pm = fm + ((wgid % nig) % gsz); u.pn = (wgid % nig) / gsz; u.idx = i; return true;
    }
    __device__ __forceinline__ void a_ready(const Unit&) const {}
    __device__ __forceinline__ void done(const Unit&) const {}
};

struct GDs {
    const bf16_t* A; const bf16_t* Bt; int lda, ldb, K, gshift; size_t gstride;
    __device__ __forceinline__ const char* a_ptr(const Unit& u) const { return (const char*)(A + (size_t)u.pm * BM * lda); }
    __device__ __forceinline__ const char* b_ptr(const Unit& u) const { return (const char*)(Bt + (size_t)(u.pm >> gshift) * gstride + (size_t)u.pn * BM * ldb); }
};
struct GDh {
    const bf16_t* A; const bf16_t* Bt; int lda, ldb, K, gshift; size_t gstride;
    __device__ __forceinline__ const char* a_ptr(const Unit& u) const { return (const char*)(A + (size_t)u.pm * BM * lda); }
    __device__ __forceinline__ const char* b_ptr(const Unit& u) const { return (const char*)(Bt + (size_t)(u.pm >> gshift) * gstride + (size_t)u.pn * HALF * ldb); }
};
struct GDt {
    const bf16_t* A; const bf16_t* Bt; int lda, ldb, K; size_t gstride; const PG8_LAS int* tab;
    __device__ __forceinline__ const char* a_ptr(const Unit& u) const { return (const char*)(A + (size_t)u.pm * BM * lda); }
    __device__ __forceinline__ const char* b_ptr(const Unit& u) const { const int grp = __builtin_amdgcn_readfirstlane(tab[u.pm]); return (const char*)(Bt + (size_t)grp * gstride + (size_t)u.pn * BM * ldb); }
};

struct GDk {
    const bf16_t* A; const bf16_t* Bt; int lda, ldb, K; size_t gstride; const PG8_LAS int* tab; int pm0, ksl;
    __device__ __forceinline__ const char* a_ptr(const Unit& u) const { return (const char*)(A + (size_t)(pm0 + u.pm) * BM * lda + (size_t)(u.pn >> 2) * ksl); }
    __device__ __forceinline__ const char* b_ptr(const Unit& u) const { const int grp = __builtin_amdgcn_readfirstlane(tab[pm0 + u.pm]); return (const char*)(Bt + (size_t)grp * gstride + (size_t)(u.pn & 3) * BM * ldb + (size_t)(u.pn >> 2) * ksl); }
};

__device__ __forceinline__ unsigned cvt_pk_bf16(float lo, float hi) { unsigned r; asm volatile("v_cvt_pk_bf16_f32 %0, %1, %2" : "=v"(r) : "v"(lo), "v"(hi)); return r; }
__device__ __forceinline__ float bf_lo(unsigned w) { return __uint_as_float(w << 16); }
__device__ __forceinline__ float bf_hi(unsigned w) { return __uint_as_float(w & 0xffff0000u); }
__device__ __forceinline__ float sigmoid_f(float x) { return __builtin_amdgcn_rcpf(1.0f + __expf(-x)); }
__device__ __forceinline__ float silu_f(float x) { return x * sigmoid_f(x); }
__device__ __forceinline__ float gelu_f(float x) { const float z2 = 1.5957691216057308f * (x + 0.044715f * x * x * x); return x * sigmoid_f(z2); }

constexpr float RMS_EPS_F = 1e-5f;
__device__ __forceinline__ float row_rstd(const float* ssq, int row, int fq) {
    const f32x4 p = *(const f32x4*)(ssq + (size_t)row * 16 + 4 * fq);
    float s = (p[0] + p[1]) + (p[2] + p[3]);
    s += __shfl_xor(s, 16); s += __shfl_xor(s, 32);
    return 1.0f / sqrtf(s * (1.0f / 1024.0f) + RMS_EPS_F);
}
__device__ __forceinline__ void rows_rstd(const float* ssq, int row0, int fq, float (&rs)[2][4]) {
    f32x4 p[2][4];
#pragma unroll
    for (int ai = 0; ai < 2; ++ai)
#pragma unroll
        for (int m = 0; m < 4; ++m) p[ai][m] = *(const f32x4*)(ssq + (size_t)(row0 + ai * HALF + m * 16) * 16 + 4 * fq);
#pragma unroll
    for (int ai = 0; ai < 2; ++ai)
#pragma unroll
        for (int m = 0; m < 4; ++m) { float s = (p[ai][m][0] + p[ai][m][1]) + (p[ai][m][2] + p[ai][m][3]); s += __shfl_xor(s, 16); s += __shfl_xor(s, 32); rs[ai][m] = 1.0f / sqrtf(s * (1.0f / 1024.0f) + RMS_EPS_F); }
}
__device__ __forceinline__ void rows_rstd_lds(const PG8_LAS float* t, float (&rs)[2][4]) {
#pragma unroll
    for (int ai = 0; ai < 2; ++ai)
#pragma unroll
        for (int m = 0; m < 4; ++m) rs[ai][m] = t[ai * HALF + m * 16];
}
__device__ __forceinline__ u32x4 pack8(const f32x4& a, const f32x4& b) { u32x4 w; w.x = cvt_pk_bf16(a[0], a[1]); w.y = cvt_pk_bf16(a[2], a[3]); w.z = cvt_pk_bf16(b[0], b[1]); w.w = cvt_pk_bf16(b[2], b[3]); return w; }

struct EpiScaleBf16 {
    static constexpr bool PERM = true, AFTER_DRAIN = false;
    bf16_t* O; int ldc; const PG8_LAS float* rst;
    __device__ __forceinline__ void operator()(const f32x4 (&acc)[2][2][4][2], const Unit& u, int wr, int wc, int fr, int fq) const {
        const int row0 = u.pm * BM + wr * 64 + fr, col0 = u.pn * BM + wc * 32 + 8 * fq;
        float rsv[2][4]; rows_rstd_lds(rst + u.idx * 256 + wr * 64 + fr, rsv);
#pragma unroll
        for (int ai = 0; ai < 2; ++ai)
#pragma unroll
            for (int m = 0; m < 4; ++m) { const int row = row0 + ai * HALF + m * 16; const float rs = rsv[ai][m]; bf16_t* rowp = O + (size_t)row * ldc + col0;
#pragma unroll
                for (int bj = 0; bj < 2; ++bj) *(u32x4*)(rowp + bj * HALF) = pack8(acc[ai][bj][m][0] * rs, acc[ai][bj][m][1] * rs); }
    }
};
template <bool SCALED> struct EpiResid {
    static constexpr bool PERM = false, AFTER_DRAIN = false;
    const float* resid; float* H; bf16_t* HB; float* ssq; float sc; unsigned char* H8;
    __device__ __forceinline__ void operator()(const f32x4 (&acc)[2][2][4][2], const Unit& u, int wr, int wc, int fr, int fq) const {
        const int row0 = u.pm * BM + wr * 64 + fr, col0 = u.pn * BM + wc * 32 + 4 * fq;
#pragma unroll
        for (int ai = 0; ai < 2; ++ai)
#pragma unroll
            for (int m = 0; m < 4; ++m) { const int row = row0 + ai * HALF + m * 16; const size_t off = (size_t)row * 1024 + col0; float q = 0.f;
#pragma unroll
                for (int bj = 0; bj < 2; ++bj)
#pragma unroll
                    for (int n = 0; n < 2; ++n) { const f32x4 bs = *(const f32x4*)(resid + off + bj * HALF + n * 16); f32x4 o; if (SCALED) { const f32x4 a4 = acc[ai][bj][m][n]; o[0] = __builtin_fmaf(a4[0], sc, bs[0]); o[1] = __builtin_fmaf(a4[1], sc, bs[1]); o[2] = __builtin_fmaf(a4[2], sc, bs[2]); o[3] = __builtin_fmaf(a4[3], sc, bs[3]); } else o = bs + acc[ai][bj][m][n];
                        *(f32x4*)(H + off + bj * HALF + n * 16) = o;
                        if (HB) { u32x2 w; w.x = cvt_pk_bf16(o[0], o[1]); w.y = cvt_pk_bf16(o[2], o[3]); *(u32x2*)(HB + off + bj * HALF + n * 16) = w; q += (o[0] * o[0] + o[1] * o[1]) + (o[2] * o[2] + o[3] * o[3]); }
                        if (H8) *(unsigned*)(H8 + off + bj * HALF + n * 16) = pk4_fp8(o[0], o[1], o[2], o[3]); }
                if (HB) { q += __shfl_xor(q, 16); q += __shfl_xor(q, 32); if (fq == 0) ssq[(size_t)row * 16 + u.pn * 4 + wc] = q; }
                asm volatile("" ::: "memory"); }
    }
};
template <bool SCALED> struct EpiResidB {
    static constexpr bool PERM = true, AFTER_DRAIN = false;
    bf16_t* HB; float* ssq; float sc; unsigned char* H8;
    __device__ __forceinline__ void operator()(const f32x4 (&acc)[2][2][4][2], const Unit& u, int wr, int wc, int fr, int fq) const {
        const int row0 = u.pm * BM + wr * 64 + fr, col0 = u.pn * BM + wc * 32 + 8 * fq;
        u32x4 rs[2][2][2];
#define PG8_RLOAD(P, B) do { _Pragma("unroll") for (int g_ = 0; g_ < 2; ++g_) { const int gi_ = 2 * (P) + g_; \
            _Pragma("unroll") for (int bj = 0; bj < 2; ++bj) rs[B][g_][bj] = *(const u32x4*)(HB + (size_t)(row0 + (gi_ >> 2) * HALF + (gi_ & 3) * 16) * 1024 + col0 + bj * HALF); } } while (0)
        PG8_RLOAD(0, 0);
#pragma unroll
        for (int p = 0; p < 4; ++p) {
            if (p < 3) PG8_RLOAD(p + 1, (p + 1) & 1);
            asm volatile("" ::: "memory");
#pragma unroll
            for (int g = 0; g < 2; ++g) { const int gi = 2 * p + g, ai = gi >> 2, m = gi & 3; const int row = row0 + ai * HALF + m * 16; const size_t off = (size_t)row * 1024 + col0; float q = 0.f;
#pragma unroll
                for (int bj = 0; bj < 2; ++bj) { const u32x4 r = rs[p & 1][g][bj]; const f32x4 a0 = acc[ai][bj][m][0], a1 = acc[ai][bj][m][1]; f32x4 o0, o1;
                    if (SCALED) { o0[0] = __builtin_fmaf(a0[0], sc, bf_lo(r.x)); o0[1] = __builtin_fmaf(a0[1], sc, bf_hi(r.x)); o0[2] = __builtin_fmaf(a0[2], sc, bf_lo(r.y)); o0[3] = __builtin_fmaf(a0[3], sc, bf_hi(r.y));
                        o1[0] = __builtin_fmaf(a1[0], sc, bf_lo(r.z)); o1[1] = __builtin_fmaf(a1[1], sc, bf_hi(r.z)); o1[2] = __builtin_fmaf(a1[2], sc, bf_lo(r.w)); o1[3] = __builtin_fmaf(a1[3], sc, bf_hi(r.w)); }
                    else { o0[0] = a0[0] + bf_lo(r.x); o0[1] = a0[1] + bf_hi(r.x); o0[2] = a0[2] + bf_lo(r.y); o0[3] = a0[3] + bf_hi(r.y); o1[0] = a1[0] + bf_lo(r.z); o1[1] = a1[1] + bf_hi(r.z); o1[2] = a1[2] + bf_lo(r.w); o1[3] = a1[3] + bf_hi(r.w); }
                    *(u32x4*)(HB + off + bj * HALF) = pack8(o0, o1);
                    q += ((o0[0] * o0[0] + o0[1] * o0[1]) + (o0[2] * o0[2] + o0[3] * o0[3])) + ((o1[0] * o1[0] + o1[1] * o1[1]) + (o1[2] * o1[2] + o1[3] * o1[3]));
                    if (H8) { u32x2 w; w.x = pk4_fp8(o0[0], o0[1], o0[2], o0[3]); w.y = pk4_fp8(o1[0], o1[1], o1[2], o1[3]); *(u32x2*)(H8 + off + bj * HALF) = w; } }
                q += __shfl_xor(q, 16); q += __shfl_xor(q, 32); if (fq == 0) ssq[(size_t)row * 16 + u.pn * 4 + wc] = q; }
            asm volatile("" ::: "memory");
        }
#undef PG8_RLOAD
    }
};
__device__ __forceinline__ f32x2 swiglu2(const f32x2 g, const f32x2 u, const float c1, const float c2) {
    const f32x2 t = g * c1; f32x2 e; e.x = __builtin_amdgcn_exp2f(t.x); e.y = __builtin_amdgcn_exp2f(t.y);
    const f32x2 d = e + 1.0f; f32x2 r; r.x = __builtin_amdgcn_rcpf(d.x); r.y = __builtin_amdgcn_rcpf(d.y);
    return ((g * u) * r) * c2;
}
template <bool MOE> struct EpiSwiGLU {
    static constexpr bool PERM = true, AFTER_DRAIN = false;
    bf16_t* U; int ldc; const PG8_LAS float* rst;
    __device__ __forceinline__ void operator()(const f32x4 (&acc)[2][2][4][2], const Unit& u, int wr, int wc, int fr, int fq) const {
        const int row0 = u.pm * BM + wr * 64 + fr, col0 = u.pn * HALF + wc * 32 + 8 * fq;
        float rsv[2][4];
        if (!MOE) rows_rstd_lds(rst + u.idx * 256 + wr * 64 + fr, rsv);
#pragma unroll
        for (int ai = 0; ai < 2; ++ai)
#pragma unroll
            for (int m = 0; m < 4; ++m) { const int row = row0 + ai * HALF + m * 16;
                const float rs = MOE ? 1.0f : rsv[ai][m], c1 = rs * -1.4426950408889634f, c2 = rs * rs;
                const f32x4 g0 = acc[ai][0][m][0], g1 = acc[ai][0][m][1], u0 = acc[ai][1][m][0], u1 = acc[ai][1][m][1];
                const f32x2 a = swiglu2((f32x2){g0[0], g0[1]}, (f32x2){u0[0], u0[1]}, c1, c2), b = swiglu2((f32x2){g0[2], g0[3]}, (f32x2){u0[2], u0[3]}, c1, c2);
                const f32x2 c = swiglu2((f32x2){g1[0], g1[1]}, (f32x2){u1[0], u1[1]}, c1, c2), d = swiglu2((f32x2){g1[2], g1[3]}, (f32x2){u1[2], u1[3]}, c1, c2);
                u32x4 w; w.x = cvt_pk_bf16(a.x, a.y); w.y = cvt_pk_bf16(b.x, b.y); w.z = cvt_pk_bf16(c.x, c.y); w.w = cvt_pk_bf16(d.x, d.y);
                *(u32x4*)(U + (size_t)row * ldc + col0) = w; }
    }
};
__device__ __forceinline__ unsigned pk4_fp8v(const f32x2 a, const f32x2 b) {
    const float a0 = __builtin_amdgcn_fmed3f(a.x, -448.f, 448.f), a1 = __builtin_amdgcn_fmed3f(a.y, -448.f, 448.f), b0 = __builtin_amdgcn_fmed3f(b.x, -448.f, 448.f), b1 = __builtin_amdgcn_fmed3f(b.y, -448.f, 448.f);
    int p = __builtin_amdgcn_cvt_pk_fp8_f32(a0, a1, 0, false); p = __builtin_amdgcn_cvt_pk_fp8_f32(b0, b1, p, true); return (unsigned)p;
}
template <bool RS> struct EpiSwiGLUF8 {
    static constexpr bool PERM = true, AFTER_DRAIN = false;
    unsigned char* U; int ldc; float isc, osc; const PG8_LAS float* rst;
    __device__ __forceinline__ void operator()(const f32x4 (&acc)[2][2][4][2], const Unit& u, int wr, int wc, int fr, int fq) const {
        const int row0 = u.pm * BM + wr * 64 + fr, col0 = u.pn * HALF + wc * 32 + 8 * fq;
        float rsv[2][4];
        if (RS) rows_rstd_lds(rst + u.idx * 256 + wr * 64 + fr, rsv);
#pragma unroll
        for (int ai = 0; ai < 2; ++ai)
#pragma unroll
            for (int m = 0; m < 4; ++m) { const int row = row0 + ai * HALF + m * 16; const float is = RS ? isc * rsv[ai][m] : isc, c1 = is * -1.4426950408889634f, c2 = is * is * osc;
                const f32x4 g0 = acc[ai][0][m][0], g1 = acc[ai][0][m][1], u0 = acc[ai][1][m][0], u1 = acc[ai][1][m][1];
                const f32x2 a = swiglu2((f32x2){g0[0], g0[1]}, (f32x2){u0[0], u0[1]}, c1, c2), b = swiglu2((f32x2){g0[2], g0[3]}, (f32x2){u0[2], u0[3]}, c1, c2);
                const f32x2 c = swiglu2((f32x2){g1[0], g1[1]}, (f32x2){u1[0], u1[1]}, c1, c2), d = swiglu2((f32x2){g1[2], g1[3]}, (f32x2){u1[2], u1[3]}, c1, c2);
                u32x2 w; w.x = pk4_fp8v(a, b); w.y = pk4_fp8v(c, d);
                *(u32x2*)(U + (size_t)row * ldc + col0) = w; }
    }
};
struct EpiOddIn {
    static constexpr bool PERM = true, AFTER_DRAIN = false;
    bf16_t* AG; bf16_t* ZUV; const PG8_LAS float* rst;
    __device__ __forceinline__ void operator()(const f32x4 (&acc)[2][2][4][2], const Unit& u, int wr, int wc, int fr, int fq) const {
        const int row0 = u.pm * BM + wr * 64 + fr;
        float rsv[2][4]; rows_rstd_lds(rst + u.idx * 256 + wr * 64 + fr, rsv);
#pragma unroll
        for (int ai = 0; ai < 2; ++ai)
#pragma unroll
            for (int m = 0; m < 4; ++m) { const int row = row0 + ai * HALF + m * 16; const float rs = rsv[ai][m];
#pragma unroll
                for (int bj = 0; bj < 2; ++bj) { f32x4 v0 = acc[ai][bj][m][0] * rs, v1 = acc[ai][bj][m][1] * rs;
                    if (u.pn < 2) { const int cc = u.pn * BM + bj * HALF + wc * 32 + 8 * fq, g = cc >> 4, h0 = cc & 15;
                        *(u32x4*)(AG + ((size_t)g * 512 + (row >> 5)) * 640 + 128 + (row & 31) * 16 + h0) = pack8(v0, v1); }
                    else { const int cc = (u.pn - 2) * BM + bj * HALF + wc * 32 + 8 * fq;
#pragma unroll
                        for (int j = 0; j < 4; ++j) { v0[j] = gelu_f(v0[j]); v1[j] = gelu_f(v1[j]); }
                        *(u32x4*)(ZUV + (size_t)row * 1024 + cc) = pack8(v0, v1); } } }
    }
};
struct EpiS5Scan {
    static constexpr bool PERM = false, AFTER_DRAIN = true;
    bf16_t* AG; const float* AT;
    __device__ __forceinline__ void operator()(const f32x4 (&)[2][2][4][2], const Unit&, int, int, int, int) const {}
    __device__ __forceinline__ void fused(const f32x4 (&acc)[2][2][4][2], const Unit& u, int wr, int wc, int fr, int fq, PG8_LAS unsigned char* lds, int wid, int lane) const {
#pragma unroll
        for (int ai = 0; ai < 2; ++ai)
#pragma unroll
            for (int m = 0; m < 4; ++m) { const int r = ai * HALF + wr * 64 + m * 16 + fr;
#pragma unroll
                for (int n = 0; n < 2; ++n) { const int gq = (wc * 32 + n * 16 + 4 * fq) >> 2; *(PG8_LAS f32x4*)(lds + r * 512 + ((gq ^ (r & 15)) << 4)) = acc[ai][0][m][n]; } }
        asm volatile("s_waitcnt lgkmcnt(0)" ::: "memory"); __builtin_amdgcn_s_barrier(); asm volatile("" ::: "memory");
        {   const int g = u.pm >> 1, p = lane, cb = wid * 32;
            const float ar = AT[(g * 64 + p) * 2], ai_ = AT[(g * 64 + p) * 2 + 1];
            const int g0 = p >> 2, g1 = (64 + p) >> 2, sub = (p & 3) << 2;
            PG8_LAS float* segT = (PG8_LAS float*)(lds + 131072 + 2048);
            float tr = 0.f, ti = 0.f;
            for (int c0 = cb; c0 < cb + 32; c0 += 8) { float sr[8], si[8];
#pragma unroll
                for (int e = 0; e < 8; ++e) { const int c = c0 + e; sr[e] = *(const PG8_LAS float*)(lds + c * 512 + ((g0 ^ (c & 15)) << 4) + sub); si[e] = *(const PG8_LAS float*)(lds + c * 512 + ((g1 ^ (c & 15)) << 4) + sub); }
#pragma unroll
                for (int e = 0; e < 8; ++e) { const float nr = ar * tr - ai_ * ti + sr[e], ni = ar * ti + ai_ * tr + si[e]; tr = nr; ti = ni; } }
            segT[(wid * 64 + p) * 2] = tr; segT[(wid * 64 + p) * 2 + 1] = ti;
            float pr = ar, pi = ai_;
#pragma unroll
            for (int q = 0; q < 5; ++q) { const float nr = pr * pr - pi * pi, ni = 2.0f * pr * pi; pr = nr; pi = ni; }
            asm volatile("s_waitcnt lgkmcnt(0)" ::: "memory"); __builtin_amdgcn_s_barrier(); asm volatile("" ::: "memory");
            float hr = 0.f, hi = 0.f;
            for (int w = 0; w < wid; ++w) { const float sr_ = segT[(w * 64 + p) * 2], si_ = segT[(w * 64 + p) * 2 + 1]; const float nr = pr * hr - pi * hi + sr_, ni = pr * hi + pi * hr + si_; hr = nr; hi = ni; }
            bf16_t* ap = AG + (size_t)u.pm * BM * 640 + p;
            for (int c0 = cb; c0 < cb + 32; c0 += 8) { float sr[8], si[8];
#pragma unroll
                for (int e = 0; e < 8; ++e) { const int c = c0 + e; sr[e] = *(const PG8_LAS float*)(lds + c * 512 + ((g0 ^ (c & 15)) << 4) + sub); si[e] = *(const PG8_LAS float*)(lds + c * 512 + ((g1 ^ (c & 15)) << 4) + sub); }
#pragma unroll
                for (int e = 0; e < 8; ++e) { const unsigned w = cvt_pk_bf16(hr, hi); ap[(size_t)(c0 + e) * 640] = (bf16_t)(w & 0xffffu); ap[(size_t)(c0 + e) * 640 + 64] = (bf16_t)(w >> 16);
                    const float nr = ar * hr - ai_ * hi + sr[e], ni = ar * hi + ai_ * hr + si[e]; hr = nr; hi = ni; } }
        }
    }
};
struct EpiS5Y {
    static constexpr bool PERM = true, AFTER_DRAIN = false;
    const bf16_t* AG; const float* dskip; bf16_t* GY;
    __device__ __forceinline__ void operator()(const f32x4 (&acc)[2][2][4][2], const Unit& u, int wr, int wc, int fr, int fq) const {
        const int row0 = u.pm * BM + wr * 64 + fr, g = u.pm >> 1;
        const int n0 = u.pn * HALF + wc * 32 + 8 * fq, jl = n0 >> 4, h0 = n0 & 15;
        const f32x4 d0 = *(const f32x4*)(dskip + g * 16 + h0), d1 = *(const f32x4*)(dskip + g * 16 + h0 + 4);
#pragma unroll
        for (int ai = 0; ai < 2; ++ai)
#pragma unroll
            for (int m = 0; m < 4; ++m) { const int row = row0 + ai * HALF + m * 16;
                const u32x4 uu = *(const u32x4*)(AG + (size_t)row * 640 + 128 + n0);
                f32x4 y0 = acc[ai][0][m][0], y1 = acc[ai][0][m][1];
                y0[0] += d0[0] * bf_lo(uu.x); y0[1] += d0[1] * bf_hi(uu.x); y0[2] += d0[2] * bf_lo(uu.y); y0[3] += d0[3] * bf_hi(uu.y);
                y1[0] += d1[0] * bf_lo(uu.z); y1[1] += d1[1] * bf_hi(uu.z); y1[2] += d1[2] * bf_lo(uu.w); y1[3] += d1[3] * bf_hi(uu.w);
#pragma unroll
                for (int j = 0; j < 4; ++j) { y0[j] = gelu_f(y0[j]); y1[j] = gelu_f(y1[j]); }
                const int chunk = row & 511, token = chunk * 32 + jl;
                *(u32x4*)(GY + (size_t)token * 512 + g * 16 + h0) = pack8(y0, y1); }
    }
};
struct EpiGLU {
    static constexpr bool PERM = true, AFTER_DRAIN = false;
    const bf16_t* GY; const float* bias; bf16_t* MIX;
    __device__ __forceinline__ void operator()(const f32x4 (&acc)[2][2][4][2], const Unit& u, int wr, int wc, int fr, int fq) const {
        const int row0 = u.pm * BM + wr * 64 + fr, c0 = u.pn * HALF + wc * 32 + 8 * fq;
        const f32x4 b0 = *(const f32x4*)(bias + c0), b1 = *(const f32x4*)(bias + c0 + 4);
#pragma unroll
        for (int ai = 0; ai < 2; ++ai)
#pragma unroll
            for (int m = 0; m < 4; ++m) { const int row = row0 + ai * HALF + m * 16;
                const u32x4 gg = *(const u32x4*)(GY + (size_t)row * 512 + c0);
                const f32x4 a0 = acc[ai][0][m][0] + b0, a1 = acc[ai][0][m][1] + b1; f32x4 o0, o1;
                o0[0] = bf_lo(gg.x) * sigmoid_f(a0[0]); o0[1] = bf_hi(gg.x) * sigmoid_f(a0[1]); o0[2] = bf_lo(gg.y) * sigmoid_f(a0[2]); o0[3] = bf_hi(gg.y) * sigmoid_f(a0[3]);
                o1[0] = bf_lo(gg.z) * sigmoid_f(a1[0]); o1[1] = bf_hi(gg.z) * sigmoid_f(a1[1]); o1[2] = bf_lo(gg.w) * sigmoid_f(a1[2]); o1[3] = bf_hi(gg.w) * sigmoid_f(a1[3]);
                *(u32x4*)(MIX + (size_t)row * 1024 + c0) = pack8(o0, o1); }
    }
};
struct EpiBf16 {
    static constexpr bool PERM = true, AFTER_DRAIN = false;
    bf16_t* O; int ldc; float sc;
    __device__ __forceinline__ void operator()(const f32x4 (&acc)[2][2][4][2], const Unit& u, int wr, int wc, int fr, int fq) const {
        const int row0 = u.pm * BM + wr * 64 + fr, col0 = u.pn * BM + wc * 32 + 8 * fq;
#pragma unroll
        for (int ai = 0; ai < 2; ++ai)
#pragma unroll
            for (int m = 0; m < 4; ++m) { bf16_t* rowp = O + (size_t)(row0 + ai * HALF + m * 16) * ldc + col0;
#pragma unroll
                for (int bj = 0; bj < 2; ++bj) *(u32x4*)(rowp + bj * HALF) = pack8(acc[ai][bj][m][0] * sc, acc[ai][bj][m][1] * sc); }
    }
};

struct EpiPartF32 {
    static constexpr bool PERM = false, AFTER_DRAIN = false;
    float* P; float sc;
    __device__ __forceinline__ void operator()(const f32x4 (&acc)[2][2][4][2], const Unit& u, int wr, int wc, int fr, int fq) const {
        float* base = P + ((size_t)(u.pm * 7 + (u.pn >> 2)) * 256 + wr * 64 + fr) * 1024 + (u.pn & 3) * BM + wc * 32 + 4 * fq;
#pragma unroll
        for (int ai = 0; ai < 2; ++ai)
#pragma unroll
            for (int m = 0; m < 4; ++m) { float* rowp = base + (size_t)(ai * HALF + m * 16) * 1024;
#pragma unroll
                for (int bj = 0; bj < 2; ++bj)
#pragma unroll
                    for (int n = 0; n < 2; ++n) *(f32x4*)(rowp + bj * HALF + n * 16) = acc[ai][bj][m][n] * sc; }
    }
};

template <class Epi, class Sched, class GD, int MMODE = 0, bool ALIGN_EPI = true, bool SP2 = true>
__device__ __forceinline__ void gemm_phase(PG8_LAS unsigned char* lds, const GD& g, const Sched& S, const Epi& E, const int wid) {
    int lane_o; asm volatile("v_mbcnt_lo_u32_b32 %0, -1, 0\n\tv_mbcnt_hi_u32_b32 %0, -1, %0" : "=v"(lane_o));
    const int lane = lane_o, tid = wid * 64 + lane, wr = wid >> 2, wc = wid & 3, fr = lane & 15, fq = lane >> 4;
    const int K = g.K, nt = K / BK, lda = g.lda, ldb = g.ldb;
    unsigned voffA[2], voffB[2];
#pragma unroll
    for (int i = 0; i < 2; ++i) { int R, C; stage_rc(tid * 16 + i * 8192, R, C); const int Rb = Epi::PERM ? ((R & ~31) + perm32(R & 31)) : R;
        voffA[i] = (unsigned)(R * lda + C) * 2u; voffB[i] = (unsigned)(Rb * ldb + C) * 2u; }
    const size_t kstep = (size_t)(BK * 2);
    const size_t hstepA = (size_t)HALF * lda * 2, hstepB = (size_t)HALF * ldb * 2;
    const unsigned ldsw = (unsigned)wid * 1024u;
    const int aoff = lds_byte(wr * 64 + fr, fq * 8), boff = lds_byte(wc * 32 + fr, fq * 8);
#define PG8_SA(b, h) (((b) * 2 + (h)) * HTB)
#define PG8_SB(b, h) ((4 + (b) * 2 + (h)) * HTB)
#define PG8_STAGE(bufoff, gbase, voff) do { _Pragma("unroll") for (int _i = 0; _i < 2; ++_i) \
        __builtin_amdgcn_global_load_lds((const unsigned*)((const char*)(gbase) + (voff)[_i]), (PG8_LAS unsigned*)(lds + (bufoff) + ldsw + _i * 8192), 16, 0, 0); } while (0)
#define PG8_LDA(dst, b, h) do { if constexpr (MMODE == 0) { _Pragma("unroll") for (int m = 0; m < 4; ++m) _Pragma("unroll") for (int k = 0; k < 2; ++k) dst[m][k] = *(const PG8_LAS bf16x8*)(lds + PG8_SA(b, h) + aoff + m * 2048 + k * 1024); } \
        else { _Pragma("unroll") for (int m = 0; m < 4; ++m) dst##8[m] = cat8(*(const PG8_LAS bf16x8*)(lds + PG8_SA(b, h) + aoff + m * 2048), *(const PG8_LAS bf16x8*)(lds + PG8_SA(b, h) + aoff + m * 2048 + 1024)); } } while (0)
#define PG8_LDB(dst, b, h) do { if constexpr (MMODE == 0) { _Pragma("unroll") for (int n = 0; n < 2; ++n) _Pragma("unroll") for (int k = 0; k < 2; ++k) dst[n][k] = *(const PG8_LAS bf16x8*)(lds + PG8_SB(b, h) + boff + n * 2048 + k * 1024); } \
        else { _Pragma("unroll") for (int n = 0; n < 2; ++n) dst##8[n] = cat8(*(const PG8_LAS bf16x8*)(lds + PG8_SB(b, h) + boff + n * 2048), *(const PG8_LAS bf16x8*)(lds + PG8_SB(b, h) + boff + n * 2048 + 1024)); } } while (0)
#define PG8_MMA(ai, bj, At, Bt) do { __builtin_amdgcn_s_setprio(1); \
        if constexpr (MMODE == 0) { _Pragma("unroll") for (int m = 0; m < 4; ++m) _Pragma("unroll") for (int n = 0; n < 2; ++n) _Pragma("unroll") for (int k = 0; k < 2; ++k) \
            acc[ai][bj][m][n] = __builtin_amdgcn_mfma_f32_16x16x32_bf16(Bt[n][k], At[m][k], acc[ai][bj][m][n], 0, 0, 0); } \
        else { asm volatile("s_nop 1"); _Pragma("unroll") for (int m = 0; m < 4; ++m) _Pragma("unroll") for (int n = 0; n < 2; ++n) \
            asm volatile("v_mfma_scale_f32_16x16x128_f8f6f4 %0, %1, %2, %0, %3, %3 op_sel_hi:[0,0,0]" : "+v"(acc[ai][bj][m][n]) : "v"(Bt##8[n]), "v"(At##8[m]), "v"(f8one)); } \
        __builtin_amdgcn_s_setprio(0); } while (0)
#define PG8_WAIT_V(n) asm volatile("s_waitcnt vmcnt(" #n ")" ::: "memory")
#define PG8_WAIT_L(n) asm volatile("s_waitcnt lgkmcnt(" #n ")" ::: "memory")
#define PG8_BAR __builtin_amdgcn_s_barrier()
#define PG8_SCHED __builtin_amdgcn_sched_barrier(0)
    Unit cur, nxt; int ui = 0;
    if (!S.next(0, cur)) return;
    f32x4 acc[2][2][4][2];
#pragma unroll
    for (int a = 0; a < 2; ++a)
#pragma unroll
        for (int b = 0; b < 2; ++b)
#pragma unroll
            for (int m = 0; m < 4; ++m)
#pragma unroll
                for (int n = 0; n < 2; ++n) acc[a][b][m][n] = (f32x4){0.f, 0.f, 0.f, 0.f};
    const int f8one = 0x7f7f7f7f;
    bf16x8 At[4][2], B0[2][2], B1[2][2]; i32x8 At8[4], B08[2], B18[2];
    const char* cA = g.a_ptr(cur); const char* cB = g.b_ptr(cur);
    S.a_ready(cur);
    if constexpr (SP2) {
        PG8_STAGE(PG8_SB(0, 0), cB, voffB); PG8_STAGE(PG8_SB(0, 1), cB + hstepB, voffB); PG8_STAGE(PG8_SA(0, 0), cA, voffA); PG8_STAGE(PG8_SA(0, 1), cA + hstepA, voffA);
        if (wr == 1) PG8_BAR;
        PG8_WAIT_V(2); PG8_BAR;
        PG8_STAGE(PG8_SB(1, 0), cB + kstep, voffB); PG8_STAGE(PG8_SA(1, 0), cA + kstep, voffA); PG8_STAGE(PG8_SB(1, 1), cB + hstepB + kstep, voffB);
        PG8_WAIT_V(6); PG8_BAR;
    } else {
        PG8_STAGE(PG8_SB(0, 0), cB, voffB); PG8_STAGE(PG8_SA(0, 0), cA, voffA); PG8_STAGE(PG8_SB(0, 1), cB + hstepB, voffB); PG8_STAGE(PG8_SA(0, 1), cA + hstepA, voffA);
        if (wr == 1) PG8_BAR;
        PG8_WAIT_V(4); PG8_BAR;
        PG8_STAGE(PG8_SB(1, 0), cB + kstep, voffB); PG8_STAGE(PG8_SA(1, 0), cA + kstep, voffA); PG8_STAGE(PG8_SB(1, 1), cB + hstepB + kstep, voffB);
        PG8_WAIT_V(6); PG8_BAR;
    }
    for (;;) {
        const bool has_next = S.next(ui + 1, nxt);
        const char* nA = has_next ? g.a_ptr(nxt) : cA; const char* nB = has_next ? g.b_ptr(nxt) : cB;
        for (int t = 0; t < nt; t += 2) {
            const bool last = (t == nt - 2);
            const char* a1 = cA + (size_t)(t + 1) * kstep;
            const char* a2 = last ? nA : cA + (size_t)(t + 2) * kstep; const char* b2 = last ? nB : cB + (size_t)(t + 2) * kstep;
            const char* a3 = a2 + kstep; const char* b3 = b2 + kstep;
            if (last && has_next) S.a_ready(nxt);
            if constexpr (SP2) {
            PG8_LDB(B0, 0, 0); PG8_LDB(B1, 0, 1); PG8_SCHED; PG8_LDA(At, 0, 0); PG8_STAGE(PG8_SA(1, 1), a1 + hstepA, voffA);
            PG8_WAIT_V(8); PG8_WAIT_L(0); PG8_BAR; PG8_MMA(0, 0, At, B0); PG8_MMA(0, 1, At, B1); PG8_BAR; PG8_SCHED;
            PG8_LDA(At, 0, 1); PG8_STAGE(PG8_SB(0, 0), b2, voffB); PG8_STAGE(PG8_SB(0, 1), b2 + hstepB, voffB); PG8_STAGE(PG8_SA(0, 0), a2, voffA);
            PG8_WAIT_V(8); PG8_WAIT_L(0); PG8_BAR; PG8_MMA(1, 0, At, B0); PG8_MMA(1, 1, At, B1); PG8_BAR; PG8_SCHED;
            PG8_LDB(B0, 1, 0); PG8_LDB(B1, 1, 1); PG8_SCHED; PG8_LDA(At, 1, 0); PG8_STAGE(PG8_SA(0, 1), a2 + hstepA, voffA);
            PG8_WAIT_V(8); PG8_WAIT_L(0); PG8_BAR; PG8_MMA(0, 0, At, B0); PG8_MMA(0, 1, At, B1); PG8_BAR; PG8_SCHED;
            PG8_LDA(At, 1, 1); PG8_STAGE(PG8_SB(1, 0), b3, voffB); PG8_STAGE(PG8_SB(1, 1), b3 + hstepB, voffB); PG8_STAGE(PG8_SA(1, 0), a3, voffA);
            PG8_WAIT_V(8); PG8_WAIT_L(0); PG8_BAR; PG8_MMA(1, 0, At, B0); PG8_MMA(1, 1, At, B1); PG8_BAR; PG8_SCHED;
            } else {
            PG8_LDB(B0, 0, 0); PG8_SCHED; PG8_LDA(At, 0, 0); PG8_STAGE(PG8_SA(1, 1), a1 + hstepA, voffA);
            PG8_WAIT_L(8); PG8_BAR; PG8_WAIT_L(0); PG8_MMA(0, 0, At, B0); PG8_BAR; PG8_SCHED;
            PG8_LDB(B1, 0, 1); PG8_STAGE(PG8_SB(0, 0), b2, voffB);
            PG8_BAR; PG8_WAIT_L(0); PG8_MMA(0, 1, At, B1); PG8_BAR;
            PG8_LDA(At, 0, 1); PG8_STAGE(PG8_SA(0, 0), a2, voffA);
            PG8_BAR; PG8_WAIT_L(0); PG8_MMA(1, 0, At, B0); PG8_BAR; PG8_SCHED;
            PG8_STAGE(PG8_SB(0, 1), b2 + hstepB, voffB);
            PG8_WAIT_V(6); PG8_BAR; PG8_MMA(1, 1, At, B1); PG8_BAR;
            PG8_LDB(B0, 1, 0); PG8_SCHED; PG8_LDA(At, 1, 0); PG8_STAGE(PG8_SA(0, 1), a2 + hstepA, voffA);
            PG8_WAIT_L(8); PG8_BAR; PG8_WAIT_L(0); PG8_MMA(0, 0, At, B0); PG8_BAR; PG8_SCHED;
            PG8_LDB(B1, 1, 1); PG8_STAGE(PG8_SB(1, 0), b3, voffB);
            PG8_BAR; PG8_WAIT_L(0); PG8_MMA(0, 1, At, B1); PG8_BAR;
            PG8_LDA(At, 1, 1); PG8_STAGE(PG8_SA(1, 0), a3, voffA);
            PG8_BAR; PG8_WAIT_L(0); PG8_MMA(1, 0, At, B0); PG8_BAR; PG8_SCHED;
            PG8_STAGE(PG8_SB(1, 1), b3 + hstepB, voffB);
            PG8_WAIT_V(6); PG8_BAR; PG8_MMA(1, 1, At, B1); PG8_BAR;
            }
        }
        if constexpr (MMODE == 1) asm volatile("s_nop 15\n\ts_nop 15" ::: "memory");
        if constexpr (ALIGN_EPI) { if (wr == 0) PG8_BAR; }
        if constexpr (!Epi::AFTER_DRAIN) { E(acc, cur, wr, wc, fr, fq); S.done(cur); }
        if (!has_next) break;
#pragma unroll
        for (int a = 0; a < 2; ++a)
#pragma unroll
            for (int b = 0; b < 2; ++b)
#pragma unroll
                for (int m = 0; m < 4; ++m)
#pragma unroll
                    for (int n = 0; n < 2; ++n) acc[a][b][m][n] = (f32x4){0.f, 0.f, 0.f, 0.f};
        cur = nxt; cA = nA; cB = nB; ++ui;
        if constexpr (ALIGN_EPI) { if (wr == 1) PG8_BAR; }
    }
    PG8_WAIT_V(0);
    if constexpr (!ALIGN_EPI) { if (wr == 0) PG8_BAR; }
    PG8_BAR;
    if constexpr (Epi::AFTER_DRAIN) { E.fused(acc, cur, wr, wc, fr, fq, lds, wid, lane); S.done(cur); }
#undef PG8_SA
#undef PG8_SB
#undef PG8_STAGE
#undef PG8_LDA
#undef PG8_LDB
#undef PG8_MMA
#undef PG8_WAIT_V
#undef PG8_WAIT_L
#undef PG8_BAR
#undef PG8_SCHED
}
}

constexpr int NWAVES = 8;
constexpr int D = 1024, SEQ = 8192, M = 16384;
constexpr int FFN = 2816, EXD = 3584, NEXP = 8;
constexpr int XS_ROWS = 2 * M + NEXP * 256;
constexpr int MAXPAN = XS_ROWS / 256;
constexpr int NPH = 31;

constexpr size_t MiB = 1u << 20;
constexpr size_t WS_CTL = 0, CTL_ZERO_BYTES = 1 * MiB;
constexpr size_t WS_SMALL = 1 * MiB;
constexpr size_t SM_AT = 0;
constexpr size_t SM_TOKE = 64 * 1024;
constexpr size_t SM_TOKW = SM_TOKE + 128 * 1024;
constexpr size_t SM_TOKR = SM_TOKW + 128 * 1024;
constexpr size_t SM_TOKP = SM_TOKR + 128 * 1024;
constexpr size_t SM_RSTD = SM_TOKP + 128 * 1024;
constexpr size_t SM_WGCNT = SM_RSTD + 64 * 1024;
constexpr size_t SM_ROWG = SM_WGCNT + 8 * 1024;
constexpr size_t SM_PANEL = SM_ROWG + 192 * 1024;
constexpr size_t SM_SSQ = 1 * MiB;
constexpr size_t WS_WEIN = 9 * MiB;
constexpr size_t EV_EIN = 0, EV_EOUT = 4 * MiB, EV_E13 = 6 * MiB, EV_E2 = 17 * MiB, EV_STRIDE = 23 * MiB;
constexpr size_t WS_WODD = WS_WEIN + 2 * EV_STRIDE;
constexpr size_t OD_OIN = 0, OD_GLU = 3 * MiB, OD_OOUT = 4 * MiB, OD_SGU = 6 * MiB, OD_WST = 7 * MiB, OD_MY = 15 * MiB, OD_M13 = 35 * MiB, OD_M2 = 147 * MiB, OD_STRIDE = 203 * MiB;
constexpr size_t WS_HB = WS_WODD + 2 * OD_STRIDE;
constexpr size_t WS_ARENA = WS_HB + 32 * MiB;
constexpr size_t AR_UM = 0;
constexpr size_t AR_Z = 0, AR_MIX = 64 * MiB, AR_UF = 96 * MiB;
constexpr size_t AR_AG = 0, AR_SST = 20 * MiB, AR_ZUV = 32 * MiB, AR_GY = 96 * MiB;
constexpr size_t AR_XS = 238 * MiB;
constexpr size_t WS_PART = WS_ARENA + 306 * MiB;
constexpr size_t WS_END = WS_PART + 56 * MiB;
static_assert((size_t)XS_ROWS * EXD * 2 <= 238 * MiB && (size_t)XS_ROWS * D * 2 <= 68 * MiB, "arena");
static_assert(SM_PANEL + 1024 <= SM_SSQ && SM_SSQ + (size_t)M * 16 * 4 <= 8 * MiB, "small tables");
constexpr int CW_TMO = 0;
constexpr int CW_BAR = 4096;
constexpr int CW_QUEUE = 64;

constexpr int RING_OFF = 0, RING_BYTES = 131072;
constexpr int LDSCTL_OFF = RING_BYTES, MISC_OFF = LDSCTL_OFF + 320;
constexpr int PTAB_OFF = LDSCTL_OFF + 1024;
constexpr int RST_OFF = LDSCTL_OFF + 2048;
constexpr int RST_UNITS = 6;
constexpr int LDS_BYTES = 147456;

#define GAS __attribute__((address_space(1)))
#define LAS __attribute__((address_space(3)))
typedef unsigned short bf16;
typedef unsigned v4u __attribute__((ext_vector_type(4)));
typedef unsigned v2u __attribute__((ext_vector_type(2)));
typedef float f32x4 __attribute__((ext_vector_type(4)));
typedef short bf16x8 __attribute__((ext_vector_type(8)));
#define RLX_AGENT __ATOMIC_RELAXED, __HIP_MEMORY_SCOPE_AGENT
#define LDS_WAIT() asm volatile("s_waitcnt lgkmcnt(0)" ::: "memory")
#define VM_WAIT() asm volatile("s_waitcnt vmcnt(0)" ::: "memory")
__device__ __forceinline__ unsigned f2bf(float f) { unsigned u = __builtin_bit_cast(unsigned, f); return (u + 0x7fffu + ((u >> 16) & 1u)) >> 16; }
__device__ __forceinline__ unsigned pk2(float lo, float hi) { return f2bf(lo) | (f2bf(hi) << 16); }
__device__ __forceinline__ float bflo(unsigned w) { return __uint_as_float(w << 16); }
__device__ __forceinline__ float bfhi(unsigned w) { return __uint_as_float(w & 0xffff0000u); }

#define XB_TMO      128
#define XB_XCNT(j)  (256  + 64 * (j))
#define XB_XSUB(j)  (1280 + 64 * (j))
#define XB_XGEN(j)  (2304 + 64 * (j))
#define XB_TOP      3328
#define XB_TOPGEN   3392
#define XCD_BAR_WORDS 3456
#define XB_SPIN_CAP (1u << 22)

__device__ __forceinline__ unsigned xb_ld(unsigned* p)              { return __hip_atomic_load(p, __ATOMIC_RELAXED, __HIP_MEMORY_SCOPE_AGENT); }
__device__ __forceinline__ unsigned xb_add(unsigned* p, unsigned v) { return __hip_atomic_fetch_add(p, v, __ATOMIC_RELAXED, __HIP_MEMORY_SCOPE_AGENT); }
__device__ __forceinline__ unsigned xb_xcc_id() { return (unsigned)__builtin_amdgcn_s_getreg((3 << 11) | 20) & 0xFu; }
#define XB_SPIN(cond, bar) do { unsigned _sp = 0; while (cond) { __builtin_amdgcn_s_sleep(1); \
    if ((++_sp & 255u) == 0u) { if (xb_ld(&(bar)[XB_TMO])) break; if (_sp > XB_SPIN_CAP) { atomicAdd(&(bar)[XB_TMO], 1u); break; } } } } while (0)

struct XcdBarrier { unsigned* bar; unsigned x; volatile LAS unsigned* st; };

__device__ __forceinline__ XcdBarrier xcd_barrier_post(unsigned* bar, volatile LAS unsigned* st) {
    XcdBarrier b; b.bar = bar; b.x = xb_xcc_id(); b.st = st;
    if (threadIdx.x == 0) st[2] = xb_add(&bar[XB_XCNT(b.x)], 1u);
    return b;
}
__device__ __forceinline__ void xcd_barrier_complete(unsigned* bar, unsigned x, unsigned& nloc, unsigned& nx, unsigned& uni, unsigned& xidx) {
    const unsigned G = gridDim.x * gridDim.y * gridDim.z;
    unsigned sum, cnt, mine, below, odd, sp = 0u;
    for (;;) {
        sum = 0u; cnt = 0u; mine = 0u; below = 0u; odd = 0u;
#pragma unroll
        for (unsigned j = 0; j < 16; ++j) { const unsigned c = xb_ld(&bar[XB_XCNT(j)]); sum += c; cnt += (c > 0u) ? 1u : 0u; mine = (j == x) ? c : mine; below += (j < x && c > 0u) ? 1u : 0u; odd += (c > 0u && c * 8u != G) ? 1u : 0u; }
        if (sum == G) break;
        __builtin_amdgcn_s_sleep(1);
        if ((++sp & 255u) == 0u) { if (xb_ld(&bar[XB_TMO])) break; if (sp > XB_SPIN_CAP) { atomicAdd(&bar[XB_TMO], 1u); break; } }
    }
    nloc = mine > 0u ? mine : 1u; nx = cnt > 0u ? cnt : 1u;
    uni = (sum == G && cnt == 8u && odd == 0u) ? 1u : 0u; xidx = below;
}
__device__ __forceinline__ void xcd_barrier(const XcdBarrier& b, const int wave_idx, const bool rel = true) {
    asm volatile("s_waitcnt vmcnt(0)" ::: "memory");
    __syncthreads();
    unsigned lane_b_; asm volatile("v_mbcnt_lo_u32_b32 %0, -1, 0\n\tv_mbcnt_hi_u32_b32 %0, -1, %0" : "=v"(lane_b_));
    if (wave_idx == 0 && lane_b_ == 0u) {
        unsigned* bar = b.bar;
        __builtin_amdgcn_s_waitcnt(0);
        unsigned nloc = b.st[0], nx = b.st[1];
        if (nloc == 0u) { unsigned uni, xidx; xcd_barrier_complete(bar, b.x, nloc, nx, uni, xidx); b.st[0] = nloc; b.st[1] = nx; b.st[3] = uni; b.st[4] = xidx; }
        const unsigned old = __hip_atomic_fetch_add(&bar[XB_XSUB(b.x)], 1u, __ATOMIC_RELAXED, __HIP_MEMORY_SCOPE_WORKGROUP);
        const unsigned gen = old / nloc;
        if (old + 1u == (gen + 1u) * nloc) {
            if (rel) { __builtin_amdgcn_fence(__ATOMIC_RELEASE, "agent"); asm volatile("s_waitcnt vmcnt(0)" ::: "memory"); }
            (void)xb_add(&bar[XB_TOP], 1u);
        }
        const unsigned target = (gen + 1u) * nx;
        asm volatile("buffer_inv sc1" ::: "memory");
        XB_SPIN(xb_ld(&bar[XB_TOP]) < target, bar);
        asm volatile("s_waitcnt vmcnt(0)" ::: "memory");
    }
    __syncthreads();
}

__device__ __forceinline__ float wave_sum(float v) {
#pragma unroll
    for (int o = 1; o < 64; o <<= 1) v += __shfl_xor(v, o);
    return v;
}
struct TTile { const float* src; const float* gain; unsigned char* dst; int ldw, ldo_b; float f8sc; };
__device__ __forceinline__ void sincos_turns(double turns, float& c, float& s) {
    const double fr = turns - __builtin_rint(turns);
    const float x = (float)fr * 6.283185307179586f;
    c = cosf(x); s = sinf(x);
}

#ifndef REP_P0
#define REP_P0 1
#endif
#ifndef REP_E2
#define REP_E2 1
#endif
#ifndef REP_SGU
#define REP_SGU 1
#endif
#ifndef REP_ROUTE
#define REP_ROUTE 1
#endif
#ifndef REP_BAR
#define REP_BAR 1
#endif
struct Args { const float* in[33]; float* out; unsigned char* ws; int ph_lo, ph_hi; };

__device__ __forceinline__ const float* in_ptr(int k) {
    const __attribute__((address_space(4))) char* ka = (const __attribute__((address_space(4))) char*)__builtin_amdgcn_kernarg_segment_ptr();
    int off = k * 8; asm volatile("" : "+s"(off));
    return *(const float* const __attribute__((address_space(4)))*)(ka + off);
}
#define INP(k) in_ptr(k)
#ifndef F8_LAST
#define F8_LAST 1
#endif
#ifndef F8_FROM
#define F8_FROM 0
#endif
#ifndef F8_FFN_FROM
#define F8_FFN_FROM 1
#endif
constexpr float F8_W13_SC = 32.f, F8_W2_SC = 64.f, F8_UM_SC = 16.f;
constexpr int TT_EV = 688, TT_OD = 5552, TT_LAYER = TT_EV + TT_OD, TT_EXP = 672, TT_TOTAL = 2 * TT_LAYER;
__device__ __forceinline__ TTile decode_tile(const Args& args, unsigned char* ws, int it) {
    const int li = it / TT_LAYER; int r = it % TT_LAYER;
    const float* W; const float* gain = nullptr; int ldw, nbn, ldo, mode = 0; unsigned char* WT; float f8sc = 0.f; int esz = 2;
    if (r < TT_EV) {
        unsigned char* wb = ws + WS_WEIN + li * EV_STRIDE;
        if (r < 96) { W = args.in[2] + (size_t)li * D * 2048; ldw = 2048; nbn = 12; gain = args.in[1] + li * D; WT = wb + EV_EIN; ldo = D; }
        else if (r < 160) { r -= 96; W = args.in[6] + (size_t)li * D * D; ldw = D; nbn = 8; WT = wb + EV_EOUT; ldo = D; }
        else if (r < 336) { r -= 160; W = args.in[8] + (size_t)li * D * FFN; ldw = FFN; nbn = 22; gain = args.in[7] + li * D; WT = wb + EV_E13; ldo = D; mode = 1; if (F8_LAST && li >= F8_FFN_FROM) { esz = 1; f8sc = F8_W13_SC; } }
        else if (r < 512) { r -= 336; W = args.in[9] + (size_t)li * D * FFN; ldw = FFN; nbn = 22; gain = args.in[7] + li * D; WT = wb + EV_E13; ldo = D; mode = 2; if (F8_LAST && li >= F8_FFN_FROM) { esz = 1; f8sc = F8_W13_SC; } }
        else { r -= 512; W = args.in[10] + (size_t)li * FFN * D; ldw = D; nbn = 8; WT = wb + EV_E2; ldo = FFN; if (F8_LAST && li >= F8_FFN_FROM) { esz = 1; f8sc = F8_W2_SC; } }
    } else {
        r -= TT_EV; unsigned char* wb = ws + WS_WODD + li * OD_STRIDE;
        if (r < 96) { W = args.in[12] + (size_t)li * D * 1536; ldw = 1536; nbn = 12; gain = args.in[11] + li * D; WT = wb + OD_OIN; ldo = D; }
        else if (r < 112) { r -= 96; W = args.in[21] + (size_t)li * 512 * 512; ldw = 512; nbn = 4; WT = wb + OD_GLU; ldo = 512; }
        else if (r < 176) { r -= 112; W = args.in[26] + (size_t)li * D * D; ldw = D; nbn = 8; WT = wb + OD_OOUT; ldo = D; }
        else { r -= 176; const int e = r / TT_EXP; r %= TT_EXP; const bool f8 = F8_LAST && li >= F8_FROM; if (f8) esz = 1;
            if (r < 224) { W = args.in[29] + ((size_t)li * NEXP + e) * D * EXD; ldw = EXD; nbn = 28; gain = args.in[27] + li * D; WT = wb + OD_M13 + (size_t)e * 2 * EXD * D * esz; ldo = D; mode = 1; if (f8) f8sc = F8_W13_SC; }
            else if (r < 448) { r -= 224; W = args.in[30] + ((size_t)li * NEXP + e) * D * EXD; ldw = EXD; nbn = 28; gain = args.in[27] + li * D; WT = wb + OD_M13 + (size_t)e * 2 * EXD * D * esz; ldo = D; mode = 2; if (f8) f8sc = F8_W13_SC; }
            else { r -= 448; W = args.in[31] + ((size_t)li * NEXP + e) * EXD * D; ldw = D; nbn = 8; WT = wb + OD_M2 + (size_t)e * D * EXD * esz; ldo = EXD; if (f8) f8sc = F8_W2_SC; } }
    }
    const int kb = r / nbn, nb = r % nbn, k0 = 128 * kb, n0 = 128 * nb;
    const size_t orow0 = mode == 0 ? (size_t)n0 : (size_t)(nb * 256 + (mode == 2 ? 128 : 0));
    TTile d; d.src = W + (size_t)k0 * ldw + n0; d.gain = gain ? gain + k0 : nullptr; d.ldw = ldw; d.f8sc = f8sc;
    d.dst = WT + (orow0 * ldo + k0) * esz; d.ldo_b = ldo * esz; return d;
}

__global__ void __launch_bounds__(NWAVES * 64, 2) trunk_fwd(Args args) {
    extern __shared__ __attribute__((aligned(16))) unsigned char lds_raw[];
    LAS unsigned char* lds = (LAS unsigned char*)lds_raw;
    volatile LAS unsigned* MISC = (volatile LAS unsigned*)(lds + MISC_OFF);
    const int G = gridDim.x, bx = blockIdx.x;
#define G_O ({ int g_ = G; asm volatile("" : "+s"(g_)); g_; })
#define BX_O ({ int b_ = cx; asm volatile("" : "+s"(b_)); b_; })
    const int wave_s = __builtin_amdgcn_readfirstlane((int)threadIdx.x >> 6);
#define PHASE_IDS int lane_o_; asm volatile("v_mbcnt_lo_u32_b32 %0, -1, 0\n\tv_mbcnt_hi_u32_b32 %0, -1, %0" : "=v"(lane_o_)); const int lane = lane_o_, wave = wave_s, tid = wave * 64 + lane; (void)tid;
#define P_ws ({ unsigned char* w_ = args.ws; asm volatile("" : "+s"(w_)); w_; })
#define P_ctl ((unsigned*)(P_ws + WS_CTL))
#define P_sm (P_ws + WS_SMALL)
#define P_SSQ ((float*)(P_ws + WS_SMALL + SM_SSQ))
#define P_HB ((bf16*)(P_ws + WS_HB))
#define P_arena (P_ws + WS_ARENA)
#define P_H ({ float* h_ = args.out; asm volatile("" : "+s"(h_)); h_; })
#define P_x_in INP(0)
#define P_wev (P_ws + WS_WEIN + lp * EV_STRIDE)
#define P_wod (P_ws + WS_WODD + lp * OD_STRIDE)
#define P_Z ((bf16*)(P_arena + AR_Z))
#define P_MIX ((bf16*)(P_arena + AR_MIX))
#define P_UF ((bf16*)(P_arena + AR_UF))
#define P_AG ((bf16*)(P_arena + AR_AG))
#define P_ZUV ((bf16*)(P_arena + AR_ZUV))
#define P_GY ((bf16*)(P_arena + AR_GY))
#define P_XS ((bf16*)(P_arena + AR_XS))
#define P_UM ((bf16*)(P_arena + AR_UM))
#define P_TOKE ((int*)(P_sm + SM_TOKE))
#define P_TOKW ((float*)(P_sm + SM_TOKW))
#define P_TOKR ((int*)(P_sm + SM_TOKR))
#define P_TOKP ((int*)(P_sm + SM_TOKP))
#define P_RSTD ((float*)(P_sm + SM_RSTD))
#define P_WGCNT ((int*)(P_sm + SM_WGCNT))
#define P_PANEL ((int*)(P_sm + SM_PANEL))
#define P_ROWT ((int*)(P_sm + SM_ROWG))

    for (int u = threadIdx.x; u < (LDS_BYTES - LDSCTL_OFF) / 4; u += NWAVES * 64) ((LAS unsigned*)(lds + LDSCTL_OFF))[u] = 0u;
    __syncthreads();
    (void)xcd_barrier_post(P_ctl + CW_BAR, MISC + 8);
    const int lo = args.ph_lo, hi = args.ph_hi;
#define IN(k) (lo <= (k) && (k) < hi)
#define RST_PREAMBLE(S) do { PHASE_IDS LAS float* rst_ = (LAS float*)(lds + RST_OFF); pg8::Unit u_; \
        for (int i_ = 0; i_ < RST_UNITS && (S).next(i_, u_); ++i_) { const int row_ = u_.pm * 256 + (tid >> 1); \
            const f32x4 a_ = *(const f32x4*)(P_SSQ + (size_t)row_ * 16 + (tid & 1) * 8), b_ = *(const f32x4*)(P_SSQ + (size_t)row_ * 16 + (tid & 1) * 8 + 4); \
            float s_ = ((a_[0] + a_[1]) + (a_[2] + a_[3])) + ((b_[0] + b_[1]) + (b_[2] + b_[3])); s_ += __shfl_xor(s_, 1); \
            if ((tid & 1) == 0) rst_[i_ * 256 + (tid >> 1)] = 1.0f / sqrtf(s_ * (1.0f / 1024.0f) + 1e-5f); } \
        __syncthreads(); } while (0)
#define SEAM_X(k, REL) do { if (IN(k) && IN((k) + 1)) { for (int rb_ = 0; rb_ < REP_BAR; ++rb_) { XcdBarrier bar_; bar_.bar = P_ctl + CW_BAR; bar_.x = xb_xcc_id(); bar_.st = (volatile LAS unsigned*)(lds + MISC_OFF) + 8; xcd_barrier(bar_, wave_s, REL); } } } while (0)
#define SEAM(k) SEAM_X(k, true)
#define SEAM_L(k) SEAM_X(k, uni_ == 0)

    for (int rep_ = 0; rep_ < REP_P0; ++rep_)
    if (IN(0)) {
        PHASE_IDS
        LAS float* scr = (LAS float*)(lds + RING_OFF + wave * 16384);
        const int gw = bx * NWAVES + wave, NGW = G * NWAVES;
        for (int task = bx; task < 64; task += G) {
            const int li = task >> 5, g = task & 31;
            LAS float* PWr = (LAS float*)(lds + RING_OFF);
            LAS float* PWi = PWr + 33 * 64;
            LAS float* BBr = PWi + 33 * 64;
            LAS float* BBi = BBr + 1024;
            LAS float* CRe = BBi + 1024;
            LAS float* CIm = CRe + 1024;
            LAS float* KT = CIm + 1024;
            __syncthreads();
            if (tid < 64) {
                const int p = tid; const int gp = (li * 32 + g) * 64 + p;
                const float lr = args.in[13][gp], lim = args.in[14][gp], dt = expf(args.in[15][li * 32 + g]);
                const float rho = lr * dt; const double td = (double)lim * (double)dt * 0.15915494309189535;
                for (int tau = 0; tau <= 32; ++tau) { float c, s; sincos_turns(td * (double)tau, c, s); const float mg = expf(rho * (float)tau); PWr[tau * 64 + p] = mg * c; PWi[tau * 64 + p] = mg * s; }
                float c1, s1, ch, sh; sincos_turns(td, c1, s1); sincos_turns(td * 0.5, ch, sh);
                const float mg = expf(rho), qr = expm1f(rho) * c1 - 2.0f * sh * sh, qi = mg * s1, den = lr * lr + lim * lim;
                const float fre = (qr * lr + qi * lim) / den, fim = (qi * lr - qr * lim) / den;
                for (int h = 0; h < 16; ++h) { const float br = args.in[16][(size_t)gp * 16 + h], bi = args.in[17][(size_t)gp * 16 + h]; BBr[p * 16 + h] = fre * br - fim * bi; BBi[p * 16 + h] = fre * bi + fim * br; }
                float* AT = (float*)(P_sm + SM_AT) + (size_t)gp * 2; AT[0] = PWr[32 * 64 + p]; AT[1] = PWi[32 * 64 + p];
            }
            for (int e = tid; e < 1024; e += 512) { CRe[e] = args.in[18][(size_t)(li * 32 + g) * 1024 + e]; CIm[e] = args.in[19][(size_t)(li * 32 + g) * 1024 + e]; }
            __syncthreads();
            for (int r = 0; r < 16; ++r) { const int o = tid + 512 * r, tau = o >> 8, hp = (o >> 4) & 15, h = o & 15; float a = 0.f;
                for (int p = 0; p < 64; ++p) { const float cr = CRe[hp * 64 + p], ci = CIm[hp * 64 + p], wr_ = PWr[tau * 64 + p], wi_ = PWi[tau * 64 + p];
                    const float car = cr * wr_ - ci * wi_, cai = cr * wi_ + ci * wr_; a += car * BBr[p * 16 + h] - cai * BBi[p * 16 + h]; }
                KT[o] = a; }
            __syncthreads();
            bf16* MY = (bf16*)(P_ws + WS_WODD + li * OD_STRIDE + OD_MY) + (size_t)g * 512 * 640;
            for (int r = 0; r < 80; ++r) { const int q = tid + 512 * r, n = q / 80, k0 = (q % 80) * 8, j = n >> 4, hp = n & 15; float v[8];
                if (k0 < 64) {
#pragma unroll
                    for (int e = 0; e < 8; ++e) { const int p = k0 + e; v[e] = CRe[hp * 64 + p] * PWr[(j + 1) * 64 + p] - CIm[hp * 64 + p] * PWi[(j + 1) * 64 + p]; }
                } else if (k0 < 128) {
#pragma unroll
                    for (int e = 0; e < 8; ++e) { const int p = k0 - 64 + e; v[e] = -(CRe[hp * 64 + p] * PWi[(j + 1) * 64 + p] + CIm[hp * 64 + p] * PWr[(j + 1) * 64 + p]); }
                } else { const int s = (k0 - 128) >> 4, h0 = (k0 - 128) & 15;
#pragma unroll
                    for (int e = 0; e < 8; ++e) v[e] = (s <= j) ? KT[(j - s) * 256 + hp * 16 + h0 + e] : 0.f; }
                v4u o; o.x = pk2(v[0], v[1]); o.y = pk2(v[2], v[3]); o.z = pk2(v[4], v[5]); o.w = pk2(v[6], v[7]);
                *(GAS v4u*)(MY + (size_t)n * 640 + k0) = o; }
            bf16* WST = (bf16*)(P_ws + WS_WODD + li * OD_STRIDE + OD_WST) + (size_t)g * 256 * 512;
            for (int r = 0; r < 32; ++r) { const int q = tid + 512 * r, n = q >> 6, k0 = (q & 63) * 8, s = k0 >> 4, h0 = k0 & 15; float v[8];
                if (n < 64) {
#pragma unroll
                    for (int e = 0; e < 8; ++e) v[e] = PWr[(31 - s) * 64 + n] * BBr[n * 16 + h0 + e] - PWi[(31 - s) * 64 + n] * BBi[n * 16 + h0 + e];
                } else if (n < 128) { const int p = n - 64;
#pragma unroll
                    for (int e = 0; e < 8; ++e) v[e] = PWr[(31 - s) * 64 + p] * BBi[p * 16 + h0 + e] + PWi[(31 - s) * 64 + p] * BBr[p * 16 + h0 + e];
                } else {
#pragma unroll
                    for (int e = 0; e < 8; ++e) v[e] = 0.f; }
                v4u o; o.x = pk2(v[0], v[1]); o.y = pk2(v[2], v[3]); o.z = pk2(v[4], v[5]); o.w = pk2(v[6], v[7]);
                *(GAS v4u*)(WST + (size_t)n * 512 + k0) = o; }
            __syncthreads();
        }
        for (int it = gw; it < 2 * 256; it += NGW) {
            const int li = it >> 8, r = it & 255, kb = r >> 4, gi = (r >> 2) & 3, db = r & 3, k = kb * 64 + lane;
            const float* wrow = args.in[2] + ((size_t)li * D + k) * 2048 + 1536 + gi * 128;
            const float* pw = args.in[4] + ((size_t)li * 4 + gi) * 128 * 128 + db * 32;
            float a[32];
#pragma unroll
            for (int d = 0; d < 32; ++d) a[d] = 0.f;
            for (int c4 = 0; c4 < 32; ++c4) { const f32x4 xv = *(const f32x4*)(wrow + c4 * 4);
#pragma unroll
                for (int cc = 0; cc < 4; ++cc) { const float xs = xv[cc]; const float* pr = pw + (size_t)(c4 * 4 + cc) * 128;
#pragma unroll
                    for (int d = 0; d < 32; ++d) a[d] += xs * pr[d]; } }
            const float gk = args.in[1][li * D + k];
            bf16* WT = (bf16*)(P_ws + WS_WEIN + li * EV_STRIDE + EV_EIN);
#pragma unroll
            for (int d = 0; d < 32; ++d) { const int n = gi * 128 + db * 32 + d; WT[(size_t)(1536 + n) * D + k] = (bf16)f2bf(a[d] * gk * args.in[5][li * 512 + n]); }
        }
        for (int q = bx * 512 + tid; q < 2 * 4 * 128 * 16; q += G * 512) {
            const int li = q >> 13, rem = q & 8191, hh = rem >> 11, i = (rem >> 4) & 127, j0 = (rem & 15) * 8;
            const float* src = args.in[24] + (((size_t)li * 4 + hh) * 128 + i) * 128 + j0;
            const f32x4 a = *(const f32x4*)src, b = *(const f32x4*)(src + 4);
            const bool keep = (j0 >> 6) <= (i >> 6);
            v4u o; o.x = keep ? pk2(a[0], a[1]) : 0u; o.y = keep ? pk2(a[2], a[3]) : 0u; o.z = keep ? pk2(b[0], b[1]) : 0u; o.w = keep ? pk2(b[2], b[3]) : 0u;
            *(GAS v4u*)((bf16*)(P_ws + WS_WODD + li * OD_STRIDE + OD_SGU) + ((size_t)hh * 128 + i) * 128 + j0) = o;
        }
        for (int m = gw; m < M; m += NGW) {
            const GAS f32x4* xr = (const GAS f32x4*)(args.in[0] + (size_t)m * D) + lane; f32x4 v[4]; float s = 0.f;
#pragma unroll
            for (int j = 0; j < 4; ++j) { v[j] = xr[64 * j]; s += (v[j].x * v[j].x + v[j].y * v[j].y) + (v[j].z * v[j].z + v[j].w * v[j].w); }
            s = wave_sum(s);
            GAS v2u* o8 = (GAS v2u*)(P_HB + (size_t)m * D) + lane;
#pragma unroll
            for (int j = 0; j < 4; ++j) { v2u w; w.x = pk2(v[j].x, v[j].y); w.y = pk2(v[j].z, v[j].w); o8[64 * j] = w; }
            if (lane < 16) P_SSQ[(size_t)m * 16 + lane] = lane == 0 ? s : 0.f;
        }
        {
            LAS float* tile = (LAS float*)(lds + RING_OFF); volatile LAS int* nxt = (volatile LAS int*)(lds + RING_OFF + 65536);
            unsigned* qctr = P_ctl + CW_QUEUE; int it = bx;
            const int lr = lane >> 5, nc4 = (lane & 31) * 4;
            const int cch = lane & 15, nro = lane >> 4;
#define TT_LOAD(RG, DD) do { _Pragma("unroll") for (int i = 0; i < 8; ++i) RG[i] = *(const f32x4*)((DD).src + (size_t)(wave * 16 + 2 * i + lr) * (DD).ldw + nc4); } while (0)
#define TT_STEP(RG, DD, ITC) do { \
                __syncthreads();                                                \
                _Pragma("unroll") for (int i = 0; i < 8; ++i) { const int k = wave * 16 + 2 * i + lr; *(LAS f32x4*)(tile + k * 128 + (nc4 ^ (((k >> 3) & 7) << 2))) = RG[i]; } \
                if (tid == 0) { nxt[0] = tk; tk = 2 * G + (int)__hip_atomic_fetch_add(qctr, 1u, RLX_AGENT); }     \
                __syncthreads(); \
                const int itn_ = nxt[0]; const TTile dc_ = DD; DD = decode_tile(args, P_ws, itn_ < TT_TOTAL ? itn_ : 0); \
                if (itn_ < TT_TOTAL) TT_LOAD(RG, DD); \
                f32x4 g0 = {1.f, 1.f, 1.f, 1.f}, g1 = {1.f, 1.f, 1.f, 1.f}; \
                if (dc_.gain) { g0 = *(const f32x4*)(dc_.gain + 8 * cch); g1 = *(const f32x4*)(dc_.gain + 8 * cch + 4); } \
                _Pragma("unroll") for (int i = 0; i < 4; ++i) { const int n = wave * 16 + i * 4 + nro; const int sw = n ^ ((cch & 7) << 2); const LAS float* s = tile + (8 * cch) * 128 + sw; \
                    const float e0 = s[0 * 128] * g0[0], e1 = s[1 * 128] * g0[1], e2 = s[2 * 128] * g0[2], e3 = s[3 * 128] * g0[3], e4 = s[4 * 128] * g1[0], e5 = s[5 * 128] * g1[1], e6 = s[6 * 128] * g1[2], e7 = s[7 * 128] * g1[3]; \
                    if (dc_.f8sc != 0.f) { const float q = dc_.f8sc; v2u o; o.x = pg8::pk4_fp8(e0 * q, e1 * q, e2 * q, e3 * q); o.y = pg8::pk4_fp8(e4 * q, e5 * q, e6 * q, e7 * q); \
                        *(GAS v2u*)(dc_.dst + (size_t)n * dc_.ldo_b + 8 * cch) = o; } \
                    else { v4u o; o.x = pk2(e0, e1); o.y = pk2(e2, e3); o.z = pk2(e4, e5); o.w = pk2(e6, e7); \
                        *(GAS v4u*)(dc_.dst + (size_t)n * dc_.ldo_b + 16 * cch) = o; } } \
                ITC = itn_; } while (0)
            int tk = 0; if (tid == 0) tk = 2 * G + (int)__hip_atomic_fetch_add(qctr, 1u, RLX_AGENT);
            f32x4 rgA[8], rgB[8]; int itA = bx, itB = bx + G;
            TTile dA = decode_tile(args, P_ws, itA < TT_TOTAL ? itA : 0), dB = decode_tile(args, P_ws, itB < TT_TOTAL ? itB : 0);
            if (itA < TT_TOTAL) TT_LOAD(rgA, dA);
            if (itB < TT_TOTAL) TT_LOAD(rgB, dB);
            for (;;) {
                if (itA < TT_TOTAL) TT_STEP(rgA, dA, itA);
                if (itB < TT_TOTAL) TT_STEP(rgB, dB, itB);
                if (itA >= TT_TOTAL && itB >= TT_TOTAL) break;
            }
#undef TT_LOAD
#undef TT_STEP
            __syncthreads();
        }
    }
    SEAM(0);
    const int uni_ = __builtin_amdgcn_readfirstlane((int)MISC[11]);
    const int cx = uni_ ? __builtin_amdgcn_readfirstlane((int)(MISC[10] * 8u + MISC[12])) : bx;
    const int vbx = uni_ ? ((cx & 7) << 5) + (cx >> 3) : bx;

    for (int lp = 0; lp < 2; ++lp) {
        const int pb = 1 + lp * 15;
        if (IN(pb + 0)) {
            pg8::GDs g{P_HB, (const bf16*)(P_wev + EV_EIN), D, D, D, 30, 0}; pg8::Order S; S.init(M / 256, 2048 / 256, G_O, BX_O);
            RST_PREAMBLE(S);
            pg8::EpiScaleBf16 E{P_Z, 2048, (const LAS float*)(lds + RST_OFF)};
            pg8::gemm_phase<pg8::EpiScaleBf16, pg8::Order, pg8::GDs>(lds + RING_OFF, g, S, E, wave_s);
        }
        SEAM(pb + 0);
        for (int rep_ = 0; rep_ < REP_E2; ++rep_)
        if (IN(pb + 1)) {
            PHASE_IDS
            const float* cw = INP(3) + (size_t)lp * 3 * 512;
            const int cv = tid & 63, c0 = 8 * cv;
            f32x4 cwv[3][2];
#pragma unroll
            for (int k = 0; k < 3; ++k) { cwv[k][0] = *(const f32x4*)(cw + (2 - k) * 512 + c0); cwv[k][1] = *(const f32x4*)(cw + (2 - k) * 512 + c0 + 4); }
            const int gi = wave & 3;
            for (int vb = vbx; vb < 256; vb += G) {
                for (int itx = 0; itx < 8; ++itx) {
                    const int tc = vb * 64 + itx * 8 + (tid >> 6), lc = tc & (SEQ - 1);
                    const bf16* zr = P_Z + (size_t)tc * 2048 + c0; const bool v1 = lc >= 1, v2 = lc >= 2;
                    const bf16* zr1 = v1 ? zr - 2048 : zr; const bf16* zr2 = v2 ? zr - 4096 : zr;
                    const v4u gb = *(const GAS v4u*)(zr), gc0 = *(const GAS v4u*)(zr + 512), xa0 = *(const GAS v4u*)(zr + 1024);
                    const v4u gc1 = *(const GAS v4u*)(zr1 + 512), xa1 = *(const GAS v4u*)(zr1 + 1024), gc2 = *(const GAS v4u*)(zr2 + 512), xa2 = *(const GAS v4u*)(zr2 + 1024);
                    const int t = vb * 64 + itx * 8 + 4 * (wave >> 2) + (lane >> 4), l = t & (SEQ - 1), pc0 = gi * 128 + 8 * (lane & 15);
                    const bf16* qr = P_Z + (size_t)t * 2048 + 1536 + pc0; float s[8];
#pragma unroll
                    for (int e = 0; e < 8; ++e) s[e] = 0.f;
                    v4u q0;
#define POOLW(WN) { v4u q[WN]; _Pragma("unroll") for (int k = 0; k < WN; ++k) q[k] = *(const GAS v4u*)(k <= l ? qr - (size_t)k * 2048 : qr); q0 = q[0]; \
                        _Pragma("unroll") for (int k = 0; k < WN; ++k) { const float mk = k <= l ? 1.f : 0.f; s[0] += mk * bflo(q[k].x); s[1] += mk * bfhi(q[k].x); s[2] += mk * bflo(q[k].y); s[3] += mk * bfhi(q[k].y); \
                            s[4] += mk * bflo(q[k].z); s[5] += mk * bfhi(q[k].z); s[6] += mk * bflo(q[k].w); s[7] += mk * bfhi(q[k].w); } }
                    if (gi == 0) POOLW(2) else if (gi == 1) POOLW(4) else if (gi == 2) POOLW(8) else POOLW(16)
#undef POOLW
                    {
                        const float m1 = v1 ? 1.f : 0.f, m2 = v2 ? 1.f : 0.f; float o[8];
#define CONV1(e, G0, X0, G1, X1, G2, X2, W) o[e] = cwv[0][(e) >> 2][(e) & 3] * W(G0) * W(X0) + m1 * cwv[1][(e) >> 2][(e) & 3] * W(G1) * W(X1) + m2 * cwv[2][(e) >> 2][(e) & 3] * W(G2) * W(X2)
                        CONV1(0, gc0.x, xa0.x, gc1.x, xa1.x, gc2.x, xa2.x, bflo); CONV1(1, gc0.x, xa0.x, gc1.x, xa1.x, gc2.x, xa2.x, bfhi);
                        CONV1(2, gc0.y, xa0.y, gc1.y, xa1.y, gc2.y, xa2.y, bflo); CONV1(3, gc0.y, xa0.y, gc1.y, xa1.y, gc2.y, xa2.y, bfhi);
                        CONV1(4, gc0.z, xa0.z, gc1.z, xa1.z, gc2.z, xa2.z, bflo); CONV1(5, gc0.z, xa0.z, gc1.z, xa1.z, gc2.z, xa2.z, bfhi);
                        CONV1(6, gc0.w, xa0.w, gc1.w, xa1.w, gc2.w, xa2.w, bflo); CONV1(7, gc0.w, xa0.w, gc1.w, xa1.w, gc2.w, xa2.w, bfhi);
#undef CONV1
                        v4u ov; ov.x = pk2(bflo(gb.x) * o[0], bfhi(gb.x) * o[1]); ov.y = pk2(bflo(gb.y) * o[2], bfhi(gb.y) * o[3]); ov.z = pk2(bflo(gb.z) * o[4], bfhi(gb.z) * o[5]); ov.w = pk2(bflo(gb.w) * o[6], bfhi(gb.w) * o[7]);
                        *(GAS v4u*)(P_MIX + (size_t)tc * 1024 + c0) = ov;
                    }
                    {
                        const int w = 2 << gi, cnt = (l + 1) < w ? (l + 1) : w; const float inv = 1.0f / (float)cnt;
                        v4u ov; ov.x = pk2(s[0] * inv - bflo(q0.x), s[1] * inv - bfhi(q0.x)); ov.y = pk2(s[2] * inv - bflo(q0.y), s[3] * inv - bfhi(q0.y));
                        ov.z = pk2(s[4] * inv - bflo(q0.z), s[5] * inv - bfhi(q0.z)); ov.w = pk2(s[6] * inv - bflo(q0.w), s[7] * inv - bfhi(q0.w));
                        *(GAS v4u*)(P_MIX + (size_t)t * 1024 + 512 + pc0) = ov;
                    }
                }
            }
        }
        SEAM_L(pb + 1);
        const bool ffn8 = F8_LAST && lp >= F8_FFN_FROM;
        if (IN(pb + 2)) {
            pg8::GDs g{P_MIX, (const bf16*)(P_wev + EV_EOUT), D, D, D, 30, 0}; pg8::Order S; S.init(M / 256, D / 256, G_O, BX_O);
            pg8::EpiResidB<false> E{P_HB, P_SSQ, 1.0f, ffn8 ? (unsigned char*)P_Z : nullptr};
            pg8::gemm_phase<pg8::EpiResidB<false>, pg8::Order, pg8::GDs>(lds + RING_OFF, g, S, E, wave_s);
        }
        SEAM_L(pb + 2);
        if (IN(pb + 3)) {
            pg8::Order S; S.init(M / 256, FFN / 128, G_O, BX_O);
            RST_PREAMBLE(S);
            if (ffn8) {
                pg8::GDs g{P_Z, (const bf16*)(P_wev + EV_E13), D / 2, D / 2, D / 2, 30, 0};
                pg8::EpiSwiGLUF8<true> E{(unsigned char*)P_UF, FFN, 1.0f / F8_W13_SC, F8_UM_SC, (const LAS float*)(lds + RST_OFF)};
                pg8::gemm_phase<pg8::EpiSwiGLUF8<true>, pg8::Order, pg8::GDs, 1>(lds + RING_OFF, g, S, E, wave_s);
            } else {
                pg8::GDs g{P_HB, (const bf16*)(P_wev + EV_E13), D, D, D, 30, 0};
                pg8::EpiSwiGLU<false> E{P_UF, FFN, (const LAS float*)(lds + RST_OFF)};
                pg8::gemm_phase<pg8::EpiSwiGLU<false>, pg8::Order, pg8::GDs>(lds + RING_OFF, g, S, E, wave_s);
            }
        }
        SEAM_L(pb + 3);
        if (IN(pb + 4)) {
            pg8::Order S; S.init(M / 256, D / 256, G_O, BX_O);
            if (ffn8) {
                pg8::GDs g{P_UF, (const bf16*)(P_wev + EV_E2), FFN / 2, FFN / 2, FFN / 2, 30, 0};
                pg8::EpiResidB<true> E{P_HB, P_SSQ, 1.0f / (F8_UM_SC * F8_W2_SC), nullptr};
                pg8::gemm_phase<pg8::EpiResidB<true>, pg8::Order, pg8::GDs, 1>(lds + RING_OFF, g, S, E, wave_s);
            } else {
                pg8::GDs g{P_UF, (const bf16*)(P_wev + EV_E2), FFN, FFN, FFN, 30, 0};
                pg8::EpiResidB<false> E{P_HB, P_SSQ, 1.0f, nullptr};
                pg8::gemm_phase<pg8::EpiResidB<false>, pg8::Order, pg8::GDs>(lds + RING_OFF, g, S, E, wave_s);
            }
        }
        SEAM_L(pb + 4);
        if (IN(pb + 5)) {
            pg8::GDs g{P_HB, (const bf16*)(P_wod + OD_OIN), D, D, D, 30, 0}; pg8::Order S; S.init(M / 256, 1536 / 256, G_O, BX_O);
            RST_PREAMBLE(S);
            pg8::EpiOddIn E{P_AG, P_ZUV, (const LAS float*)(lds + RST_OFF)};
            pg8::gemm_phase<pg8::EpiOddIn, pg8::Order, pg8::GDs>(lds + RING_OFF, g, S, E, wave_s);
        }
        SEAM(pb + 5);
        if (IN(pb + 6)) {
            const int NS5 = G >= 128 ? 64 : 0;
            if (NS5 == 0 || cx < NS5) {
                pg8::GDs g{P_AG + 128, (const bf16*)(P_wod + OD_WST), 640, 512, 512, 1, (size_t)256 * 512}; pg8::Order S; S.init(64, 1, NS5 ? NS5 : G_O, BX_O);
                pg8::EpiS5Scan E{P_AG, (const float*)(P_sm + SM_AT) + (size_t)lp * 32 * 64 * 2};
                pg8::gemm_phase<pg8::EpiS5Scan, pg8::Order, pg8::GDs>(lds + RING_OFF, g, S, E, wave_s);
            }
            for (int rep_ = 0; rep_ < REP_SGU; ++rep_)
            if (NS5 == 0 || cx >= NS5) {
                PHASE_IDS
                const int nwk = NS5 ? G - NS5 : G, wk = NS5 ? cx - NS5 : cx;
                LAS bf16* vT = (LAS bf16*)(lds + RING_OFF);
                const bf16* Wm = (const bf16*)(P_wod + OD_SGU);
                const float* lng = INP(23) + lp * 512; const float* sb = INP(25) + lp * 512;
                const int j_ln = tid >> 2, cq = tid & 3, fr = lane & 15, fq = lane >> 4, i_pos = wave * 16 + fr;
                for (int un = wk; un < 512; un += nwk) {
                    const int nb = un >> 2, hh = un & 3;
                    v4u vraw[4];
                    { const bf16* src = P_ZUV + (size_t)(nb * 128 + j_ln) * 1024 + 512 + hh * 128 + cq * 32;
#pragma unroll
                      for (int q4 = 0; q4 < 4; ++q4) vraw[q4] = *(const GAS v4u*)(src + q4 * 8); }
                    bf16x8 wf[4];
#pragma unroll
                    for (int ks = 0; ks < 4; ++ks) wf[ks] = *(const GAS bf16x8*)(Wm + ((size_t)hh * 128 + i_pos) * 128 + ks * 32 + fq * 8);
                    const float bias = sb[hh * 128 + i_pos]; const size_t tok = (size_t)(nb * 128 + i_pos);
                    v2u uu[8];
#pragma unroll
                    for (int ct = 0; ct < 8; ++ct) uu[ct] = *(const GAS v2u*)(P_ZUV + tok * 1024 + hh * 128 + ct * 16 + fq * 4);
                    __syncthreads();
                    {
                        float v[32]; float s = 0.f;
#pragma unroll
                        for (int q4 = 0; q4 < 4; ++q4) { const v4u w = vraw[q4];
                            v[q4 * 8 + 0] = bflo(w.x); v[q4 * 8 + 1] = bfhi(w.x); v[q4 * 8 + 2] = bflo(w.y); v[q4 * 8 + 3] = bfhi(w.y);
                            v[q4 * 8 + 4] = bflo(w.z); v[q4 * 8 + 5] = bfhi(w.z); v[q4 * 8 + 6] = bflo(w.w); v[q4 * 8 + 7] = bfhi(w.w); }
#pragma unroll
                        for (int e = 0; e < 32; ++e) s += v[e];
                        s += __shfl_xor(s, 1); s += __shfl_xor(s, 2);
                        const float mu = s * (1.0f / 128.0f); float q = 0.f;
#pragma unroll
                        for (int e = 0; e < 32; ++e) { v[e] -= mu; q += v[e] * v[e]; }
                        q += __shfl_xor(q, 1); q += __shfl_xor(q, 2);
                        const float rstd = 1.0f / sqrtf(q * (1.0f / 128.0f) + 1e-5f);
#pragma unroll
                        for (int e = 0; e < 32; ++e) { const int c = cq * 32 + e; vT[c * 136 + j_ln] = (bf16)f2bf(v[e] * rstd * lng[hh * 128 + c]); }
                    }
                    __syncthreads();
                    {
                        f32x4 acc[8];
#pragma unroll
                        for (int ct = 0; ct < 8; ++ct) acc[ct] = (f32x4){0.f, 0.f, 0.f, 0.f};
#pragma unroll
                        for (int ks = 0; ks < 4; ++ks) {
#pragma unroll
                            for (int ct = 0; ct < 8; ++ct) { const bf16x8 vf = *(const LAS bf16x8*)(vT + (ct * 16 + fr) * 136 + ks * 32 + fq * 8);
                                acc[ct] = __builtin_amdgcn_mfma_f32_16x16x32_bf16(vf, wf[ks], acc[ct], 0, 0, 0); }
                        }
#pragma unroll
                        for (int ct = 0; ct < 8; ++ct) { const int c = ct * 16 + fq * 4;
                            v2u o; o.x = pk2(bflo(uu[ct].x) * (acc[ct][0] + bias), bfhi(uu[ct].x) * (acc[ct][1] + bias)); o.y = pk2(bflo(uu[ct].y) * (acc[ct][2] + bias), bfhi(uu[ct].y) * (acc[ct][3] + bias));
                            *(GAS v2u*)(P_MIX + tok * 1024 + 512 + hh * 128 + c) = o; }
                    }
                }
                __syncthreads();
            }
        }
        SEAM(pb + 6);
        if (IN(pb + 7)) {
            pg8::GDh g{P_AG, (const bf16*)(P_wod + OD_MY), 640, 640, 640, 1, (size_t)512 * 640}; pg8::Order S; S.init(64, 4, G_O, BX_O);
            pg8::EpiS5Y E{P_AG, INP(20) + lp * 512, P_GY};
            pg8::gemm_phase<pg8::EpiS5Y, pg8::Order, pg8::GDh>(lds + RING_OFF, g, S, E, wave_s);
        }
        SEAM(pb + 7);
        if (IN(pb + 8)) {
            pg8::GDh g{P_GY, (const bf16*)(P_wod + OD_GLU), 512, 512, 512, 30, 0}; pg8::Order S; S.init(M / 256, 4, G_O, BX_O);
            pg8::EpiGLU E{P_GY, INP(22) + lp * 512, P_MIX};
            pg8::gemm_phase<pg8::EpiGLU, pg8::Order, pg8::GDh>(lds + RING_OFF, g, S, E, wave_s);
        }
        SEAM(pb + 8);
        if (IN(pb + 9)) {
            pg8::GDs g{P_MIX, (const bf16*)(P_wod + OD_OOUT), D, D, D, 30, 0}; pg8::Order S; S.init(M / 256, D / 256, G_O, BX_O);
            pg8::EpiResidB<false> E{P_HB, P_SSQ, 1.0f, nullptr};
            pg8::gemm_phase<pg8::EpiResidB<false>, pg8::Order, pg8::GDs>(lds + RING_OFF, g, S, E, wave_s);
        }
        SEAM_L(pb + 9);
        for (int rep_ = 0; rep_ < REP_ROUTE; ++rep_)
        if (IN(pb + 10)) {
            PHASE_IDS
            LAS unsigned short* Bl = (LAS unsigned short*)(lds + RING_OFF);
            LAS float* Cp = (LAS float*)(lds + RING_OFF + 32768);
            const float* Wr = INP(28) + (size_t)lp * D * 8; const float* g2 = INP(27) + lp * D;
            const int fr = lane & 15, fq = lane >> 4, mt = wave & 3, kh = wave >> 2;
            __syncthreads();
#pragma unroll
            for (int kk = 0; kk < 2; ++kk) { const int k = tid * 2 + kk; const float gk = g2[k]; const f32x4 w0 = *(const f32x4*)(Wr + (size_t)k * 8), w1 = *(const f32x4*)(Wr + (size_t)k * 8 + 4);
                LAS unsigned short* dst = Bl + (size_t)(((k >> 5) * 4 + ((k >> 3) & 3)) * 16) * 8 + (k & 7);
#pragma unroll
                for (int e = 0; e < 8; ++e) { const float w = (e < 4 ? w0[e] : w1[e - 4]) * gk; const unsigned hi = f2bf(w), lo = f2bf(w - __uint_as_float(hi << 16)); dst[e * 8] = (unsigned short)hi; dst[(e + 8) * 8] = (unsigned short)lo; } }
            for (int vb = vbx; vb < 256; vb += G) {
                bf16x8 af[16];
                { const bf16* arow = P_HB + (size_t)(vb * 64 + mt * 16 + fr) * D + kh * 512 + fq * 8;
#pragma unroll
                  for (int ks = 0; ks < 16; ++ks) af[ks] = *(const GAS bf16x8*)(arow + ks * 32); }
                __syncthreads();
                f32x4 acc = {0.f, 0.f, 0.f, 0.f};
#pragma unroll
                for (int ks = 0; ks < 16; ++ks) { const bf16x8 bfr = *(const LAS bf16x8*)(Bl + (size_t)(((kh * 16 + ks) * 4 + fq) * 16 + fr) * 8);
                    acc = __builtin_amdgcn_mfma_f32_16x16x32_bf16(af[ks], bfr, acc, 0, 0, 0); }
#pragma unroll
                for (int j = 0; j < 4; ++j) Cp[(wave * 16 + 4 * fq + j) * 16 + fr] = acc[j];
                __syncthreads();
                if (wave == 0) { const int t = vb * 64 + lane; const LAS float* p0 = Cp + ((lane >> 4) * 16 + (lane & 15)) * 16; const LAS float* p1 = p0 + 4 * 256;
                    f32x4 c0[4], c1[4];
#pragma unroll
                    for (int i = 0; i < 4; ++i) { c0[i] = *(const LAS f32x4*)(p0 + 4 * i); c1[i] = *(const LAS f32x4*)(p1 + 4 * i); }
                    const f32x4 s0 = *(const f32x4*)(P_SSQ + (size_t)t * 16), s1 = *(const f32x4*)(P_SSQ + (size_t)t * 16 + 4), s2 = *(const f32x4*)(P_SSQ + (size_t)t * 16 + 8), s3 = *(const f32x4*)(P_SSQ + (size_t)t * 16 + 12);
                    const float ss = (((s0[0] + s0[1]) + (s0[2] + s0[3])) + ((s1[0] + s1[1]) + (s1[2] + s1[3]))) + (((s2[0] + s2[1]) + (s2[2] + s2[3])) + ((s3[0] + s3[1]) + (s3[2] + s3[3])));
                    const float rstd = 1.0f / sqrtf(ss * (1.0f / 1024.0f) + 1e-5f);
                    float lv[8];
#pragma unroll
                    for (int e = 0; e < 8; ++e) lv[e] = ((c0[e >> 2][e & 3] + c0[2 + (e >> 2)][e & 3]) + (c1[e >> 2][e & 3] + c1[2 + (e >> 2)][e & 3])) * rstd;
                    int e0 = 0; float v0 = lv[0];
#pragma unroll
                    for (int e = 1; e < 8; ++e) { if (lv[e] > v0) { v0 = lv[e]; e0 = e; } }
                    int e1 = -1; float v1 = 0.f;
#pragma unroll
                    for (int e = 0; e < 8; ++e) { if (e != e0 && (e1 < 0 || lv[e] > v1)) { v1 = lv[e]; e1 = e; } }
                    const float ex = __expf(v1 - v0), w0 = 1.0f / (1.0f + ex), w1 = ex * w0;
                    P_TOKE[t * 2] = e0; P_TOKE[t * 2 + 1] = e1; P_TOKW[t * 2] = w0; P_TOKW[t * 2 + 1] = w1; P_RSTD[t] = rstd;
                    int r0 = 0, r1 = 0;
#pragma unroll
                    for (int e = 0; e < 8; ++e) { const unsigned long long mk = __ballot(e0 == e || e1 == e); const int rk = __popcll(mk & ((1ull << lane) - 1ull));
                        if (e0 == e) r0 = rk; if (e1 == e) r1 = rk; if (lane == 0) P_WGCNT[vb * 8 + e] = __popcll(mk); }
                    P_TOKR[t * 2] = r0; P_TOKR[t * 2 + 1] = r1; }
            }
            __syncthreads();
        }
        SEAM(pb + 10);
        for (int rep_ = 0; rep_ < REP_ROUTE; ++rep_)
        if (IN(pb + 11)) {
            PHASE_IDS
            const bool f8 = F8_LAST && lp >= F8_FROM;
            LAS int* cntT = (LAS int*)(lds + RING_OFF);
            LAS int* pre = cntT + 32;
            __syncthreads();
            {
                const int e = wave; int s = 0;
#pragma unroll
                for (int i = 0; i < 4; ++i) s += P_WGCNT[(lane * 4 + i) * 8 + e];
#pragma unroll
                for (int o = 1; o < 64; o <<= 1) s += __shfl_xor(s, o);
                if (lane == 0) { cntT[e] = s; cntT[16 + e] = (s + 255) & ~255; }
            }
            __syncthreads();
            if (tid == 0) { int b = 0; for (int e = 0; e < 8; ++e) { cntT[8 + e] = b; b += cntT[16 + e]; } cntT[24] = b >> 8; }
            __syncthreads();
            if (bx == 0) { const int np = cntT[24];
                if (tid < MAXPAN) { int ex = 0; for (int e = 0; e < 8; ++e) if (tid * 256 >= cntT[8 + e]) ex = e; P_PANEL[tid] = tid < np ? ex : 0; }
                if (tid == 0) P_PANEL[MAXPAN] = np; }
            for (int e = bx; e < 8; e += G) {
                const int r0 = cntT[8 + e] + cntT[e], r1 = cntT[8 + e] + cntT[16 + e];
                if (tid < r1 - r0 && r0 + tid >= 128 * 256) P_ROWT[r0 + tid] = -1;
                if (f8) { for (int q = tid; q < (r1 - r0) * 64; q += 512) { const int r = r0 + (q >> 6); *(GAS v4u*)((unsigned char*)P_XS + (size_t)r * D + (q & 63) * 16) = (v4u){0u, 0u, 0u, 0u}; } }
                else { for (int q = tid; q < (r1 - r0) * 128; q += 512) { const int r = r0 + (q >> 7); *(GAS v4u*)(P_XS + (size_t)r * D + (q & 127) * 8) = (v4u){0u, 0u, 0u, 0u}; } }
            }
            for (int vb = bx; vb < 256; vb += G) {
                __syncthreads();
                {   const int e = wave; int s = 0;
#pragma unroll
                    for (int i = 0; i < 4; ++i) { const int b2 = lane * 4 + i; s += b2 < vb ? P_WGCNT[b2 * 8 + e] : 0; }
#pragma unroll
                    for (int o = 1; o < 64; o <<= 1) s += __shfl_xor(s, o);
                    if (lane == 0) pre[e] = s; }
                __syncthreads();
                int mp0 = 0, mp1 = 0; float mrs = 0.f;
                if (lane < 8) { const int t = vb * 64 + wave * 8 + lane; const int e0 = P_TOKE[t * 2], e1 = P_TOKE[t * 2 + 1];
                    mp0 = cntT[8 + e0] + pre[e0] + P_TOKR[t * 2]; mp1 = cntT[8 + e1] + pre[e1] + P_TOKR[t * 2 + 1]; mrs = P_RSTD[t];
                    P_TOKP[t * 2] = mp0; P_TOKP[t * 2 + 1] = mp1; if (mp0 >= 128 * 256) P_ROWT[mp0] = t; if (mp1 >= 128 * 256) P_ROWT[mp1] = t; }
                for (int tt = 0; tt < 8; tt += 2) {
                    const int t = vb * 64 + wave * 8 + tt;
                    const GAS v2u* hr = (const GAS v2u*)(P_HB + (size_t)t * D) + lane;
                    v2u hw2[2][4];
#pragma unroll
                    for (int q = 0; q < 2; ++q)
#pragma unroll
                        for (int j = 0; j < 4; ++j) hw2[q][j] = hr[q * 256 + 64 * j];
                    f32x4 hv2[2][4];
#pragma unroll
                    for (int q = 0; q < 2; ++q)
#pragma unroll
                        for (int j = 0; j < 4; ++j) { hv2[q][j].x = bflo(hw2[q][j].x); hv2[q][j].y = bfhi(hw2[q][j].x); hv2[q][j].z = bflo(hw2[q][j].y); hv2[q][j].w = bfhi(hw2[q][j].y); }
#pragma unroll
                    for (int q = 0; q < 2; ++q) {
                        const int p0 = __shfl(mp0, tt + q), p1 = __shfl(mp1, tt + q); const float rstd = __shfl(mrs, tt + q);
                        if (f8) { GAS unsigned* o0 = (GAS unsigned*)((unsigned char*)P_XS + (size_t)p0 * D) + lane; GAS unsigned* o1 = (GAS unsigned*)((unsigned char*)P_XS + (size_t)p1 * D) + lane;
#pragma unroll
                            for (int j = 0; j < 4; ++j) { const f32x4 hv = hv2[q][j]; const unsigned w = pg8::pk4_fp8(hv.x * rstd, hv.y * rstd, hv.z * rstd, hv.w * rstd); o0[64 * j] = w; o1[64 * j] = w; }
                        } else { GAS v2u* o0 = (GAS v2u*)(P_XS + (size_t)p0 * D) + lane; GAS v2u* o1 = (GAS v2u*)(P_XS + (size_t)p1 * D) + lane;
#pragma unroll
                            for (int j = 0; j < 4; ++j) { const f32x4 hv = hv2[q][j]; v2u w; w.x = pk2(hv.x * rstd, hv.y * rstd); w.y = pk2(hv.z * rstd, hv.w * rstd); o0[64 * j] = w; o1[64 * j] = w; } }
                    }
                }
            }
        }
        SEAM(pb + 11);
        LAS int* ptab = (LAS int*)(lds + PTAB_OFF);
        if (IN(pb + 12) || IN(pb + 13)) {
            PHASE_IDS
            __syncthreads();
            if (tid <= MAXPAN) ptab[tid] = (int)__hip_atomic_load((unsigned*)P_PANEL + tid, RLX_AGENT);
            __syncthreads();
        }
        if (IN(pb + 12)) {
            const int np = __builtin_amdgcn_readfirstlane(ptab[MAXPAN]);
            pg8::Order S; S.init(np, EXD / 128, G_O, BX_O);
            if (F8_LAST && lp >= F8_FROM) {
                pg8::GDt g{P_XS, (const bf16*)(P_wod + OD_M13), D / 2, D / 2, D / 2, (size_t)EXD * D, ptab};
                pg8::EpiSwiGLUF8<false> E{(unsigned char*)P_UM, EXD, 1.0f / F8_W13_SC, F8_UM_SC, nullptr};
                pg8::gemm_phase<pg8::EpiSwiGLUF8<false>, pg8::Order, pg8::GDt, 1>(lds + RING_OFF, g, S, E, wave_s);
            } else {
                pg8::GDt g{P_XS, (const bf16*)(P_wod + OD_M13), D, D, D, (size_t)2 * EXD * D, ptab};
                pg8::EpiSwiGLU<true> E{P_UM, EXD, nullptr};
                pg8::gemm_phase<pg8::EpiSwiGLU<true>, pg8::Order, pg8::GDt>(lds + RING_OFF, g, S, E, wave_s);
            }
        }
        SEAM(pb + 12);
        if (IN(pb + 13)) {
            const int np = __builtin_amdgcn_readfirstlane(ptab[MAXPAN]);
            if (F8_LAST && lp >= F8_FROM) {
                const float osc = 1.0f / (F8_UM_SC * F8_W2_SC);
                {   pg8::GDt g{P_UM, (const bf16*)(P_wod + OD_M2), EXD / 2, EXD / 2, EXD / 2, (size_t)D * EXD / 2, ptab}; pg8::Order S; S.init(np < 128 ? np : 128, D / 256, G_O, BX_O);
                    pg8::EpiBf16 E{P_XS, D, osc};
                    pg8::gemm_phase<pg8::EpiBf16, pg8::Order, pg8::GDt, 1>(lds + RING_OFF, g, S, E, wave_s); }
                if (np > 128) {
                    pg8::GDk g{P_UM, (const bf16*)(P_wod + OD_M2), EXD / 2, EXD / 2, 256, (size_t)D * EXD / 2, ptab, 128, 256}; pg8::Order S; S.init(np - 128, 28, G_O, BX_O);
                    pg8::EpiPartF32 E{(float*)(P_ws + WS_PART), osc};
                    pg8::gemm_phase<pg8::EpiPartF32, pg8::Order, pg8::GDk, 1>(lds + RING_OFF, g, S, E, wave_s); }
            } else {
                {
                    pg8::GDt g{P_UM, (const bf16*)(P_wod + OD_M2), EXD, EXD, EXD, (size_t)D * EXD, ptab}; pg8::Order S; S.init(np < 128 ? np : 128, D / 256, G_O, BX_O);
                    pg8::EpiBf16 E{P_XS, D, 1.0f};
                    pg8::gemm_phase<pg8::EpiBf16, pg8::Order, pg8::GDt>(lds + RING_OFF, g, S, E, wave_s); }
                if (np > 128) {
                    pg8::GDk g{P_UM, (const bf16*)(P_wod + OD_M2), EXD, EXD, 512, (size_t)D * EXD, ptab, 128, 512}; pg8::Order S; S.init(np - 128, 28, G_O, BX_O);
                    pg8::EpiPartF32 E{(float*)(P_ws + WS_PART), 1.0f};
                    pg8::gemm_phase<pg8::EpiPartF32, pg8::Order, pg8::GDk>(lds + RING_OFF, g, S, E, wave_s); }
            }
        }
        SEAM(pb + 13);
        if (IN(pb + 14)) {
            PHASE_IDS
            const int gw = bx * NWAVES + wave, NGW = G * NWAVES; const bf16* YC = P_XS; const float* fg = INP(32); const float* PART = (const float*)(P_ws + WS_PART);
            int mp0 = 0, mp1 = 0; float mw0 = 0.f, mw1 = 0.f;
            if (lane < 8 && gw + lane * NGW < M) { const int t = gw + lane * NGW; mp0 = P_TOKP[t * 2]; mp1 = P_TOKP[t * 2 + 1]; mw0 = P_TOKW[t * 2]; mw1 = P_TOKW[t * 2 + 1]; }
#define COMBINE_FIN(T, V, AV, BV, FAST, PP0, PP1, GW0, GW1) do { GAS f32x4* hr_ = (GAS f32x4*)(P_H + (size_t)(T) * D) + lane; float s_ = 0.f;   \
                if (FAST) { _Pragma("unroll") for (int j = 0; j < 4; ++j) { V[j].x += GW0 * bflo(AV[j].x) + GW1 * bflo(BV[j].x); V[j].y += GW0 * bfhi(AV[j].x) + GW1 * bfhi(BV[j].x); V[j].z += GW0 * bflo(AV[j].y) + GW1 * bflo(BV[j].y); V[j].w += GW0 * bfhi(AV[j].y) + GW1 * bfhi(BV[j].y); } } \
                else { _Pragma("unroll") for (int sl = 0; sl < 2; ++sl) { const int p_ = sl ? PP1 : PP0; const float gwt_ = sl ? GW1 : GW0; \
                        if (p_ < 128 * 256) { const GAS v2u* y_ = (const GAS v2u*)(YC + (size_t)p_ * D) + lane; \
                            _Pragma("unroll") for (int j = 0; j < 4; ++j) { const v2u a_ = y_[64 * j]; V[j].x += gwt_ * bflo(a_.x); V[j].y += gwt_ * bfhi(a_.x); V[j].z += gwt_ * bflo(a_.y); V[j].w += gwt_ * bfhi(a_.y); } } \
                        else { const int q_ = (p_ - 128 * 256) >> 8, r_ = p_ & 255; \
                            for (int ks = 0; ks < 7; ++ks) { const GAS f32x4* y_ = (const GAS f32x4*)(PART + ((size_t)(q_ * 7 + ks) * 256 + r_) * D) + lane; \
                                _Pragma("unroll") for (int j = 0; j < 4; ++j) V[j] += gwt_ * y_[64 * j]; } } } } \
                _Pragma("unroll") for (int j = 0; j < 4; ++j) s_ += (V[j].x * V[j].x + V[j].y * V[j].y) + (V[j].z * V[j].z + V[j].w * V[j].w); \
                s_ = wave_sum(s_); \
                if (lp == 1) { const float rstd_ = 1.0f / sqrtf(s_ * (1.0f / 1024.0f) + 1e-5f); \
                    _Pragma("unroll") for (int j = 0; j < 4; ++j) { const f32x4 gv_ = *((const GAS f32x4*)fg + lane + 64 * j); f32x4 o_; o_.x = V[j].x * rstd_ * gv_.x; o_.y = V[j].y * rstd_ * gv_.y; o_.z = V[j].z * rstd_ * gv_.z; o_.w = V[j].w * rstd_ * gv_.w; hr_[64 * j] = o_; } } \
                else { GAS v2u* o8_ = (GAS v2u*)(P_HB + (size_t)(T) * D) + lane; \
                    _Pragma("unroll") for (int j = 0; j < 4; ++j) { v2u w_; w_.x = pk2(V[j].x, V[j].y); w_.y = pk2(V[j].z, V[j].w); o8_[64 * j] = w_; } \
                    if (lane < 16) P_SSQ[(size_t)(T) * 16 + lane] = lane == 0 ? s_ : 0.f; } } while (0)
            for (int it = 0; it < 8; it += 2) {
                const int t0 = gw + it * NGW, t1 = t0 + NGW; if (t0 >= M) break;
                const bool ok1 = t1 < M;
                const int p00 = __shfl(mp0, it), p01 = __shfl(mp1, it), p10 = __shfl(mp0, it + 1), p11 = __shfl(mp1, it + 1);
                const float g00 = __shfl(mw0, it), g01 = __shfl(mw1, it), g10 = __shfl(mw0, it + 1), g11 = __shfl(mw1, it + 1);
                const bool fast0 = p00 < 128 * 256 && p01 < 128 * 256, fast1 = ok1 && p10 < 128 * 256 && p11 < 128 * 256;
                f32x4 v0[4], v1[4]; v2u a0[4], b0[4], a1[4], b1[4], h0w[4], h1w[4];
                const int t1c = ok1 ? t1 : t0;
                const GAS v2u* hr0 = (const GAS v2u*)(P_HB + (size_t)t0 * D) + lane; const GAS v2u* hr1 = (const GAS v2u*)(P_HB + (size_t)t1c * D) + lane;
                const GAS v2u* y00 = (const GAS v2u*)(YC + (size_t)(fast0 ? p00 : 0) * D) + lane; const GAS v2u* y01 = (const GAS v2u*)(YC + (size_t)(fast0 ? p01 : 0) * D) + lane;
                const GAS v2u* y10 = (const GAS v2u*)(YC + (size_t)(fast1 ? p10 : 0) * D) + lane; const GAS v2u* y11 = (const GAS v2u*)(YC + (size_t)(fast1 ? p11 : 0) * D) + lane;
#pragma unroll
                for (int j = 0; j < 4; ++j) { h0w[j] = hr0[64 * j]; a0[j] = y00[64 * j]; b0[j] = y01[64 * j]; }
#pragma unroll
                for (int j = 0; j < 4; ++j) { h1w[j] = hr1[64 * j]; a1[j] = y10[64 * j]; b1[j] = y11[64 * j]; }
#pragma unroll
                for (int j = 0; j < 4; ++j) { v0[j].x = bflo(h0w[j].x); v0[j].y = bfhi(h0w[j].x); v0[j].z = bflo(h0w[j].y); v0[j].w = bfhi(h0w[j].y); v1[j].x = bflo(h1w[j].x); v1[j].y = bfhi(h1w[j].x); v1[j].z = bflo(h1w[j].y); v1[j].w = bfhi(h1w[j].y); }
                if (fast0) COMBINE_FIN(t0, v0, a0, b0, true, p00, p01, g00, g01);
                if (fast1) COMBINE_FIN(t1, v1, a1, b1, true, p10, p11, g10, g11);
            }
            {
                const int nrow = (int)__hip_atomic_load((unsigned*)P_PANEL + MAXPAN, RLX_AGENT) * 256;
                for (int r = 128 * 256 + gw; r < nrow; r += NGW) {
                    const int t = __builtin_amdgcn_readfirstlane(P_ROWT[r]); if (t < 0) continue;
                    const int q0 = __builtin_amdgcn_readfirstlane(P_TOKP[t * 2]), q1 = __builtin_amdgcn_readfirstlane(P_TOKP[t * 2 + 1]);
                    if ((q0 >= 128 * 256 ? q0 : q1) != r) continue;
                    const float h0 = P_TOKW[t * 2], h1 = P_TOKW[t * 2 + 1];
                    f32x4 v[4]; v2u ax[4], bx_[4]; const GAS v2u* hrr = (const GAS v2u*)(P_HB + (size_t)t * D) + lane;
#pragma unroll
                    for (int j = 0; j < 4; ++j) { const v2u hw = hrr[64 * j]; v[j].x = bflo(hw.x); v[j].y = bfhi(hw.x); v[j].z = bflo(hw.y); v[j].w = bfhi(hw.y); ax[j] = (v2u){0u, 0u}; bx_[j] = (v2u){0u, 0u}; }
                    COMBINE_FIN(t, v, ax, bx_, false, q0, q1, h0, h1);
                }
            }
#undef COMBINE_FIN
        }
        if (lp == 0) SEAM(pb + 14);
    }
#undef IN
#undef SEAM
}

#ifndef MK_PER_PHASE
#define MK_PER_PHASE 0
#endif
extern "C" void kernel_launch(void* const* d_in, const int* in_sizes, int n_in, void* d_out, int out_size, void* d_ws, size_t ws_size, hipStream_t stream) {
    static int grid = 0;
    if (grid == 0) {
        if (n_in != 33 || out_size != M * D || ws_size < WS_END) { fprintf(stderr, "kernel_launch: unexpected shapes (n_in %d, out %d, ws %zu, need %zu)\n", n_in, out_size, ws_size, (size_t)WS_END); grid = -1; return; }
        int dev = 0, cus = 0, per_cu = 0;
        if (hipGetDevice(&dev) != hipSuccess || hipDeviceGetAttribute(&cus, hipDeviceAttributeMultiprocessorCount, dev) != hipSuccess) { grid = -1; return; }
        if (hipFuncSetAttribute((const void*)trunk_fwd, hipFuncAttributeMaxDynamicSharedMemorySize, LDS_BYTES) != hipSuccess) { fprintf(stderr, "kernel_launch: hipFuncSetAttribute failed\n"); grid = -1; return; }
        if (hipOccupancyMaxActiveBlocksPerMultiprocessor(&per_cu, (const void*)trunk_fwd, NWAVES * 64, LDS_BYTES) != hipSuccess || per_cu < 1) fprintf(stderr, "kernel_launch: occupancy query reports %d\n", per_cu);
        (void)hipGetLastError();
        grid = cus;
    }
    if (grid < 0) return;
    if (hipMemsetAsync((char*)d_ws + WS_CTL, 0, CTL_ZERO_BYTES, stream) != hipSuccess) return;
    Args a{};
    for (int i = 0; i < 33; ++i) a.in[i] = (const float*)d_in[i];
    a.out = (float*)d_out; a.ws = (unsigned char*)d_ws;
#if MK_PER_PHASE
    for (int p = 0; p < NPH; ++p) { a.ph_lo = p; a.ph_hi = p + 1; hipLaunchKernelGGL(trunk_fwd, dim3(grid), dim3(NWAVES * 64), LDS_BYTES, stream, a); }
#elif defined(PROBE_PRE_LO)
    for (int rp = 0; rp < PROBE_PRE_N; ++rp) { a.ph_lo = PROBE_PRE_LO; a.ph_hi = PROBE_PRE_HI; hipLaunchKernelGGL(trunk_fwd, dim3(grid), dim3(NWAVES * 64), LDS_BYTES, stream, a);
        (void)hipMemsetAsync((char*)d_ws + WS_CTL, 0, CTL_ZERO_BYTES, stream); }
    a.ph_lo = 0; a.ph_hi = NPH;
    hipLaunchKernelGGL(trunk_fwd, dim3(grid), dim3(NWAVES * 64), LDS_BYTES, stream, a);
#elif defined(PROBE_POST_LO)
    a.ph_lo = 0; a.ph_hi = NPH;
    hipLaunchKernelGGL(trunk_fwd, dim3(grid), dim3(NWAVES * 64), LDS_BYTES, stream, a);
    for (int rp = 0; rp < PROBE_POST_N; ++rp) { (void)hipMemsetAsync((char*)d_ws + WS_CTL, 0, CTL_ZERO_BYTES, stream);
        a.ph_lo = PROBE_POST_LO; a.ph_hi = PROBE_POST_HI; hipLaunchKernelGGL(trunk_fwd, dim3(grid), dim3(NWAVES * 64), LDS_BYTES, stream, a); }
#else
    a.ph_lo = 0; a.ph_hi = NPH;
    hipLaunchKernelGGL(trunk_fwd, dim3(grid), dim3(NWAVES * 64), LDS_BYTES, stream, a);
#endif
}
```
